# Optimizing an MI355X kernel written in HIP

```python
import jax, jax.numpy as jnp
from jax import lax
import numpy as np

D_MODEL = 1024
BATCH = 2
SEQ = 8192
DEPTH = 4

N_A_LAYERS = DEPTH // 2
N_B_LAYERS = DEPTH - N_A_LAYERS
N_DENSE = (DEPTH + 1) // 2
N_MOE = DEPTH // 2
HGRN_EXPAND = 128
HGRN_HEADS = D_MODEL // HGRN_EXPAND
HGRN_DV = D_MODEL // HGRN_HEADS
HGRN_CHUNK = 64
SB_HEADS = 16
SB_HEAD_DIM = D_MODEL // SB_HEADS
SB_BLOCK = 128
FFN_DENSE = 2816
N_EXPERTS = 8
TOP_K = 2
FFN_EXPERT = 3584
MOE_BLOCK = 128
EPS = 1e-6
F_FLOOR = 1e-30

kernel_name = "yoco_hgrn2_stickbreak_moe"


def rmsnorm(x, w):
    xf = x.astype(jnp.float32)
    y = xf * lax.rsqrt(jnp.mean(xf * xf, axis=-1, keepdims=True) + EPS)
    return (y * w.astype(jnp.float32)).astype(x.dtype)


def hgrn2_lower_bounds(lb_raw):
    p = jax.nn.softmax(lb_raw.astype(jnp.float32), axis=0)
    return jnp.cumsum(p, axis=0) - p[0:1]


def hgrn2_mixer(h, w_in, lb, gnorm_w, w_out):
    bsz, seq, _ = h.shape
    n_chunks = seq // HGRN_CHUNK
    q, f_raw, i, g = jnp.split(h @ w_in, 4, axis=-1)
    q = jax.nn.silu(q.astype(jnp.float32))
    f_raw = f_raw.astype(jnp.float32)
    f = lb + (1.0 - lb) * jax.nn.sigmoid(f_raw)
    log_f = jnp.log(jnp.maximum(f, F_FLOOR))
    k = (1.0 - lb) * jax.nn.sigmoid(-f_raw)

    def to_chunks(t):
        return t.reshape(bsz, n_chunks, HGRN_CHUNK, HGRN_HEADS, -1).transpose(1, 0, 3, 2, 4)

    qc, kc, vc, lfc = (to_chunks(t) for t in (q, k, i.astype(jnp.float32), log_f))
    causal = jnp.tril(jnp.ones((HGRN_CHUNK, HGRN_CHUNK), dtype=bool))[:, :, None]

    def step(state, inp):
        qt, kt, vt, lft = inp
        G = jnp.cumsum(lft, axis=2)
        o = jnp.einsum('bhtd,bhde->bhte', qt * jnp.exp(G), state)
        diff = G[:, :, :, None, :] - G[:, :, None, :, :]
        decay = jnp.where(causal, jnp.exp(jnp.where(causal, diff, 0.0)), 0.0)
        scores = jnp.einsum('bhtd,bhtsd,bhsd->bhts', qt, decay, kt)
        o = o + jnp.einsum('bhts,bhse->bhte', scores, vt)
        G_last = G[:, :, -1:, :]
        state = (jnp.exp(G_last[:, :, 0, :])[..., None] * state
                 + jnp.einsum('bhsd,bhse->bhde', kt * jnp.exp(G_last - G), vt))
        return state, o

    state0 = jnp.zeros((bsz, HGRN_HEADS, HGRN_EXPAND, HGRN_DV), jnp.float32)
    _, o = lax.scan(step, state0, (qc, kc, vc, lfc))
    o = o.transpose(1, 0, 3, 2, 4).reshape(bsz, seq, HGRN_HEADS, HGRN_DV)
    o = o * lax.rsqrt(jnp.mean(o * o, axis=-1, keepdims=True) + EPS) * gnorm_w.astype(jnp.float32)
    o = o.reshape(bsz, seq, D_MODEL) * jax.nn.silu(g.astype(jnp.float32))
    return o.astype(h.dtype) @ w_out


def stick_breaking_attention(h, w_q, w_o, k, v):
    bsz, seq, _ = h.shape
    q = (h @ w_q).reshape(bsz, seq, SB_HEADS, SB_HEAD_DIM)
    scale = SB_HEAD_DIM ** -0.5
    outs = []
    for blk in range(seq // SB_BLOCK):
        q0 = blk * SB_BLOCK
        end = q0 + SB_BLOCK
        qb, kb, vb = q[:, q0:end], k[:, :end], v[:, :end]
        z = jnp.einsum('bqhd,bkhd->bhqk', qb, kb).astype(jnp.float32) * scale
        t_pos = q0 + jnp.arange(SB_BLOCK)
        s_pos = jnp.arange(end)
        mask = s_pos[None, :] < t_pos[:, None]
        log_beta = jax.nn.log_sigmoid(z)
        log_rem = jnp.where(mask, log_beta - z, 0.0)
        between = lax.cumsum(log_rem, axis=3, reverse=True) - log_rem
        weights = jnp.where(mask, jnp.exp(jnp.where(mask, log_beta + between, 0.0)), 0.0)
        outs.append(jnp.einsum('bhqk,bkhd->bqhd', weights.astype(vb.dtype), vb))
    o = jnp.concatenate(outs, axis=1).reshape(bsz, seq, D_MODEL)
    return o @ w_o


def swiglu(h, w_gu, w_down):
    gate, up = jnp.split(h @ w_gu, 2, axis=-1)
    return (jax.nn.silu(gate) * up) @ w_down


def moe_swiglu(h, router, w_gate, w_up, w_down):
    bsz, seq, d = h.shape
    n_tok = bsz * seq
    n_assign = n_tok * TOP_K
    xf = h.reshape(n_tok, d)
    logits = (xf @ router).astype(jnp.float32)
    top_logits, top_idx = lax.top_k(logits, TOP_K)
    gates = jax.nn.softmax(top_logits, axis=-1)
    flat_e = top_idx.reshape(-1)
    flat_tok = jnp.repeat(jnp.arange(n_tok, dtype=jnp.int32), TOP_K)
    flat_gate = gates.reshape(-1).astype(h.dtype)
    order = jnp.argsort(flat_e)
    sorted_e = flat_e[order]
    counts = jnp.bincount(flat_e, length=N_EXPERTS)
    starts = jnp.cumsum(counts) - counts
    padded = (counts + MOE_BLOCK - 1) // MOE_BLOCK * MOE_BLOCK
    pad_ends = jnp.cumsum(padded)
    pad_starts = pad_ends - padded
    dest = pad_starts[sorted_e] + jnp.arange(n_assign) - starts[sorted_e]
    n_rows = n_assign + N_EXPERTS * MOE_BLOCK
    n_blocks = n_rows // MOE_BLOCK
    buf_tok = jnp.full((n_rows,), n_tok, jnp.int32).at[dest].set(flat_tok[order])
    buf_gate = jnp.zeros((n_rows,), h.dtype).at[dest].set(flat_gate[order])
    block_expert = jnp.minimum(
        jnp.searchsorted(pad_ends, jnp.arange(n_blocks) * MOE_BLOCK, side='right'), N_EXPERTS - 1)
    x_pad = jnp.concatenate([xf, jnp.zeros((1, d), h.dtype)], axis=0)
    xb = x_pad[buf_tok].reshape(n_blocks, MOE_BLOCK, d)

    def expert_block(args):
        xblk, e = args
        return (jax.nn.silu(xblk @ w_gate[e]) * (xblk @ w_up[e])) @ w_down[e]

    yb = lax.map(expert_block, (xb, block_expert))
    y = yb.reshape(n_rows, d) * buf_gate[:, None]
    out = jnp.zeros((n_tok + 1, d), y.dtype).at[buf_tok].add(y)[:n_tok]
    return out.reshape(bsz, seq, d)


def setup_inputs(seed: int = 0) -> dict:
    key = jax.random.key(seed)
    ks = jax.random.split(key, 18)

    def dense(k, shape, fan_in):
        return jax.random.normal(k, shape, jnp.float32) * fan_in ** -0.5

    def gain(k, shape):
        return 1.0 + 0.02 * jax.random.normal(k, shape, jnp.float32)

    D = D_MODEL
    return {
        "x": jax.random.normal(ks[0], (BATCH, SEQ, D), jnp.float32),
        "mix_norm": gain(ks[1], (DEPTH, D)),
        "ffn_norm": gain(ks[2], (DEPTH, D)),
        "hgrn_w_in": dense(ks[3], (N_A_LAYERS, D, 4 * D), D),
        "hgrn_lb_raw": 0.1 * jax.random.normal(ks[4], (N_A_LAYERS, D), jnp.float32),
        "hgrn_gnorm": gain(ks[5], (N_A_LAYERS, HGRN_DV)),
        "hgrn_w_out": dense(ks[6], (N_A_LAYERS, D, D), D),
        "kv_norm": gain(ks[7], (D,)),
        "w_kv": dense(ks[8], (D, 2 * D), D),
        "sb_w_q": dense(ks[9], (N_B_LAYERS, D, D), D),
        "sb_w_o": dense(ks[10], (N_B_LAYERS, D, D), D),
        "ffn_w_gu": dense(ks[11], (N_DENSE, D, 2 * FFN_DENSE), D),
        "ffn_w_down": dense(ks[12], (N_DENSE, FFN_DENSE, D), FFN_DENSE),
        "moe_router": dense(ks[13], (N_MOE, D, N_EXPERTS), D),
        "moe_w_gate": dense(ks[14], (N_MOE, N_EXPERTS, D, FFN_EXPERT), D),
        "moe_w_up": dense(ks[15], (N_MOE, N_EXPERTS, D, FFN_EXPERT), D),
        "moe_w_down": dense(ks[16], (N_MOE, N_EXPERTS, FFN_EXPERT, D), FFN_EXPERT),
        "final_norm": gain(ks[17], (D,)),
    }


def reference(x, mix_norm, ffn_norm, hgrn_w_in, hgrn_lb_raw, hgrn_gnorm, hgrn_w_out,
              kv_norm, w_kv, sb_w_q, sb_w_o, ffn_w_gu, ffn_w_down,
              moe_router, moe_w_gate, moe_w_up, moe_w_down, final_norm):
    bsz, seq, _ = x.shape
    lower_bounds = hgrn2_lower_bounds(hgrn_lb_raw)
    shared_k = None
    shared_v = None
    for layer in range(DEPTH):
        h = rmsnorm(x, mix_norm[layer])
        if layer < N_A_LAYERS:
            x = x + hgrn2_mixer(h, hgrn_w_in[layer], lower_bounds[layer],
                                hgrn_gnorm[layer], hgrn_w_out[layer])
        else:
            j = layer - N_A_LAYERS
            x = x + stick_breaking_attention(h, sb_w_q[j], sb_w_o[j], shared_k, shared_v)
        h = rmsnorm(x, ffn_norm[layer])
        if layer % 2 == 0:
            x = x + swiglu(h, ffn_w_gu[layer // 2], ffn_w_down[layer // 2])
        else:
            x = x + moe_swiglu(h, moe_router[layer // 2], moe_w_gate[layer // 2],
                               moe_w_up[layer // 2], moe_w_down[layer // 2])
        if layer == N_A_LAYERS - 1:
            kv = rmsnorm(x, kv_norm) @ w_kv
            k_flat, v_flat = jnp.split(kv, 2, axis=-1)
            shared_k = k_flat.reshape(bsz, seq, SB_HEADS, SB_HEAD_DIM)
            shared_v = v_flat.reshape(bsz, seq, SB_HEADS, SB_HEAD_DIM)
    return rmsnorm(x, final_norm)
```

```cpp
#include <hip/hip_runtime.h>
#include <cstdio>
#include <cstdint>
namespace pg8 {
#define PG8_LAS __attribute__((address_space(3)))
typedef unsigned short bf16_t;
typedef short bf16x8 __attribute__((ext_vector_type(8)));
typedef float f32x4 __attribute__((ext_vector_type(4)));
typedef unsigned u32x4 __attribute__((ext_vector_type(4)));
constexpr int BM = 256, BK = 64, HALF = 128, HTB = HALF * BK * 2  , STAGE_BYTES = 8 * HTB, NXCD = 8, WGM = 8;

__host__ __device__ __forceinline__ int lds_byte(int r, int c) { const int st = (r >> 4) * 2 + (c >> 5), rr = r & 15, cc = c & 31, ob = rr * 64 + cc * 2; return st * 1024 + (ob ^ (((ob >> 9) & 1) << 5)); }
__host__ __device__ __forceinline__ void stage_rc(int b, int& R, int& C) { const int st = b / 1024, sb = b % 1024, swz = sb ^ (((sb >> 9) & 1) << 5); R = (st >> 1) * 16 + swz / 64; C = (st & 1) * 32 + (swz % 64) / 2; }
__host__ __device__ __forceinline__ int perm32(int rho) { const int n = rho >> 4, i = rho & 15; return 8 * (i >> 2) + 4 * n + (i & 3); }

struct Unit { int pm, pn, pc; };
struct Gemm { const bf16_t* A; const bf16_t* Bt; int M, N, K; };

struct StaticOrder {
    int nM, nN, nwg, G, c;
    __host__ __device__ void init(int M, int N, int G_, int c_) { nM = M / BM; nN = N / BM; nwg = nM * nN; G = G_; c = c_; }
    __host__ __device__ bool next(int i, Unit& u) const {
        const long L = (long)i * G + c; if (L >= nwg) return false;
        int wgid = (int)L; { const int q = nwg / NXCD, r = nwg % NXCD, xcd = wgid % NXCD, off = wgid / NXCD; wgid = (xcd < r ? xcd * (q + 1) : r * (q + 1) + (xcd - r) * q) + off; }
        const int nig = WGM * nN, gid = wgid / nig, fm = gid * WGM, gsz = (nM - fm) < WGM ? (nM - fm) : WGM;
        u.pm = fm + ((wgid % nig) % gsz); u.pn = (wgid % nig) / gsz; u.pc = u.pn; return true;
    }
    __device__ __forceinline__ void a_ready(const Unit&) const {}
    __device__ __forceinline__ void done(const Unit&) const {}
};

__device__ __forceinline__ unsigned cvt_pk_bf16(float lo, float hi) { unsigned r; asm volatile("v_cvt_pk_bf16_f32 %0, %1, %2" : "=v"(r) : "v"(lo), "v"(hi)); return r; }
typedef float f32x2 __attribute__((ext_vector_type(2)));

__device__ __forceinline__ float fsigmoid(float x) { return __builtin_amdgcn_rcpf(1.0f + __builtin_amdgcn_exp2f(-1.44269504089f * x)); }
__device__ __forceinline__ float fsilu(float x) { return x * fsigmoid(x); }

struct EpiResid {
    static constexpr bool PERM = false, AFTER_DRAIN = false;
    const float* base; float* out; int ldc;
    __device__ __forceinline__ void operator()(const f32x4 (&acc)[2][2][4][2], const Unit& u, int wr, int wc, int fr, int fq) const {
        const int row0 = u.pm * BM + wr * 64 + fr, col0 = u.pc * BM + wc * 32 + 4 * fq;
#pragma unroll
        for (int ai = 0; ai < 2; ++ai)
#pragma unroll
            for (int m = 0; m < 4; ++m) { const size_t off = (size_t)(row0 + ai * HALF + m * 16) * ldc + col0;
#pragma unroll
                for (int bj = 0; bj < 2; ++bj)
#pragma unroll
                    for (int n = 0; n < 2; ++n) { f32x4 b = (f32x4){0.f, 0.f, 0.f, 0.f}; if (base) b = *(const f32x4*)(base + off + bj * HALF + n * 16); *(f32x4*)(out + off + bj * HALF + n * 16) = b + acc[ai][bj][m][n]; } }
    }
};
struct EpiF32 {
    static constexpr bool PERM = false, AFTER_DRAIN = false;
    float* out; int ldc;
    __device__ __forceinline__ void operator()(const f32x4 (&acc)[2][2][4][2], const Unit& u, int wr, int wc, int fr, int fq) const {
        const int row0 = u.pm * BM + wr * 64 + fr, col0 = u.pc * BM + wc * 32 + 4 * fq;
#pragma unroll
        for (int ai = 0; ai < 2; ++ai)
#pragma unroll
            for (int m = 0; m < 4; ++m) { const size_t off = (size_t)(row0 + ai * HALF + m * 16) * ldc + col0;
#pragma unroll
                for (int bj = 0; bj < 2; ++bj)
#pragma unroll
                    for (int n = 0; n < 2; ++n) *(f32x4*)(out + off + bj * HALF + n * 16) = acc[ai][bj][m][n]; }
    }
};
struct EpiBf16P {
    static constexpr bool PERM = true, AFTER_DRAIN = false;
    bf16_t* O; int ldc;
    __device__ __forceinline__ void operator()(const f32x4 (&acc)[2][2][4][2], const Unit& u, int wr, int wc, int fr, int fq) const {
        const int row0 = u.pm * BM + wr * 64 + fr, col0 = u.pc * BM + wc * 32 + 8 * fq;
#pragma unroll
        for (int ai = 0; ai < 2; ++ai)
#pragma unroll
            for (int m = 0; m < 4; ++m) { bf16_t* rowp = O + (size_t)(row0 + ai * HALF + m * 16) * ldc + col0;
#pragma unroll
                for (int bj = 0; bj < 2; ++bj) { const f32x4 v0 = acc[ai][bj][m][0], v1 = acc[ai][bj][m][1];
                    u32x4 w; w.x = cvt_pk_bf16(v0[0], v0[1]); w.y = cvt_pk_bf16(v0[2], v0[3]); w.z = cvt_pk_bf16(v1[0], v1[1]); w.w = cvt_pk_bf16(v1[2], v1[3]);
                    *(u32x4*)(rowp + bj * HALF) = w; } }
    }
};
struct EpiSwiglu {
    static constexpr bool PERM = true, AFTER_DRAIN = false;
    bf16_t* H; int ldc;
    __device__ __forceinline__ void operator()(const f32x4 (&acc)[2][2][4][2], const Unit& u, int wr, int wc, int fr, int fq) const {
        const int row0 = u.pm * BM + wr * 64 + fr, col0 = u.pc * HALF + wc * 32 + 8 * fq;
#pragma unroll
        for (int ai = 0; ai < 2; ++ai)
#pragma unroll
            for (int m = 0; m < 4; ++m) { bf16_t* rowp = H + (size_t)(row0 + ai * HALF + m * 16) * ldc + col0;
                float h[8];
#pragma unroll
                for (int n = 0; n < 2; ++n)
#pragma unroll
                    for (int j = 0; j < 4; ++j) h[4 * n + j] = fsilu(acc[ai][0][m][n][j]) * acc[ai][1][m][n][j];
                u32x4 w; w.x = cvt_pk_bf16(h[0], h[1]); w.y = cvt_pk_bf16(h[2], h[3]); w.z = cvt_pk_bf16(h[4], h[5]); w.w = cvt_pk_bf16(h[6], h[7]);
                *(u32x4*)rowp = w; }
    }
};
struct EpiHgrnIn {
    static constexpr bool PERM = true, AFTER_DRAIN = false;
    bf16_t *QS, *KK, *VV, *GG; float* LF; const float* lb;
    __device__ __forceinline__ void operator()(const f32x4 (&acc)[2][2][4][2], const Unit& u, int wr, int wc, int fr, int fq) const {
        const int seg = u.pc >> 2;
        const int row0 = u.pm * BM + wr * 64 + fr, col0 = (u.pc & 3) * BM + wc * 32 + 8 * fq;
        bf16_t* O = seg == 0 ? QS : (seg == 1 ? KK : (seg == 2 ? VV : GG));
        float lbv[2][8];
        if (seg == 1) {
#pragma unroll
            for (int bj = 0; bj < 2; ++bj) { const f32x4 a = *(const f32x4*)(lb + col0 + bj * HALF), b = *(const f32x4*)(lb + col0 + bj * HALF + 4);
#pragma unroll
                for (int j = 0; j < 4; ++j) { lbv[bj][j] = a[j]; lbv[bj][4 + j] = b[j]; } }
        }
#pragma unroll
        for (int ai = 0; ai < 2; ++ai)
#pragma unroll
            for (int m = 0; m < 4; ++m) { const size_t roff = (size_t)(row0 + ai * HALF + m * 16) * 1024 + col0;
#pragma unroll
                for (int bj = 0; bj < 2; ++bj) {
                    float v[8];
#pragma unroll
                    for (int n = 0; n < 2; ++n)
#pragma unroll
                        for (int j = 0; j < 4; ++j) v[4 * n + j] = acc[ai][bj][m][n][j];
                    if (seg == 0 || seg == 3) {
#pragma unroll
                        for (int j = 0; j < 8; ++j) v[j] = fsilu(v[j]);
                    } else if (seg == 1) {
                        float lf[8];
#pragma unroll
                        for (int j = 0; j < 8; ++j) { const float sg = fsigmoid(v[j]), om = 1.0f - lbv[bj][j]; const float f = lbv[bj][j] + om * sg;
                            lf[j] = 0.69314718056f * __builtin_amdgcn_logf(fmaxf(f, 1e-30f)); v[j] = om * (1.0f - sg); }
                        *(f32x4*)(LF + roff + bj * HALF) = (f32x4){lf[0], lf[1], lf[2], lf[3]}; *(f32x4*)(LF + roff + bj * HALF + 4) = (f32x4){lf[4], lf[5], lf[6], lf[7]};
                    }
                    u32x4 w; w.x = cvt_pk_bf16(v[0], v[1]); w.y = cvt_pk_bf16(v[2], v[3]); w.z = cvt_pk_bf16(v[4], v[5]); w.w = cvt_pk_bf16(v[6], v[7]);
                    *(u32x4*)(O + roff + bj * HALF) = w; } }
    }
};
struct MoeOrder {
    StaticOrder so; const int* tile_e; int nN;
    __device__ void init(int nrt, int nN_, int G_, int c_, const int* te) { so.nM = nrt; so.nN = nN_; so.nwg = nrt * nN_; so.G = G_; so.c = c_; tile_e = te; nN = nN_; }
    __device__ bool next(int i, Unit& u) const { if (!so.next(i, u)) return false; const int e = __builtin_amdgcn_readfirstlane(tile_e[u.pm]); u.pn = e * nN + u.pc; return true; }
    __device__ __forceinline__ void a_ready(const Unit&) const {}
    __device__ __forceinline__ void done(const Unit&) const {}
};
template <class Epi, class Sched, bool ALIGN_EPI = false, bool SP2 = false>
__device__ __forceinline__ void gemm_phase(PG8_LAS unsigned char* lds, const Gemm g, const Sched& S, const Epi& E) {
    int tid_ = threadIdx.x; asm volatile("" : "+v"(tid_));
    const int tid = tid_, wid = __builtin_amdgcn_readfirstlane(tid >> 6), lane = tid & 63, wr = wid >> 2, wc = wid & 3, fr = lane & 15, fq = lane >> 4;
    const int K = g.K, nt = K / BK;
    unsigned voffA[2], voffB[2];
#pragma unroll
    for (int i = 0; i < 2; ++i) { int R, C; stage_rc(tid * 16 + i * 8192, R, C); const int Rb = Epi::PERM ? ((R & ~31) + perm32(R & 31)) : R;
        voffA[i] = (unsigned)(R * K + C) * 2u; voffB[i] = (unsigned)(Rb * K + C) * 2u; }
    const size_t kstep = (size_t)(BK * 2);
    const size_t hstep = (size_t)HALF * K * 2;
    const size_t tstep = 2 * hstep;
    const unsigned ldsw = (unsigned)wid * 1024u;
    const int aoff = lds_byte(wr * 64 + fr, fq * 8), boff = lds_byte(wc * 32 + fr, fq * 8);
#define PG8_SA(b, h) (((b) * 2 + (h)) * HTB)
#define PG8_SB(b, h) ((4 + (b) * 2 + (h)) * HTB)
#define PG8_STAGE(bufoff, gbase, voff) do { _Pragma("unroll") for (int _i = 0; _i < 2; ++_i) \
        __builtin_amdgcn_global_load_lds((const unsigned*)((const char*)(gbase) + (voff)[_i]), (PG8_LAS unsigned*)(lds + (bufoff) + ldsw + _i * 8192), 16, 0, 0); } while (0)
#define PG8_LDA(dst, b, h) do { _Pragma("unroll") for (int m = 0; m < 4; ++m) _Pragma("unroll") for (int k = 0; k < 2; ++k) dst[m][k] = *(const PG8_LAS bf16x8*)(lds + PG8_SA(b, h) + aoff + m * 2048 + k * 1024); } while (0)
#define PG8_LDB(dst, b, h) do { _Pragma("unroll") for (int n = 0; n < 2; ++n) _Pragma("unroll") for (int k = 0; k < 2; ++k) dst[n][k] = *(const PG8_LAS bf16x8*)(lds + PG8_SB(b, h) + boff + n * 2048 + k * 1024); } while (0)
#define PG8_MMA(ai, bj, At, Bt) do { __builtin_amdgcn_s_setprio(1); _Pragma("unroll") for (int m = 0; m < 4; ++m) _Pragma("unroll") for (int n = 0; n < 2; ++n) _Pragma("unroll") for (int k = 0; k < 2; ++k) \
        acc[ai][bj][m][n] = __builtin_amdgcn_mfma_f32_16x16x32_bf16(Bt[n][k], At[m][k], acc[ai][bj][m][n], 0, 0, 0); __builtin_amdgcn_s_setprio(0); } while (0)
#define PG8_WAIT_V(n) asm volatile("s_waitcnt vmcnt(" #n ")" ::: "memory")
#define PG8_WAIT_L(n) asm volatile("s_waitcnt lgkmcnt(" #n ")" ::: "memory")
#define PG8_BAR __builtin_amdgcn_s_barrier()
#define PG8_SCHED __builtin_amdgcn_sched_barrier(0)
    Unit cur, nxt; int ui = 0;
    if (!S.next(0, cur)) return;
    f32x4 acc[2][2][4][2];
#pragma unroll
    for (int a = 0; a < 2; ++a)
#pragma unroll
        for (int b = 0; b < 2; ++b)
#pragma unroll
            for (int m = 0; m < 4; ++m)
#pragma unroll
                for (int n = 0; n < 2; ++n) acc[a][b][m][n] = (f32x4){0.f, 0.f, 0.f, 0.f};
    bf16x8 At[4][2], B0[2][2], B1[2][2];
    const char* cA = (const char*)g.A + (size_t)cur.pm * tstep; const char* cB = (const char*)g.Bt + (size_t)cur.pn * tstep;
    S.a_ready(cur);
    if constexpr (SP2) {
        PG8_STAGE(PG8_SB(0, 0), cB, voffB); PG8_STAGE(PG8_SB(0, 1), cB + hstep, voffB); PG8_STAGE(PG8_SA(0, 0), cA, voffA); PG8_STAGE(PG8_SA(0, 1), cA + hstep, voffA);
        if (wr == 1) PG8_BAR;
        PG8_WAIT_V(2); PG8_BAR;
        PG8_STAGE(PG8_SB(1, 0), cB + kstep, voffB); PG8_STAGE(PG8_SA(1, 0), cA + kstep, voffA); PG8_STAGE(PG8_SB(1, 1), cB + hstep + kstep, voffB);
        PG8_WAIT_V(6); PG8_BAR;
    } else {
        PG8_STAGE(PG8_SB(0, 0), cB, voffB); PG8_STAGE(PG8_SA(0, 0), cA, voffA); PG8_STAGE(PG8_SB(0, 1), cB + hstep, voffB); PG8_STAGE(PG8_SA(0, 1), cA + hstep, voffA);
        if (wr == 1) PG8_BAR;
        PG8_WAIT_V(4); PG8_BAR;
        PG8_STAGE(PG8_SB(1, 0), cB + kstep, voffB); PG8_STAGE(PG8_SA(1, 0), cA + kstep, voffA); PG8_STAGE(PG8_SB(1, 1), cB + hstep + kstep, voffB);
        PG8_WAIT_V(6); PG8_BAR;
    }
    for (;;) {
        const bool has_next = S.next(ui + 1, nxt);
        const char* nA = has_next ? (const char*)g.A + (size_t)nxt.pm * tstep : cA; const char* nB = has_next ? (const char*)g.Bt + (size_t)nxt.pn * tstep : cB;
        for (int t = 0; t < nt; t += 2) {
            const bool last = (t == nt - 2);
            const char* a1 = cA + (size_t)(t + 1) * kstep;
            const char* a2 = last ? nA : cA + (size_t)(t + 2) * kstep; const char* b2 = last ? nB : cB + (size_t)(t + 2) * kstep;
            const char* a3 = a2 + kstep; const char* b3 = b2 + kstep;
            if (last && has_next) S.a_ready(nxt);
            if constexpr (SP2) {
            PG8_LDB(B0, 0, 0); PG8_LDB(B1, 0, 1); PG8_SCHED; PG8_LDA(At, 0, 0); PG8_STAGE(PG8_SA(1, 1), a1 + hstep, voffA);
            PG8_WAIT_V(8); PG8_WAIT_L(0); PG8_BAR; PG8_MMA(0, 0, At, B0); PG8_MMA(0, 1, At, B1); PG8_BAR; PG8_SCHED;
            PG8_LDA(At, 0, 1); PG8_STAGE(PG8_SB(0, 0), b2, voffB); PG8_STAGE(PG8_SB(0, 1), b2 + hstep, voffB); PG8_STAGE(PG8_SA(0, 0), a2, voffA);
            PG8_WAIT_V(8); PG8_WAIT_L(0); PG8_BAR; PG8_MMA(1, 0, At, B0); PG8_MMA(1, 1, At, B1); PG8_BAR; PG8_SCHED;
            PG8_LDB(B0, 1, 0); PG8_LDB(B1, 1, 1); PG8_SCHED; PG8_LDA(At, 1, 0); PG8_STAGE(PG8_SA(0, 1), a2 + hstep, voffA);
            PG8_WAIT_V(8); PG8_WAIT_L(0); PG8_BAR; PG8_MMA(0, 0, At, B0); PG8_MMA(0, 1, At, B1); PG8_BAR; PG8_SCHED;
            PG8_LDA(At, 1, 1); PG8_STAGE(PG8_SB(1, 0), b3, voffB); PG8_STAGE(PG8_SB(1, 1), b3 + hstep, voffB); PG8_STAGE(PG8_SA(1, 0), a3, voffA);
            PG8_WAIT_V(8); PG8_WAIT_L(0); PG8_BAR; PG8_MMA(1, 0, At, B0); PG8_MMA(1, 1, At, B1); PG8_BAR; PG8_SCHED;
            } else {
            PG8_LDB(B0, 0, 0); PG8_SCHED; PG8_LDA(At, 0, 0); PG8_STAGE(PG8_SA(1, 1), a1 + hstep, voffA);
            PG8_WAIT_L(8); PG8_BAR; PG8_WAIT_L(0); PG8_MMA(0, 0, At, B0); PG8_BAR; PG8_SCHED;
            PG8_LDB(B1, 0, 1); PG8_STAGE(PG8_SB(0, 0), b2, voffB);
            PG8_BAR; PG8_WAIT_L(0); PG8_MMA(0, 1, At, B1); PG8_BAR;
            PG8_LDA(At, 0, 1); PG8_STAGE(PG8_SA(0, 0), a2, voffA);
            PG8_BAR; PG8_WAIT_L(0); PG8_MMA(1, 0, At, B0); PG8_BAR; PG8_SCHED;
            PG8_STAGE(PG8_SB(0, 1), b2 + hstep, voffB);
            PG8_WAIT_V(6); PG8_BAR; PG8_MMA(1, 1, At, B1); PG8_BAR;
            PG8_LDB(B0, 1, 0); PG8_SCHED; PG8_LDA(At, 1, 0); PG8_STAGE(PG8_SA(0, 1), a2 + hstep, voffA);
            PG8_WAIT_L(8); PG8_BAR; PG8_WAIT_L(0); PG8_MMA(0, 0, At, B0); PG8_BAR; PG8_SCHED;
            PG8_LDB(B1, 1, 1); PG8_STAGE(PG8_SB(1, 0), b3, voffB);
            PG8_BAR; PG8_WAIT_L(0); PG8_MMA(0, 1, At, B1); PG8_BAR;
            PG8_LDA(At, 1, 1); PG8_STAGE(PG8_SA(1, 0), a3, voffA);
            PG8_BAR; PG8_WAIT_L(0); PG8_MMA(1, 0, At, B0); PG8_BAR; PG8_SCHED;
            PG8_STAGE(PG8_SB(1, 1), b3 + hstep, voffB);
            PG8_WAIT_V(6); PG8_BAR; PG8_MMA(1, 1, At, B1); PG8_BAR;
            }
        }
        if constexpr (ALIGN_EPI) { if (wr == 0) PG8_BAR; }
        if constexpr (!Epi::AFTER_DRAIN) { E(acc, cur, wr, wc, fr, fq); S.done(cur); }
        if (!has_next) break;
#pragma unroll
        for (int a = 0; a < 2; ++a)
#pragma unroll
            for (int b = 0; b < 2; ++b)
#pragma unroll
                for (int m = 0; m < 4; ++m)
#pragma unroll
                    for (int n = 0; n < 2; ++n) acc[a][b][m][n] = (f32x4){0.f, 0.f, 0.f, 0.f};
        cur = nxt; cA = nA; cB = nB; ++ui;
        if constexpr (ALIGN_EPI) { if (wr == 1) PG8_BAR; }
    }
    PG8_WAIT_V(0);
    if constexpr (!ALIGN_EPI) { if (wr == 0) PG8_BAR; }
    PG8_BAR;
    if constexpr (Epi::AFTER_DRAIN) { E.fused(acc, cur, wr, wc, fr, fq, lds, wid, lane); S.done(cur); }
#undef PG8_SA
#undef PG8_SB
#undef PG8_STAGE
#undef PG8_LDA
#undef PG8_LDB
#undef PG8_MMA
#undef PG8_WAIT_V
#undef PG8_WAIT_L
#undef PG8_BAR
#undef PG8_SCHED
}
}
#define GAS __attribute__((address_space(1)))
#define LAS __attribute__((address_space(3)))
typedef unsigned short bf16;
typedef unsigned v4u __attribute__((ext_vector_type(4)));
typedef float f32x4 __attribute__((ext_vector_type(4)));
typedef short bf16x8 __attribute__((ext_vector_type(8)));
typedef GAS unsigned gu32;
typedef GAS unsigned long long gu64;
#define RLX_AGENT __ATOMIC_RELAXED, __HIP_MEMORY_SCOPE_AGENT
#define LDS_WAIT() asm volatile("s_waitcnt lgkmcnt(0)" ::: "memory")
#define VM_WAIT() asm volatile("s_waitcnt vmcnt(0)" ::: "memory")
__device__ __forceinline__ unsigned long long rt() { return __builtin_amdgcn_s_memrealtime(); }
__device__ __forceinline__ unsigned f2bf(float f) { unsigned u = __builtin_bit_cast(unsigned, f); return (u + 0x7fffu + ((u >> 16) & 1u)) >> 16; }
__device__ __forceinline__ unsigned pk2(float lo, float hi) { return f2bf(lo) | (f2bf(hi) << 16); }

#define XB_TMO      128
#define XB_XCNT(j)  (256  + 64 * (j))
#define XB_XSUB(j)  (1280 + 64 * (j))
#define XB_XGEN(j)  (2304 + 64 * (j))
#define XB_TOP      3328
#define XB_TOPGEN   3392
#define XCD_BAR_WORDS 3456
#define XB_SPIN_CAP (1u << 22)

__device__ __forceinline__ unsigned xb_ld(unsigned* p)              { return __hip_atomic_load(p, __ATOMIC_RELAXED, __HIP_MEMORY_SCOPE_AGENT); }
__device__ __forceinline__ unsigned xb_add(unsigned* p, unsigned v) { return __hip_atomic_fetch_add(p, v, __ATOMIC_RELAXED, __HIP_MEMORY_SCOPE_AGENT); }
__device__ __forceinline__ unsigned xb_xcc_id() { return (unsigned)__builtin_amdgcn_s_getreg((3 << 11) | 20) & 0xFu; }
#define XB_SPIN(cond, bar) do { unsigned _sp = 0; while (cond) { __builtin_amdgcn_s_sleep(1); \
    if ((++_sp & 255u) == 0u) { if (xb_ld(&(bar)[XB_TMO])) break; if (_sp > XB_SPIN_CAP) { atomicAdd(&(bar)[XB_TMO], 1u); break; } } } } while (0)

struct XcdBarrier {
    unsigned* bar; unsigned x;
    volatile LAS unsigned* st;
};

__device__ __forceinline__ XcdBarrier xcd_barrier_post(unsigned* bar, volatile LAS unsigned* st) {
    XcdBarrier b; b.bar = bar; b.x = xb_xcc_id(); b.st = st;
    if (threadIdx.x == 0) (void)xb_add(&bar[XB_XCNT(b.x)], 1u);
    return b;
}
__device__ __forceinline__ void xcd_barrier_complete(unsigned* bar, unsigned x, unsigned& nloc, unsigned& nx) {
    const unsigned G = gridDim.x * gridDim.y * gridDim.z;
    unsigned sum, cnt, mine, sp = 0u;
    for (;;) {
        sum = 0u; cnt = 0u; mine = 0u;
#pragma unroll
        for (unsigned j = 0; j < 16; ++j) { const unsigned c = xb_ld(&bar[XB_XCNT(j)]); sum += c; cnt += (c > 0u) ? 1u : 0u; mine = (j == x) ? c : mine; }
        if (sum == G) break;
        __builtin_amdgcn_s_sleep(1);
        if ((++sp & 255u) == 0u) { if (xb_ld(&bar[XB_TMO])) break; if (sp > XB_SPIN_CAP) { atomicAdd(&bar[XB_TMO], 1u); break; } }
    }
    nloc = mine > 0u ? mine : 1u; nx = cnt > 0u ? cnt : 1u;
}

__device__ __forceinline__ void xcd_barrier(const XcdBarrier& b) {
    asm volatile("s_waitcnt vmcnt(0)" ::: "memory");
    __syncthreads();
    if (threadIdx.x == 0) {
        unsigned* bar = b.bar;
        __builtin_amdgcn_s_waitcnt(0);
        unsigned nloc = b.st[0], nx = b.st[1];
        if (nloc == 0u) { xcd_barrier_complete(bar, b.x, nloc, nx); b.st[0] = nloc; b.st[1] = nx; }
        const unsigned old = xb_add(&bar[XB_XSUB(b.x)], 1u);
        const unsigned gen = old / nloc;
        if (old + 1u == (gen + 1u) * nloc) {
            __builtin_amdgcn_fence(__ATOMIC_RELEASE, "agent");
            asm volatile("s_waitcnt vmcnt(0)" ::: "memory");
            const unsigned og = xb_add(&bar[XB_TOP], 1u);
            const unsigned tg = og / nx;
            if (og + 1u == (tg + 1u) * nx) xb_add(&bar[XB_TOPGEN], 1u);
            else XB_SPIN(xb_ld(&bar[XB_TOPGEN]) == tg, bar);
            __builtin_amdgcn_fence(__ATOMIC_ACQUIRE, "agent");
            xb_add(&bar[XB_XGEN(b.x)], 1u);
            asm volatile("s_waitcnt vmcnt(0)" ::: "memory");
        } else {
            XB_SPIN(xb_ld(&bar[XB_XGEN(b.x)]) == gen, bar);
            __builtin_amdgcn_fence(__ATOMIC_ACQUIRE, "agent");
            asm volatile("s_waitcnt vmcnt(0)" ::: "memory");
        }
    }
    __syncthreads();
}

constexpr int NWAVES = 8;
constexpr int GRID = 256;
constexpr int BATCH = 2, T = 8192, D = 1024, M = BATCH * T;
constexpr int HG_H = 8;
constexpr int SB_H = 16, SB_D = 64;
constexpr int FFD = 2816, FFE = 3584, NE = 8;
constexpr int MROWS = 2 * M + NE * 256, MRT = MROWS / 256;
constexpr float EPS = 1e-6f;
constexpr float QSCALE = 0.125f * 1.44269504089f;

constexpr size_t MiB = 1u << 20;
constexpr size_t WS_CTL = 0, CTL_ZERO_BYTES = 1 * MiB;
constexpr size_t WS_TAB = 1 * MiB;
constexpr size_t TAB_LB = WS_TAB, TAB_HIST = WS_TAB + 16384, TAB_TILE = WS_TAB + 32768, TAB_TOKE = WS_TAB + 65536, TAB_TOKG = WS_TAB + 262144, TAB_TOKP = WS_TAB + 524288;
constexpr size_t WS_WIN = 8 * MiB, WS_WOUT = 24 * MiB, WS_WQ = 28 * MiB, WS_WK = 32 * MiB, WS_WV = 34 * MiB, WS_WO = 36 * MiB, WS_WGU = 40 * MiB, WS_WDN = 62 * MiB;
constexpr size_t WS_WMGU = 80 * MiB, WS_WMDN = 192 * MiB;
constexpr size_t WS_XN = 248 * MiB;
constexpr size_t WS_K = 280 * MiB, WS_VT = 312 * MiB;
constexpr size_t WS_S = 344 * MiB;
constexpr size_t WS_QS = WS_S, WS_KK = WS_S + 32 * MiB, WS_VV = WS_S + 64 * MiB, WS_GG = WS_S + 96 * MiB, WS_LF = WS_S + 128 * MiB, WS_OR = WS_S + 192 * MiB, WS_OG = WS_S + 256 * MiB;
constexpr size_t WS_HB = WS_S;
constexpr size_t WS_XP = WS_S, WS_HM = WS_S + 68 * MiB, WS_Y = WS_S + 306 * MiB;
constexpr size_t WS_Q = WS_S, WS_AO = WS_S + 32 * MiB;
constexpr size_t WS_END = WS_S + 442 * MiB;
static_assert(WS_HM + (size_t)MROWS * FFE * 2 <= WS_Y && WS_Y + (size_t)MROWS * D * 4 <= WS_END && WS_XP + (size_t)MROWS * D * 2 <= WS_HM, "MoE scratch map");
static_assert(WS_WDN + (size_t)2 * D * FFD * 2 <= WS_WMGU && WS_WMGU + (size_t)NE * 2 * FFE * D * 2 <= WS_WMDN && WS_WMDN + (size_t)NE * D * FFE * 2 <= WS_XN, "weight map");
constexpr int CW_BAR = 4096;
constexpr int CW_ZTAB = 16384;

constexpr int RING_OFF = 0, RING_BYTES = 131072;
constexpr int LDSCTL_OFF = RING_BYTES, MISC_OFF = LDSCTL_OFF + 320;
constexpr int LDS_BYTES = 147456;

struct Args { const float* in[18]; float* out; unsigned char* ws; int ph_lo, ph_hi; };
typedef const __attribute__((address_space(4))) Args* CArgsP;
__device__ __forceinline__ CArgsP kargs() { CArgsP p = (CArgsP)__builtin_amdgcn_kernarg_segment_ptr(); asm volatile("" : "+s"(p)); return p; }
__device__ __forceinline__ int lg(int v) { asm volatile("" : "+s"(v)); return v; }
__device__ __forceinline__ unsigned char* wsbase() { return kargs()->ws; }
typedef float f32x2 __attribute__((ext_vector_type(2)));
struct Frame;
#define PHASE_LOCALS const int blk = lg((int)blockIdx.x); Frame F = F_; { int t_ = F_.tid; asm volatile("" : "+v"(t_)); F.tid = t_; F.lane = t_ & 63; F.wave = lg(F_.wave); F.vcu = lg(F_.vcu); F.G = lg(F_.G); } (void)blk;
struct Frame {
    LAS unsigned char* lds;
    volatile LAS unsigned* MISC;
    int tid, lane, wave;
    int vcu, G;
};

__device__ __forceinline__ float wave_sum(float v) {
#pragma unroll
    for (int o = 1; o < 64; o <<= 1) v += __shfl_xor(v, o);
    return v;
}
__device__ __forceinline__ float bf_lo(unsigned u) { return __uint_as_float(u << 16); }
__device__ __forceinline__ float bf_hi(unsigned u) { return __uint_as_float(u & 0xffff0000u); }
__device__ __forceinline__ float bf2f(bf16 b) { return __uint_as_float((unsigned)b << 16); }

__device__ __forceinline__ void conv_item(const float* W, int pitch, int c0, const float* gain, float scale, bf16* WT, int ldk, int drow0, int k0, int n0, LAS float* scr, int lane) {
#pragma unroll 8
    for (int i = 0; i < 32; ++i) { const int kk = 2 * i + (lane >> 5); const float g = gain ? gain[k0 + kk] * scale : scale;
        scr[kk * 33 + (lane & 31)] = W[(size_t)(k0 + kk) * pitch + c0 + n0 + (lane & 31)] * g; }
    LDS_WAIT(); asm volatile("" ::: "memory");
    const int c = lane & 7;
#pragma unroll
    for (int j = 0; j < 4; ++j) { const int n = (lane >> 3) + 8 * j; const LAS float* s = scr + (8 * c) * 33 + n;
        v4u o; o.x = pk2(s[0 * 33], s[1 * 33]); o.y = pk2(s[2 * 33], s[3 * 33]); o.z = pk2(s[4 * 33], s[5 * 33]); o.w = pk2(s[6 * 33], s[7 * 33]);
        *(GAS v4u*)(WT + (size_t)(drow0 + n) * ldk + k0 + 8 * c) = o; }
    LDS_WAIT(); asm volatile("" ::: "memory");
}
__device__ __forceinline__ void conv_mat(Frame& F_, const float* W, int K, int pitch, int c0, int nc, const float* gain, float scale, bf16* WT, int row_off, int il) {
    PHASE_LOCALS
    LAS float* scr = (LAS float*)(F.lds + RING_OFF + F.wave * 16384);
    const int gw = F.vcu * NWAVES + F.wave, NGW = F.G * NWAVES, nb = nc / 32, items = (K / 64) * nb;
    for (int it = gw; it < items; it += NGW) { const int kb = it / nb, n0 = (it % nb) * 32;
        const int drow0 = il == 0 ? row_off + n0 : row_off + (n0 >> 7) * 256 + (il - 1) * 128 + (n0 & 127);
        conv_item(W, pitch, c0, gain, scale, WT, K, drow0, kb * 64, n0, scr, F.lane); }
}
__device__ __forceinline__ void conv_moe(Frame& F_, const float* Wg, const float* Wu, const float* Wd, const float* gain) {
    PHASE_LOCALS
    unsigned char* const ws_ = kargs()->ws;
    LAS float* scr = (LAS float*)(F.lds + RING_OFF + F.wave * 16384);
    bf16* WMGU = (bf16*)(ws_ + WS_WMGU); bf16* WMDN = (bf16*)(ws_ + WS_WMDN);
    const int gw = F.vcu * NWAVES + F.wave, NGW = F.G * NWAVES;
    constexpr int PER = 1792;
    for (int it = gw; it < 24 * PER; it += NGW) { const int r = it / PER, loc = it % PER, ty = r >> 3, e = r & 7;
        if (ty < 2) { const int kb = loc / 112, n0 = (loc % 112) * 32; const float* W = (ty == 0 ? Wg : Wu) + (size_t)e * D * FFE;
            conv_item(W, FFE, 0, gain, 1.0f, WMGU + (size_t)e * 2 * FFE * D, D, (n0 >> 7) * 256 + ty * 128 + (n0 & 127), kb * 64, n0, scr, F.lane); }
        else { const int kb = loc / 32, n0 = (loc % 32) * 32; const float* W = Wd + (size_t)e * FFE * D;
            conv_item(W, D, 0, nullptr, 1.0f, WMDN + (size_t)e * D * FFE, FFE, n0, kb * 64, n0, scr, F.lane); }
    }
}

__device__ __forceinline__ void store_xn(bf16* XN, int m, int lane, const f32x4 (&v)[4], float rstd) {
    GAS unsigned long long* o8 = (GAS unsigned long long*)(XN + (size_t)m * D) + lane;
#pragma unroll
    for (int j = 0; j < 4; ++j) o8[64 * j] = (unsigned long long)pk2(v[j].x * rstd, v[j].y * rstd) | ((unsigned long long)pk2(v[j].z * rstd, v[j].w * rstd) << 32);
}
__device__ __forceinline__ float row_rstd(const f32x4 (&v)[4]) {
    float s = 0.f;
#pragma unroll
    for (int j = 0; j < 4; ++j) s += (v[j].x * v[j].x + v[j].y * v[j].y) + (v[j].z * v[j].z + v[j].w * v[j].w);
    return 1.0f / sqrtf(wave_sum(s) * (1.0f / D) + EPS);
}
__device__ __forceinline__ void norm_phase(Frame& F_, const float* X, bool route, const float* router  , const float* rgain  ) {
    PHASE_LOCALS
    unsigned char* const ws_ = kargs()->ws;
    bf16* XN = (bf16*)(ws_ + WS_XN);
    LAS float* RGT = (LAS float*)(F.lds + RING_OFF);
    LAS int* hist = (LAS int*)(F.lds + RING_OFF + 32768);
    if (route) {
        for (int i = F.tid; i < D * NE; i += NWAVES * 64) { const int k = i >> 3, e = i & 7; RGT[e * D + k] = router[i] * rgain[k]; }
        if (F.tid < NE) hist[F.tid] = 0;
        __syncthreads();
    }
    for (int i = 0; i < 8; ++i) {
        const int m = blk * 64 + F.wave * 8 + i;
        const GAS f32x4* xr = (const GAS f32x4*)(X + (size_t)m * D) + F.lane;
        f32x4 v[4];
#pragma unroll
        for (int j = 0; j < 4; ++j) v[j] = xr[64 * j];
        const float rstd = row_rstd(v);
        store_xn(XN, m, F.lane, v, rstd);
        if (route) {
            float lg[NE];
#pragma unroll
            for (int e = 0; e < NE; ++e) { float s = 0.f;
#pragma unroll
                for (int j = 0; j < 4; ++j) { const f32x4 r = *(const LAS f32x4*)(RGT + e * D + 4 * F.lane + 256 * j); s += (v[j].x * r.x + v[j].y * r.y) + (v[j].z * r.z + v[j].w * r.w); }
                lg[e] = wave_sum(s) * rstd; }
            float b0 = -3.0e38f, b1 = -3.0e38f; int i0 = 0, i1 = 0;
#pragma unroll
            for (int e = 0; e < NE; ++e) { if (lg[e] > b0) { b1 = b0; i1 = i0; b0 = lg[e]; i0 = e; } else if (lg[e] > b1) { b1 = lg[e]; i1 = e; } }
            if (F.lane == 0) { const float ex = __expf(b1 - b0), g0 = 1.0f / (1.0f + ex);
                ((GAS int*)(ws_ + TAB_TOKE))[2 * m] = i0; ((GAS int*)(ws_ + TAB_TOKE))[2 * m + 1] = i1;
                ((GAS float*)(ws_ + TAB_TOKG))[2 * m] = g0; ((GAS float*)(ws_ + TAB_TOKG))[2 * m + 1] = ex * g0;
                atomicAdd((int*)(hist + i0), 1); atomicAdd((int*)(hist + i1), 1); }
        }
    }
    if (route) { __syncthreads(); if (F.tid < NE) ((GAS int*)(ws_ + TAB_HIST))[blk * NE + F.tid] = hist[F.tid]; }
}
__device__ __forceinline__ void scatter_phase(Frame& F_) {
    PHASE_LOCALS
    unsigned char* const ws_ = kargs()->ws;
    LAS int* h = (LAS int*)(F.lds + RING_OFF);
    LAS int* pre = h + 2048; LAS int* tot = pre + 8; LAS int* pst = tot + 8; LAS int* pos = pst + 16;
    const GAS int* HIST = (const GAS int*)(ws_ + TAB_HIST);
    for (int i = F.tid; i < GRID * NE; i += NWAVES * 64) h[i] = HIST[i];
    __syncthreads();
    if (F.tid < NE) { int p = 0, t = 0; for (int b = 0; b < GRID; ++b) { const int v = h[b * NE + F.tid]; p += (b < blk) ? v : 0; t += v; } pre[F.tid] = p; tot[F.tid] = t; }
    __syncthreads();
    if (F.tid == 0) { int s = 0; for (int e = 0; e < NE; ++e) { pst[e] = s; s += (tot[e] + 255) & ~255; } pst[NE] = s; }
    __syncthreads();
    if (F.wave == 0) {
        const int m = blk * 64 + F.lane;
        const int e0 = ((const GAS int*)(ws_ + TAB_TOKE))[2 * m], e1 = ((const GAS int*)(ws_ + TAB_TOKE))[2 * m + 1];
        int p0 = 0, p1 = 0; const unsigned long long lt = (1ull << F.lane) - 1ull;
#pragma unroll
        for (int e = 0; e < NE; ++e) { const unsigned long long mk = __ballot(e0 == e || e1 == e); const int rk = __popcll(mk & lt) + pst[e] + pre[e];
            if (e0 == e) p0 = rk; if (e1 == e) p1 = rk; }
        ((GAS int*)(ws_ + TAB_TOKP))[2 * m] = p0; ((GAS int*)(ws_ + TAB_TOKP))[2 * m + 1] = p1;
        pos[2 * F.lane] = p0; pos[2 * F.lane + 1] = p1;
    }
    if (blk == 0 && F.tid >= 64 && F.tid < 64 + MRT + 1) { const int rt = F.tid - 64; GAS int* TE = (GAS int*)(ws_ + TAB_TILE);
        if (rt == MRT) TE[160] = pst[NE] >> 8;
        else { int e = NE - 1; for (int q = NE - 1; q >= 0; --q) if (rt * 256 < pst[q + 1]) e = q; TE[rt] = e; } }
    __syncthreads();
    const bf16* XN = (const bf16*)(ws_ + WS_XN); bf16* XP = (bf16*)(ws_ + WS_XP);
    for (int i = 0; i < 8; ++i) { const int tl = F.wave * 8 + i, m = blk * 64 + tl;
        const GAS v4u* s = (const GAS v4u*)(XN + (size_t)m * D); const v4u a = s[F.lane], b = s[64 + F.lane];
        GAS v4u* d0 = (GAS v4u*)(XP + (size_t)pos[2 * tl] * D); GAS v4u* d1 = (GAS v4u*)(XP + (size_t)pos[2 * tl + 1] * D);
        d0[F.lane] = a; d0[64 + F.lane] = b; d1[F.lane] = a; d1[64 + F.lane] = b; }
}
__device__ __forceinline__ void combine_phase(Frame& F_, float* X, bool last, const float* fgain) {
    PHASE_LOCALS
    unsigned char* const ws_ = kargs()->ws;
    const float* Y = (const float*)(ws_ + WS_Y); bf16* XN = (bf16*)(ws_ + WS_XN);
    for (int i = 0; i < 8; ++i) {
        const int m = blk * 64 + F.wave * 8 + i;
        const int p0 = ((const GAS int*)(ws_ + TAB_TOKP))[2 * m], p1 = ((const GAS int*)(ws_ + TAB_TOKP))[2 * m + 1];
        const float g0 = ((const GAS float*)(ws_ + TAB_TOKG))[2 * m], g1 = ((const GAS float*)(ws_ + TAB_TOKG))[2 * m + 1];
        GAS f32x4* xr = (GAS f32x4*)(X + (size_t)m * D) + F.lane;
        const GAS f32x4* y0 = (const GAS f32x4*)(Y + (size_t)p0 * D) + F.lane; const GAS f32x4* y1 = (const GAS f32x4*)(Y + (size_t)p1 * D) + F.lane;
        f32x4 v[4];
#pragma unroll
        for (int j = 0; j < 4; ++j) v[j] = xr[64 * j] + g0 * y0[64 * j] + g1 * y1[64 * j];
        const float rstd = row_rstd(v);
        if (last) {
#pragma unroll
            for (int j = 0; j < 4; ++j) { const f32x4 g = *((const GAS f32x4*)fgain + F.lane + 64 * j); xr[64 * j] = v[j] * rstd * g; }
        } else {
#pragma unroll
            for (int j = 0; j < 4; ++j) xr[64 * j] = v[j];
            store_xn(XN, m, F.lane, v, rstd);
        }
    }
}

__device__ __forceinline__ void hgrn_naive(Frame& F_) {
    PHASE_LOCALS
    unsigned char* const ws_ = kargs()->ws;
    const bf16* QS = (const bf16*)(ws_ + WS_QS); const bf16* KK = (const bf16*)(ws_ + WS_KK); const bf16* VV = (const bf16*)(ws_ + WS_VV);
    const float* LF = (const float*)(ws_ + WS_LF); float* OR = (float*)(ws_ + WS_OR);
    const int gw = blk * NWAVES + F.wave, bh = gw >> 7, e = gw & 127, b = bh >> 3, hh = bh & 7;
    const size_t base = (size_t)b * T * D + hh * 128;
    float S0 = 0.f, S1 = 0.f;
    for (int t0 = 0; t0 < T; t0 += 8) {
        float q0[8], q1[8], k0[8], k1[8], f0[8], f1[8], vv[8];
#pragma unroll
        for (int i = 0; i < 8; ++i) { const size_t off = base + (size_t)(t0 + i) * D;
            const unsigned qq = *(const GAS unsigned*)(QS + off + 2 * F.lane), kk = *(const GAS unsigned*)(KK + off + 2 * F.lane);
            const f32x2 lf = *(const GAS f32x2*)(LF + off + 2 * F.lane);
            q0[i] = bf_lo(qq); q1[i] = bf_hi(qq); k0[i] = bf_lo(kk); k1[i] = bf_hi(kk); f0[i] = __expf(lf.x); f1[i] = __expf(lf.y); vv[i] = bf2f(VV[off + e]); }
        float p[8];
#pragma unroll
        for (int i = 0; i < 8; ++i) { S0 = f0[i] * S0 + k0[i] * vv[i]; S1 = f1[i] * S1 + k1[i] * vv[i]; p[i] = q0[i] * S0 + q1[i] * S1; }
#pragma unroll
        for (int i = 0; i < 8; ++i) p[i] = wave_sum(p[i]);
        float o = p[0];
#pragma unroll
        for (int i = 1; i < 8; ++i) o = (F.lane == i) ? p[i] : o;
        if (F.lane < 8) OR[base + (size_t)(t0 + F.lane) * D + e] = o;
    }
}
__device__ __forceinline__ void gate_norm_phase(Frame& F_, const float* gnorm  ) {
    PHASE_LOCALS
    unsigned char* const ws_ = kargs()->ws;
    const float* OR = (const float*)(ws_ + WS_OR); const bf16* GG = (const bf16*)(ws_ + WS_GG); bf16* OG = (bf16*)(ws_ + WS_OG);
    const f32x4 gn = *((const GAS f32x4*)gnorm + (F.lane & 31));
    for (int i = 0; i < 8; ++i) {
        const int m = blk * 64 + F.wave * 8 + i;
        const GAS f32x4* orow = (const GAS f32x4*)(OR + (size_t)m * D) + F.lane;
        const GAS unsigned long long* grow = (const GAS unsigned long long*)(GG + (size_t)m * D) + F.lane;
        GAS unsigned long long* o8 = (GAS unsigned long long*)(OG + (size_t)m * D) + F.lane;
#pragma unroll
        for (int j = 0; j < 4; ++j) { const f32x4 o = orow[64 * j]; const unsigned long long g = grow[64 * j];
            float s = (o.x * o.x + o.y * o.y) + (o.z * o.z + o.w * o.w);
#pragma unroll
            for (int w = 1; w < 32; w <<= 1) s += __shfl_xor(s, w);
            const float rs = 1.0f / sqrtf(s * (1.0f / 128.0f) + EPS);
            const unsigned glo = (unsigned)g, ghi = (unsigned)(g >> 32);
            o8[64 * j] = (unsigned long long)pk2(o.x * rs * gn.x * bf_lo(glo), o.y * rs * gn.y * bf_hi(glo)) | ((unsigned long long)pk2(o.z * rs * gn.z * bf_lo(ghi), o.w * rs * gn.w * bf_hi(ghi)) << 32); }
    }
}
__device__ __forceinline__ void attn_naive(Frame& F_) {
    PHASE_LOCALS
    unsigned char* const ws_ = kargs()->ws;
    const bf16* Q = (const bf16*)(ws_ + WS_Q); const bf16* K = (const bf16*)(ws_ + WS_K); const bf16* VT = (const bf16*)(ws_ + WS_VT); bf16* AO = (bf16*)(ws_ + WS_AO);
    for (int r = 0; r < 2; ++r) {
        const int idx = r * (GRID * 512) + blk * 512 + F.tid, bh = idx >> 13, t = idx & (T - 1), b = bh >> 4, hh = bh & 15;
        float q[64], o[64];
        const GAS v4u* qp = (const GAS v4u*)(Q + (size_t)(b * T + t) * D + hh * 64);
#pragma unroll
        for (int c = 0; c < 8; ++c) { const v4u w = qp[c]; q[8 * c] = bf_lo(w.x); q[8 * c + 1] = bf_hi(w.x); q[8 * c + 2] = bf_lo(w.y); q[8 * c + 3] = bf_hi(w.y); q[8 * c + 4] = bf_lo(w.z); q[8 * c + 5] = bf_hi(w.z); q[8 * c + 6] = bf_lo(w.w); q[8 * c + 7] = bf_hi(w.w); }
#pragma unroll
        for (int d = 0; d < 64; ++d) o[d] = 0.f;
        float R = 0.f;
        for (int s = t - 1; s >= 0; --s) {
            const GAS v4u* kp = (const GAS v4u*)(K + (size_t)(b * T + s) * D + hh * 64);
            float z = 0.f;
#pragma unroll
            for (int c = 0; c < 8; ++c) { const v4u w = kp[c];
                z += q[8 * c] * bf_lo(w.x) + q[8 * c + 1] * bf_hi(w.x) + q[8 * c + 2] * bf_lo(w.y) + q[8 * c + 3] * bf_hi(w.y) + q[8 * c + 4] * bf_lo(w.z) + q[8 * c + 5] * bf_hi(w.z) + q[8 * c + 6] * bf_lo(w.w) + q[8 * c + 7] * bf_hi(w.w); }
            z = fminf(z, 126.0f);
            const float L = __builtin_amdgcn_logf(1.0f + __builtin_amdgcn_exp2f(z));
            const float w = __builtin_amdgcn_exp2f(z - L + R);
            R -= L;
            const bf16* vp = VT + (size_t)(hh * 64) * M + (size_t)b * T + s;
#pragma unroll
            for (int d = 0; d < 64; ++d) o[d] += w * bf2f(vp[(size_t)d * M]);
            if (R < -150.0f) break;
        }
        GAS v4u* op = (GAS v4u*)(AO + (size_t)(b * T + t) * D + hh * 64);
#pragma unroll
        for (int c = 0; c < 8; ++c) { v4u w; w.x = pk2(o[8 * c], o[8 * c + 1]); w.y = pk2(o[8 * c + 2], o[8 * c + 3]); w.z = pk2(o[8 * c + 4], o[8 * c + 5]); w.w = pk2(o[8 * c + 6], o[8 * c + 7]); op[c] = w; }
    }
}

__device__ __forceinline__ void prologue(Frame& F_) {
    PHASE_LOCALS
    unsigned char* const ws_ = kargs()->ws;
#define in (kargs()->in)
    if (blk == 0) { GAS float* LB = (GAS float*)(ws_ + TAB_LB); const float* raw = in[4];
        for (int c = F.tid; c < D; c += NWAVES * 64) { const float a = raw[c], b = raw[D + c], mx = fmaxf(a, b), ea = __expf(a - mx), eb = __expf(b - mx); LB[c] = 0.f; LB[D + c] = eb / (ea + eb); } }
    const float* mixn = in[1]; const float* ffnn = in[2];
#pragma nounroll
    for (int l = 0; l < 2; ++l) {
        conv_mat(F, in[3] + (size_t)l * D * 4 * D, D, 4 * D, 0, 4 * D, mixn + l * D, 1.0f, (bf16*)(ws_ + WS_WIN) + (size_t)l * 4 * D * D, 0, 0);
        conv_mat(F, in[6] + (size_t)l * D * D, D, D, 0, D, nullptr, 1.0f, (bf16*)(ws_ + WS_WOUT) + (size_t)l * D * D, 0, 0);
        conv_mat(F, in[9] + (size_t)l * D * D, D, D, 0, D, mixn + (2 + l) * D, QSCALE, (bf16*)(ws_ + WS_WQ) + (size_t)l * D * D, 0, 0);
        conv_mat(F, in[10] + (size_t)l * D * D, D, D, 0, D, nullptr, 1.0f, (bf16*)(ws_ + WS_WO) + (size_t)l * D * D, 0, 0);
        conv_mat(F, in[11] + (size_t)l * D * 2 * FFD, D, 2 * FFD, 0, FFD, ffnn + (2 * l) * D, 1.0f, (bf16*)(ws_ + WS_WGU) + (size_t)l * 2 * FFD * D, 0, 1);
        conv_mat(F, in[11] + (size_t)l * D * 2 * FFD, D, 2 * FFD, FFD, FFD, ffnn + (2 * l) * D, 1.0f, (bf16*)(ws_ + WS_WGU) + (size_t)l * 2 * FFD * D, 0, 2);
        conv_mat(F, in[12] + (size_t)l * FFD * D, FFD, D, 0, D, nullptr, 1.0f, (bf16*)(ws_ + WS_WDN) + (size_t)l * D * FFD, 0, 0);
    }
    conv_mat(F, in[8], D, 2 * D, 0, D, in[7], 1.0f, (bf16*)(ws_ + WS_WK), 0, 0);
    conv_mat(F, in[8], D, 2 * D, D, D, in[7], 1.0f, (bf16*)(ws_ + WS_WV), 0, 0);
    conv_moe(F, in[14], in[15], in[16], ffnn + D);
    norm_phase(F, in[0], false, nullptr, nullptr);
#undef in
}


constexpr int NPH = 1 + (4 + 1 + 3) + (4 + 1 + 4) + (3 + 1 + 3) + (3 + 1 + 4);
__global__ void __launch_bounds__(NWAVES * 64, 2) yoco_fwd(Args) {
    extern __shared__ __attribute__((aligned(16))) unsigned char lds[];
    Frame F;
    F.lds = (LAS unsigned char*)lds;
    F.MISC = (volatile LAS unsigned*)(F.lds + MISC_OFF);
    F.tid = threadIdx.x; F.lane = F.tid & 63; F.wave = __builtin_amdgcn_readfirstlane(F.tid >> 6);
    F.G = gridDim.x; { const int bx = blockIdx.x; F.vcu = (F.G % 8 == 0) ? (bx % 8) * (F.G / 8) + bx / 8 : bx; }
    for (int u = F.tid; u < (LDS_BYTES - LDSCTL_OFF) / 4; u += NWAVES * 64) ((LAS unsigned*)(F.lds + LDSCTL_OFF))[u] = 0u;
    __syncthreads();
    const int lo = kargs()->ph_lo, hi = kargs()->ph_hi;
    XcdBarrier bar; bar.bar = (unsigned*)(kargs()->ws + WS_CTL) + CW_BAR; bar.x = 0; bar.st = nullptr;
    if (hi - lo > 1) bar = xcd_barrier_post((unsigned*)(kargs()->ws + WS_CTL) + CW_BAR, F.MISC + 8);
    int ph = 0;
#define PH_ON (ph >= lo && ph < hi)
#define PH_END do { if (ph >= lo && ph + 1 < hi) { XcdBarrier b2_; b2_.bar = (unsigned*)(wsbase() + WS_CTL) + CW_BAR; b2_.st = bar.st; b2_.x = lg((int)__builtin_amdgcn_readfirstlane(bar.x)); xcd_barrier(b2_); } ++ph; } while (0)
#define in (kargs()->in)
#define X (kargs()->out)
#define XN ((bf16*)(wsbase() + WS_XN))
#define ws (wsbase())

    if (PH_ON) prologue(F);
    PH_END;
#pragma nounroll
    for (int layer = 0; layer < 4; ++layer) {
        const bool hg = layer < 2, moe = (layer & 1) != 0;
        const int fi = layer >> 1;
        if (hg) {
            if (PH_ON) {
                pg8::Gemm g{XN, (const bf16*)(ws + WS_WIN) + (size_t)layer * 4 * D * D, M, 4 * D, D}; pg8::StaticOrder S; S.init(M, 4 * D, lg(F.G), lg((int)blockIdx.x));
                pg8::EpiHgrnIn E{(bf16*)(ws + WS_QS), (bf16*)(ws + WS_KK), (bf16*)(ws + WS_VV), (bf16*)(ws + WS_GG), (float*)(ws + WS_LF), (const float*)(ws + TAB_LB) + layer * D};
                pg8::gemm_phase<pg8::EpiHgrnIn, pg8::StaticOrder, true, true>(F.lds + RING_OFF, g, S, E);
            }
            PH_END;
            if (PH_ON) hgrn_naive(F);
            PH_END;
            if (PH_ON) gate_norm_phase(F, in[5] + layer * 128);
            PH_END;
        } else {
            if (PH_ON) {
                const int nw = (layer == 2) ? 3 : 1;
#pragma nounroll
                for (int w = 0; w < nw; ++w) {
                    pg8::Gemm g; pg8::EpiBf16P E; pg8::StaticOrder S;
                    if (w == 0) { g = pg8::Gemm{XN, (const bf16*)(ws + WS_WQ) + (size_t)(layer - 2) * D * D, M, D, D}; E = pg8::EpiBf16P{(bf16*)(ws + WS_Q), D}; }
                    else if (w == 1) { g = pg8::Gemm{XN, (const bf16*)(ws + WS_WK), M, D, D}; E = pg8::EpiBf16P{(bf16*)(ws + WS_K), D}; }
                    else { g = pg8::Gemm{(const bf16*)(ws + WS_WV), XN, D, M, D}; E = pg8::EpiBf16P{(bf16*)(ws + WS_VT), M}; }
                    S.init(g.M, g.N, lg(F.G), lg((int)blockIdx.x));
                    pg8::gemm_phase<pg8::EpiBf16P, pg8::StaticOrder, true, true>(F.lds + RING_OFF, g, S, E);
                    __syncthreads();
                }
            }
            PH_END;
            if (PH_ON) attn_naive(F);
            PH_END;
        }
        if (PH_ON) {
            const float* xin = (layer == 0) ? in[0] : X;
            pg8::Gemm g{hg ? (const bf16*)(ws + WS_OG) : (const bf16*)(ws + WS_AO), hg ? (const bf16*)(ws + WS_WOUT) + (size_t)layer * D * D : (const bf16*)(ws + WS_WO) + (size_t)(layer - 2) * D * D, M, D, D};
            pg8::StaticOrder S; S.init(M, D, lg(F.G), lg((int)blockIdx.x));
            pg8::EpiResid E{xin, X, D};
            pg8::gemm_phase<pg8::EpiResid, pg8::StaticOrder, true, true>(F.lds + RING_OFF, g, S, E);
        }
        PH_END;
        if (PH_ON) norm_phase(F, X, moe, in[13] + (size_t)fi * D * NE, in[2] + layer * D);
        PH_END;
        if (moe) { if (PH_ON) scatter_phase(F); PH_END; }
        if (PH_ON) {
            const int nrt = moe ? __builtin_amdgcn_readfirstlane(((const GAS int*)(ws + TAB_TILE))[160]) : M / 256;
            pg8::Gemm g{moe ? (const bf16*)(ws + WS_XP) : (const bf16*)XN, moe ? (const bf16*)(ws + WS_WMGU) : (const bf16*)(ws + WS_WGU) + (size_t)fi * 2 * FFD * D, nrt * 256, moe ? 2 * FFE : 2 * FFD, D};
            pg8::MoeOrder S; S.init(nrt, (moe ? 2 * FFE : 2 * FFD) / 256, lg(F.G), lg((int)blockIdx.x), moe ? (const int*)(ws + TAB_TILE) : (const int*)(ws + WS_CTL) + CW_ZTAB);
            pg8::EpiSwiglu E{moe ? (bf16*)(ws + WS_HM) : (bf16*)(ws + WS_HB), moe ? FFE : FFD};
            pg8::gemm_phase<pg8::EpiSwiglu, pg8::MoeOrder, true, true>(F.lds + RING_OFF, g, S, E);
        }
        PH_END;
        if (PH_ON) {
            const int nrt = moe ? __builtin_amdgcn_readfirstlane(((const GAS int*)(ws + TAB_TILE))[160]) : M / 256;
            pg8::Gemm g{moe ? (const bf16*)(ws + WS_HM) : (const bf16*)(ws + WS_HB), moe ? (const bf16*)(ws + WS_WMDN) : (const bf16*)(ws + WS_WDN) + (size_t)fi * D * FFD, nrt * 256, D, moe ? FFE : FFD};
            pg8::MoeOrder S; S.init(nrt, D / 256, lg(F.G), lg((int)blockIdx.x), moe ? (const int*)(ws + TAB_TILE) : (const int*)(ws + WS_CTL) + CW_ZTAB);
            pg8::EpiResid E{moe ? nullptr : X, moe ? (float*)(ws + WS_Y) : X, D};
            pg8::gemm_phase<pg8::EpiResid, pg8::MoeOrder, true, true>(F.lds + RING_OFF, g, S, E);
        }
        PH_END;
        if (PH_ON) {
            if (moe) { combine_phase(F, X, layer == 3, in[17]); if (layer == 1) { __syncthreads(); conv_moe(F, in[14] + (size_t)NE * D * FFE, in[15] + (size_t)NE * D * FFE, in[16] + (size_t)NE * FFE * D, in[2] + 3 * D); } }
            else norm_phase(F, X, false, nullptr, nullptr);
        }
        PH_END;
    }
#undef PH_ON
#undef PH_END
#undef in
#undef X
#undef ws
#undef XN
}

#ifndef MK_PER_PHASE
#define MK_PER_PHASE 1
#endif
extern "C" void kernel_launch(void* const* d_in, const int* in_sizes, int n_in, void* d_out, int out_size, void* d_ws, size_t ws_size, hipStream_t stream) {
    static int ok = 0;
    if (ok == 0) {
        if (n_in != 18 || in_sizes[0] != M * D || out_size != M * D || ws_size < WS_END) { fprintf(stderr, "kernel_launch: unexpected shapes / workspace (n_in %d, ws %zu, need %zu); nothing launched\n", n_in, ws_size, (size_t)WS_END); ok = -1; return; }
        if (hipFuncSetAttribute((const void*)yoco_fwd, hipFuncAttributeMaxDynamicSharedMemorySize, LDS_BYTES) != hipSuccess) { fprintf(stderr, "kernel_launch: hipFuncSetAttribute failed\n"); ok = -1; return; }
        int per_cu = 0;
        if (hipOccupancyMaxActiveBlocksPerMultiprocessor(&per_cu, (const void*)yoco_fwd, NWAVES * 64, LDS_BYTES) != hipSuccess || per_cu < 1) fprintf(stderr, "kernel_launch: note: occupancy query reports %d workgroups per CU\n", per_cu);
        (void)hipGetLastError();
        ok = 1;
    }
    if (ok < 0) return;
    (void)hipMemsetAsync((char*)d_ws + WS_CTL, 0, CTL_ZERO_BYTES, stream);
    Args a{};
    for (int i = 0; i < 18; ++i) a.in[i] = (const float*)d_in[i];
    a.out = (float*)d_out; a.ws = (unsigned char*)d_ws;
#if MK_PER_PHASE
    for (int p = 0; p < NPH; ++p) { a.ph_lo = p; a.ph_hi = p + 1; hipLaunchKernelGGL(yoco_fwd, dim3(GRID), dim3(NWAVES * 64), LDS_BYTES, stream, a); }
#else
    a.ph_lo = 0; a.ph_hi = NPH; hipLaunchKernelGGL(yoco_fwd, dim3(GRID), dim3(NWAVES * 64), LDS_BYTES, stream, a);
#endif
}
```

```cpp
#include <hip/hip_runtime.h>
#include <cstdio>
#include <cstdint>
#ifndef REP_EPI8
#define REP_EPI8 1
#endif
#ifndef REP_HCC
#define REP_HCC 1
#endif
#ifndef REP_HCB
#define REP_HCB 1
#endif
namespace pg8 {
#define PG8_LAS __attribute__((address_space(3)))
typedef unsigned short bf16_t;
typedef short bf16x8 __attribute__((ext_vector_type(8)));
typedef float f32x4 __attribute__((ext_vector_type(4)));
typedef unsigned u32x4 __attribute__((ext_vector_type(4)));
constexpr int BM = 256, BK = 64, HALF = 128, HTB = HALF * BK * 2  , STAGE_BYTES = 8 * HTB, NXCD = 8, WGM = 4;

__host__ __device__ __forceinline__ int lds_byte(int r, int c) { const int st = (r >> 4) * 2 + (c >> 5), rr = r & 15, cc = c & 31, ob = rr * 64 + cc * 2; return st * 1024 + (ob ^ (((ob >> 9) & 1) << 5)); }
__host__ __device__ __forceinline__ void stage_rc(int b, int& R, int& C) { const int st = b / 1024, sb = b % 1024, swz = sb ^ (((sb >> 9) & 1) << 5); R = (st >> 1) * 16 + swz / 64; C = (st & 1) * 32 + (swz % 64) / 2; }
__host__ __device__ __forceinline__ int perm32(int rho) { const int n = rho >> 4, i = rho & 15; return 8 * (i >> 2) + 4 * n + (i & 3); }

struct Unit { int pm, pn, pc, ko, po; };
struct Gemm { const bf16_t* A; const bf16_t* Bt; int M, N, K, KL; int pA = 0, pB = 0; long ksA = 0, ksB = 0; const float* sA = nullptr; const float* sB = nullptr; };

struct StaticOrder {
    int nM, nN, nwg, G, c;
    __host__ __device__ void init(int M, int N, int G_, int c_) { nM = M / BM; nN = N / BM; nwg = nM * nN; G = G_; c = c_; }
    __host__ __device__ bool next(int i, Unit& u) const {
        const long L = (long)i * G + c; if (L >= nwg) return false;
        int wgid = (int)L; { const int q = nwg / NXCD, r = nwg % NXCD, xcd = wgid % NXCD, off = wgid / NXCD; wgid = (xcd < r ? xcd * (q + 1) : r * (q + 1) + (xcd - r) * q) + off; }
        const int nig = WGM * nN, gid = wgid / nig, fm = gid * WGM, gsz = (nM - fm) < WGM ? (nM - fm) : WGM;
        u.pm = fm + ((wgid % nig) % gsz); u.pn = (wgid % nig) / gsz; u.pc = u.pn; u.ko = 0; u.po = u.pm; return true;
    }
    __device__ __forceinline__ void a_ready(const Unit&) const {}
    __device__ __forceinline__ void done(const Unit&) const {}
};

__device__ __forceinline__ unsigned cvt_pk_bf16(float lo, float hi) { unsigned r; asm volatile("v_cvt_pk_bf16_f32 %0, %1, %2" : "=v"(r) : "v"(lo), "v"(hi)); return r; }
typedef float f32x2 __attribute__((ext_vector_type(2)));

typedef int i32x4 __attribute__((ext_vector_type(4)));
template <bool I8> struct AccSel { typedef f32x4 type; };
template <> struct AccSel<true> { typedef i32x4 type; };
__device__ __forceinline__ f32x4 mma16(bf16x8 a, bf16x8 b, f32x4 c) { return __builtin_amdgcn_mfma_f32_16x16x32_bf16(a, b, c, 0, 0, 0); }
__device__ __forceinline__ i32x4 mma16(bf16x8 a, bf16x8 b, i32x4 c) { return __builtin_amdgcn_mfma_i32_16x16x64_i8(__builtin_bit_cast(i32x4, a), __builtin_bit_cast(i32x4, b), c, 0, 0, 0); }
template <bool PERM> __device__ __forceinline__ void dequant(const f32x4 (&)[2][2][4][2], f32x4 (&)[2][2][4][2], const PG8_LAS float*, int, int, int, int) {}
template <bool PERM> __device__ __forceinline__ void dequant(const i32x4 (&acc)[2][2][4][2], f32x4 (&f)[2][2][4][2], const PG8_LAS float* SL, int wr, int wc, int fr, int fq) {
    const PG8_LAS float* sa = SL + wr * 64 + fr; const PG8_LAS float* sb = SL + 256 + wc * 32 + (PERM ? 8 * fq : 4 * fq);
    f32x4 cs[2][2];
#pragma unroll
    for (int bj = 0; bj < 2; ++bj)
#pragma unroll
        for (int n = 0; n < 2; ++n) cs[bj][n] = *(const PG8_LAS f32x4*)(sb + bj * HALF + (PERM ? 4 * n : 16 * n));
#pragma unroll
    for (int ai = 0; ai < 2; ++ai)
#pragma unroll
        for (int m = 0; m < 4; ++m) { const float rs = sa[ai * HALF + m * 16];
#pragma unroll
            for (int bj = 0; bj < 2; ++bj)
#pragma unroll
                for (int n = 0; n < 2; ++n) { const i32x4 a = acc[ai][bj][m][n]; f[ai][bj][m][n] = (f32x4){(float)a[0], (float)a[1], (float)a[2], (float)a[3]} * (cs[bj][n] * rs); } }
}
__device__ __forceinline__ float fsigmoid(float x) { return __builtin_amdgcn_rcpf(1.0f + __builtin_amdgcn_exp2f(-1.44269504089f * x)); }
__device__ __forceinline__ float fsilu(float x) { return x * fsigmoid(x); }

struct EpiResid {
    static constexpr bool PERM = false, AFTER_DRAIN = false;
    const float* base; float* out; int ldc;
    __device__ __forceinline__ void operator()(const f32x4 (&acc)[2][2][4][2], const Unit& u, int wr, int wc, int fr, int fq) const {
        const int row0 = u.pm * BM + wr * 64 + fr, col0 = u.pc * BM + wc * 32 + 4 * fq;
#pragma unroll
        for (int ai = 0; ai < 2; ++ai)
#pragma unroll
            for (int m = 0; m < 4; ++m) { const size_t off = (size_t)(row0 + ai * HALF + m * 16) * ldc + col0;
#pragma unroll
                for (int bj = 0; bj < 2; ++bj)
#pragma unroll
                    for (int n = 0; n < 2; ++n) { f32x4 b = (f32x4){0.f, 0.f, 0.f, 0.f}; if (base) b = *(const f32x4*)(base + off + bj * HALF + n * 16); *(f32x4*)(out + off + bj * HALF + n * 16) = b + acc[ai][bj][m][n]; } }
    }
};
struct EpiF32 {
    static constexpr bool PERM = false, AFTER_DRAIN = false;
    float* out; int ldc;
    __device__ __forceinline__ void operator()(const f32x4 (&acc)[2][2][4][2], const Unit& u, int wr, int wc, int fr, int fq) const {
        const int row0 = u.pm * BM + wr * 64 + fr, col0 = u.pc * BM + wc * 32 + 4 * fq;
#pragma unroll
        for (int ai = 0; ai < 2; ++ai)
#pragma unroll
            for (int m = 0; m < 4; ++m) { const size_t off = (size_t)(row0 + ai * HALF + m * 16) * ldc + col0;
#pragma unroll
                for (int bj = 0; bj < 2; ++bj)
#pragma unroll
                    for (int n = 0; n < 2; ++n) *(f32x4*)(out + off + bj * HALF + n * 16) = acc[ai][bj][m][n]; }
    }
};
struct EpiBf16P {
    static constexpr bool PERM = true, AFTER_DRAIN = false;
    bf16_t* O; int ldc, mode;
    __device__ __forceinline__ void operator()(const f32x4 (&acc)[2][2][4][2], const Unit& u, int wr, int wc, int fr, int fq) const {
        const int row0 = u.pm * BM + wr * 64 + fr, col0 = u.pc * BM + wc * 32 + 8 * fq;
#pragma unroll
        for (int ai = 0; ai < 2; ++ai)
#pragma unroll
            for (int m = 0; m < 4; ++m) { const int row = row0 + ai * HALF + m * 16;
#pragma unroll
                for (int bj = 0; bj < 2; ++bj) { const f32x4 v0 = acc[ai][bj][m][0], v1 = acc[ai][bj][m][1]; const int col = col0 + bj * HALF;
                    u32x4 w; w.x = cvt_pk_bf16(v0[0], v0[1]); w.y = cvt_pk_bf16(v0[2], v0[3]); w.z = cvt_pk_bf16(v1[0], v1[1]); w.w = cvt_pk_bf16(v1[2], v1[3]);
                    size_t off;
                    if (mode == 0) off = (size_t)row * ldc + col;
                    else if (mode == 1) { const int b = row >> 13, key = row & 8191, kk = key & 31, rr = (kk & ~12) | ((kk & 4) << 1) | ((kk & 8) >> 1), h = col >> 6;
                        off = ((size_t)((((b * 16 + h) * 256 + (key >> 5)) * 4 + ((col & 63) >> 4)) * 64 + ((col & 15) >> 3) * 32 + rr)) * 8; }
                    else { const int h = row >> 6, d = row & 63, b = col >> 13, key = col & 8191;
                        off = ((size_t)((((b * 16 + h) * 256 + (key >> 5)) * 4 + (d >> 5) * 2 + ((key & 31) >> 4)) * 64 + ((key & 15) >> 3) * 32 + (d & 31))) * 8; }
                    *(u32x4*)(O + off) = w; } }
    }
};
struct EpiSwiglu {
    static constexpr bool PERM = true, AFTER_DRAIN = false;
    bf16_t* H; int rows;
    __device__ __forceinline__ void operator()(const f32x4 (&acc)[2][2][4][2], const Unit& u, int wr, int wc, int fr, int fq) const {
        const int row0 = u.pm * BM + wr * 64 + fr, kt = u.pc * 2 + (wc >> 1), c64 = (wc & 1) * 32 + 8 * fq;
#pragma unroll
        for (int ai = 0; ai < 2; ++ai)
#pragma unroll
            for (int m = 0; m < 4; ++m) { bf16_t* rowp = H + ((size_t)kt * rows + (row0 + ai * HALF + m * 16)) * 64 + c64;
                float h[8];
#pragma unroll
                for (int n = 0; n < 2; ++n)
#pragma unroll
                    for (int j = 0; j < 4; ++j) h[4 * n + j] = fsilu(acc[ai][0][m][n][j]) * acc[ai][1][m][n][j];
                u32x4 w; w.x = cvt_pk_bf16(h[0], h[1]); w.y = cvt_pk_bf16(h[2], h[3]); w.z = cvt_pk_bf16(h[4], h[5]); w.w = cvt_pk_bf16(h[6], h[7]);
                *(u32x4*)rowp = w; }
    }
};
struct EpiHgrnIn {
    static constexpr bool PERM = true, AFTER_DRAIN = false;
    bf16_t* QS; _Float16* LF; const float* lb;
    static constexpr size_t SEGSTRIDE = (size_t)16 << 20;
    __device__ __forceinline__ void operator()(const f32x4 (&acc)[2][2][4][2], const Unit& u, int wr, int wc, int fr, int fq) const {
        const int seg = u.pc >> 2;
        const int row0 = u.pm * BM + wr * 64 + fr, col0 = (u.pc & 3) * BM + wc * 32 + 8 * fq;
        bf16_t* O = QS + (size_t)seg * SEGSTRIDE;
        float lbv[2][8];
        if (seg == 1) {
#pragma unroll
            for (int bj = 0; bj < 2; ++bj) { const f32x4 a = *(const f32x4*)(lb + col0 + bj * HALF), b = *(const f32x4*)(lb + col0 + bj * HALF + 4);
#pragma unroll
                for (int j = 0; j < 4; ++j) { lbv[bj][j] = a[j]; lbv[bj][4 + j] = b[j]; } }
        }
#pragma unroll
        for (int ai = 0; ai < 2; ++ai)
#pragma unroll
            for (int m = 0; m < 4; ++m) { const size_t roff = (size_t)(row0 + ai * HALF + m * 16) * 1024 + col0;
#pragma unroll
                for (int bj = 0; bj < 2; ++bj) {
                    float v[8];
#pragma unroll
                    for (int n = 0; n < 2; ++n)
#pragma unroll
                        for (int j = 0; j < 4; ++j) v[4 * n + j] = acc[ai][bj][m][n][j];
                    if (seg == 1) {
                        typedef _Float16 f16x2 __attribute__((ext_vector_type(2)));
                        float lf[8];
#pragma unroll
                        for (int j = 0; j < 8; ++j) { const float sg = fsigmoid(v[j]); const float f = lbv[bj][j] + (1.0f - lbv[bj][j]) * sg; lf[j] = 0.69314718056f * __builtin_amdgcn_logf(fmaxf(f, 1e-30f)); }
                        u32x4 hw;
                        hw.x = __builtin_bit_cast(unsigned, (f16x2){(_Float16)lf[0], (_Float16)lf[1]}); hw.y = __builtin_bit_cast(unsigned, (f16x2){(_Float16)lf[2], (_Float16)lf[3]});
                        hw.z = __builtin_bit_cast(unsigned, (f16x2){(_Float16)lf[4], (_Float16)lf[5]}); hw.w = __builtin_bit_cast(unsigned, (f16x2){(_Float16)lf[6], (_Float16)lf[7]});
                        *(u32x4*)(LF + roff + bj * HALF) = hw;
                    } else {
                        if (seg != 2) {
#pragma unroll
                            for (int j = 0; j < 8; ++j) v[j] = fsilu(v[j]); }
                        u32x4 w; w.x = cvt_pk_bf16(v[0], v[1]); w.y = cvt_pk_bf16(v[2], v[3]); w.z = cvt_pk_bf16(v[4], v[5]); w.w = cvt_pk_bf16(v[6], v[7]);
                        *(u32x4*)(O + roff + bj * HALF) = w; } } }
    }
};
struct EpiDown {
    static constexpr bool PERM = false, AFTER_DRAIN = false;
    const float* base; float* out; bf16_t* y; size_t ystride; int kl, ldc;
    __device__ __forceinline__ void operator()(const f32x4 (&acc)[2][2][4][2], const Unit& u, int wr, int wc, int fr, int fq) const {
        const int col0 = u.pc * BM + wc * 32 + 4 * fq;
        if (out) {
            const int row0 = u.pm * BM + wr * 64 + fr;
#pragma unroll
            for (int ai = 0; ai < 2; ++ai)
#pragma unroll
                for (int m = 0; m < 4; ++m) { const size_t off = (size_t)(row0 + ai * HALF + m * 16) * ldc + col0;
#pragma unroll
                    for (int bj = 0; bj < 2; ++bj)
#pragma unroll
                        for (int n = 0; n < 2; ++n) { const f32x4 b = *(const f32x4*)(base + off + bj * HALF + n * 16); *(f32x4*)(out + off + bj * HALF + n * 16) = b + acc[ai][bj][m][n]; } }
        } else {
            const int row0 = u.po * BM + wr * 64 + fr; bf16_t* Y = y + (size_t)(u.ko / kl) * ystride;
            typedef unsigned u32x2 __attribute__((ext_vector_type(2)));
#pragma unroll
            for (int ai = 0; ai < 2; ++ai)
#pragma unroll
                for (int m = 0; m < 4; ++m) { const size_t off = (size_t)(row0 + ai * HALF + m * 16) * ldc + col0;
#pragma unroll
                    for (int bj = 0; bj < 2; ++bj)
#pragma unroll
                        for (int n = 0; n < 2; ++n) { const f32x4 v = acc[ai][bj][m][n]; u32x2 w; w.x = cvt_pk_bf16(v[0], v[1]); w.y = cvt_pk_bf16(v[2], v[3]); *(u32x2*)(Y + off + bj * HALF + n * 16) = w; } }
        }
    }
};
struct EpiDownMoe {
    static constexpr bool PERM = true, AFTER_DRAIN = false;
    bf16_t* y; size_t ystride; int kl, ldc;
    __device__ __forceinline__ void operator()(const f32x4 (&acc)[2][2][4][2], const Unit& u, int wr, int wc, int fr, int fq) const {
        const int row0 = u.po * BM + wr * 64 + fr, col0 = u.pc * BM + wc * 32 + 8 * fq; bf16_t* Y = y + (size_t)(u.ko / kl) * ystride;
#pragma unroll
        for (int ai = 0; ai < 2; ++ai)
#pragma unroll
            for (int m = 0; m < 4; ++m) { bf16_t* rowp = Y + (size_t)(row0 + ai * HALF + m * 16) * ldc + col0;
#pragma unroll
                for (int bj = 0; bj < 2; ++bj) { const f32x4 v0 = acc[ai][bj][m][0], v1 = acc[ai][bj][m][1];
                    u32x4 w; w.x = cvt_pk_bf16(v0[0], v0[1]); w.y = cvt_pk_bf16(v0[2], v0[3]); w.z = cvt_pk_bf16(v1[0], v1[1]); w.w = cvt_pk_bf16(v1[2], v1[3]);
                    *(u32x4*)(rowp + bj * HALF) = w; } }
    }
};
struct MoeOrder {
    StaticOrder so; const int* tile_e; const int* list; int nN, KL, compact, rev;
    __device__ void init(int nrt, int nN_, int KS, int KL_, int G_, int c_, const int* te, const int* li, int compact_, int rev_ = 0) { compact = compact_; rev = rev_; so.nM = nrt; so.nN = nN_ * KS; so.nwg = nrt * nN_ * KS; so.G = G_; so.c = c_; tile_e = te; list = li; nN = nN_; KL = KL_; }
    __device__ bool next(int i, Unit& u) const { if (!so.next(i, u)) return false;
        if (list) u.pm = __builtin_amdgcn_readfirstlane(list[rev ? so.nM - 1 - u.pm : u.pm]);
        if (!compact) u.po = u.pm;
        const int e = __builtin_amdgcn_readfirstlane(tile_e[u.pm]); const int ks = u.pc / nN, pl = u.pc - ks * nN;
        u.pn = e * nN + pl; u.pc = pl; u.ko = ks * KL; return true; }
    __device__ __forceinline__ void a_ready(const Unit&) const {}
    __device__ __forceinline__ void done(const Unit&) const {}
};
template <class Epi, class Sched, bool ALIGN_EPI = false, bool SP2 = false, bool I8 = false>
__device__ __forceinline__ void gemm_phase(PG8_LAS unsigned char* lds, const Gemm g, const Sched& S, const Epi& E) {
    int tid_ = threadIdx.x; asm volatile("" : "+v"(tid_));
    const int tid = tid_, wid = __builtin_amdgcn_readfirstlane(tid >> 6), lane = tid & 63, wr = wid >> 2, wc = wid & 3, fr = lane & 15, fq = lane >> 4;
    const int K = g.K  , nt = g.KL / BK  ;
    const int pitA = g.pA ? g.pA : K, pitB = g.pB ? g.pB : K;
    unsigned voffA[2], voffB[2];
#pragma unroll
    for (int i = 0; i < 2; ++i) { int R, C; stage_rc(tid * 16 + i * 8192, R, C); const int Rb = Epi::PERM ? ((R & ~31) + perm32(R & 31)) : R;
        voffA[i] = (unsigned)(R * pitA + C) * 2u; voffB[i] = (unsigned)(Rb * pitB + C) * 2u; }
    const size_t kstepA = g.ksA ? (size_t)g.ksA : (size_t)(BK * 2), kstepB = g.ksB ? (size_t)g.ksB : (size_t)(BK * 2);
    const size_t hstepA = (size_t)HALF * pitA * 2, hstepB = (size_t)HALF * pitB * 2;
    const size_t tstepA = 2 * hstepA, tstepB = 2 * hstepB;
    const unsigned ldsw = (unsigned)wid * 1024u;
    const int aoff = lds_byte(wr * 64 + fr, fq * 8), boff = lds_byte(wc * 32 + fr, fq * 8);
#define PG8_SA(b, h) (((b) * 2 + (h)) * HTB)
#define PG8_SB(b, h) ((4 + (b) * 2 + (h)) * HTB)
#define PG8_STAGE(bufoff, gbase, voff) do { _Pragma("unroll") for (int _i = 0; _i < 2; ++_i) \
        __builtin_amdgcn_global_load_lds((const unsigned*)((const char*)(gbase) + (voff)[_i]), (PG8_LAS unsigned*)(lds + (bufoff) + ldsw + _i * 8192), 16, 0, 0); } while (0)
#define PG8_LDA(dst, b, h) do { _Pragma("unroll") for (int m = 0; m < 4; ++m) _Pragma("unroll") for (int k = 0; k < 2; ++k) dst[m][k] = *(const PG8_LAS bf16x8*)(lds + PG8_SA(b, h) + aoff + m * 2048 + k * 1024); } while (0)
#define PG8_LDB(dst, b, h) do { _Pragma("unroll") for (int n = 0; n < 2; ++n) _Pragma("unroll") for (int k = 0; k < 2; ++k) dst[n][k] = *(const PG8_LAS bf16x8*)(lds + PG8_SB(b, h) + boff + n * 2048 + k * 1024); } while (0)
#define PG8_MMA(ai, bj, At, Bt) do { __builtin_amdgcn_s_setprio(1); _Pragma("unroll") for (int m = 0; m < 4; ++m) _Pragma("unroll") for (int n = 0; n < 2; ++n) _Pragma("unroll") for (int k = 0; k < 2; ++k) \
        acc[ai][bj][m][n] = mma16(Bt[n][k], At[m][k], acc[ai][bj][m][n]); __builtin_amdgcn_s_setprio(0); } while (0)
#define PG8_WAIT_V(n) asm volatile("s_waitcnt vmcnt(" #n ")" ::: "memory")
#define PG8_WAIT_L(n) asm volatile("s_waitcnt lgkmcnt(" #n ")" ::: "memory")
#define PG8_BAR __builtin_amdgcn_s_barrier()
#define PG8_SCHED __builtin_amdgcn_sched_barrier(0)
    Unit cur, nxt; int ui = 0;
    if (!S.next(0, cur)) return;
    typedef typename AccSel<I8>::type acc_t;
    acc_t acc[2][2][4][2];
#pragma unroll
    for (int a = 0; a < 2; ++a)
#pragma unroll
        for (int b = 0; b < 2; ++b)
#pragma unroll
            for (int m = 0; m < 4; ++m)
#pragma unroll
                for (int n = 0; n < 2; ++n) acc[a][b][m][n] = (acc_t){0, 0, 0, 0};
    bf16x8 At[4][2], B0[2][2], B1[2][2];
    const char* cA = (const char*)g.A + (size_t)cur.pm * tstepA + (size_t)(cur.ko / BK) * kstepA; const char* cB = (const char*)g.Bt + (size_t)cur.pn * tstepB + (size_t)(cur.ko / BK) * kstepB;
    S.a_ready(cur);
    if constexpr (SP2) {
        PG8_STAGE(PG8_SB(0, 0), cB, voffB); PG8_STAGE(PG8_SB(0, 1), cB + hstepB, voffB); PG8_STAGE(PG8_SA(0, 0), cA, voffA); PG8_STAGE(PG8_SA(0, 1), cA + hstepA, voffA);
        if (wr == 1) PG8_BAR;
        PG8_WAIT_V(2); PG8_BAR;
        PG8_STAGE(PG8_SB(1, 0), cB + kstepB, voffB); PG8_STAGE(PG8_SA(1, 0), cA + kstepA, voffA); PG8_STAGE(PG8_SB(1, 1), cB + hstepB + kstepB, voffB);
        PG8_WAIT_V(6); PG8_BAR;
    } else {
        PG8_STAGE(PG8_SB(0, 0), cB, voffB); PG8_STAGE(PG8_SA(0, 0), cA, voffA); PG8_STAGE(PG8_SB(0, 1), cB + hstepB, voffB); PG8_STAGE(PG8_SA(0, 1), cA + hstepA, voffA);
        if (wr == 1) PG8_BAR;
        PG8_WAIT_V(4); PG8_BAR;
        PG8_STAGE(PG8_SB(1, 0), cB + kstepB, voffB); PG8_STAGE(PG8_SA(1, 0), cA + kstepA, voffA); PG8_STAGE(PG8_SB(1, 1), cB + hstepB + kstepB, voffB);
        PG8_WAIT_V(6); PG8_BAR;
    }
    for (;;) {
        const bool has_next = S.next(ui + 1, nxt);
        if constexpr (I8) {
            const float* sp_ = tid < 256 ? g.sA + cur.pm * BM + tid : g.sB + cur.pn * BM + (tid - 256);
            __builtin_amdgcn_global_load_lds((const unsigned*)sp_, (PG8_LAS unsigned*)(lds + STAGE_BYTES + (ui & 1) * 2048 + wid * 256), 4, 0, 0); }
        const char* nA = has_next ? (const char*)g.A + (size_t)nxt.pm * tstepA + (size_t)(nxt.ko / BK) * kstepA : cA; const char* nB = has_next ? (const char*)g.Bt + (size_t)nxt.pn * tstepB + (size_t)(nxt.ko / BK) * kstepB : cB;
        for (int t = 0; t < nt; t += 2) {
            const bool last = (t == nt - 2);
            const char* a1 = cA + (size_t)(t + 1) * kstepA;
            const char* a2 = last ? nA : cA + (size_t)(t + 2) * kstepA; const char* b2 = last ? nB : cB + (size_t)(t + 2) * kstepB;
            const char* a3 = a2 + kstepA; const char* b3 = b2 + kstepB;
            if (last && has_next) S.a_ready(nxt);
            if constexpr (SP2) {
            PG8_LDB(B0, 0, 0); PG8_LDB(B1, 0, 1); PG8_SCHED; PG8_LDA(At, 0, 0); PG8_STAGE(PG8_SA(1, 1), a1 + hstepA, voffA);
            PG8_WAIT_V(8); PG8_WAIT_L(0); PG8_BAR; PG8_MMA(0, 0, At, B0); PG8_MMA(0, 1, At, B1); PG8_BAR; PG8_SCHED;
            PG8_LDA(At, 0, 1); PG8_STAGE(PG8_SB(0, 0), b2, voffB); PG8_STAGE(PG8_SB(0, 1), b2 + hstepB, voffB); PG8_STAGE(PG8_SA(0, 0), a2, voffA);
            PG8_WAIT_V(8); PG8_WAIT_L(0); PG8_BAR; PG8_MMA(1, 0, At, B0); PG8_MMA(1, 1, At, B1); PG8_BAR; PG8_SCHED;
            PG8_LDB(B0, 1, 0); PG8_LDB(B1, 1, 1); PG8_SCHED; PG8_LDA(At, 1, 0); PG8_STAGE(PG8_SA(0, 1), a2 + hstepA, voffA);
            PG8_WAIT_V(8); PG8_WAIT_L(0); PG8_BAR; PG8_MMA(0, 0, At, B0); PG8_MMA(0, 1, At, B1); PG8_BAR; PG8_SCHED;
            PG8_LDA(At, 1, 1); PG8_STAGE(PG8_SB(1, 0), b3, voffB); PG8_STAGE(PG8_SB(1, 1), b3 + hstepB, voffB); PG8_STAGE(PG8_SA(1, 0), a3, voffA);
            PG8_WAIT_V(8); PG8_WAIT_L(0); PG8_BAR; PG8_MMA(1, 0, At, B0); PG8_MMA(1, 1, At, B1); PG8_BAR; PG8_SCHED;
            } else {
            PG8_LDB(B0, 0, 0); PG8_SCHED; PG8_LDA(At, 0, 0); PG8_STAGE(PG8_SA(1, 1), a1 + hstepA, voffA);
            PG8_WAIT_L(8); PG8_BAR; PG8_WAIT_L(0); PG8_MMA(0, 0, At, B0); PG8_BAR; PG8_SCHED;
            PG8_LDB(B1, 0, 1); PG8_STAGE(PG8_SB(0, 0), b2, voffB);
            PG8_BAR; PG8_WAIT_L(0); PG8_MMA(0, 1, At, B1); PG8_BAR;
            PG8_LDA(At, 0, 1); PG8_STAGE(PG8_SA(0, 0), a2, voffA);
            PG8_BAR; PG8_WAIT_L(0); PG8_MMA(1, 0, At, B0); PG8_BAR; PG8_SCHED;
            PG8_STAGE(PG8_SB(0, 1), b2 + hstepB, voffB);
            PG8_WAIT_V(6); PG8_BAR; PG8_MMA(1, 1, At, B1); PG8_BAR;
            PG8_LDB(B0, 1, 0); PG8_SCHED; PG8_LDA(At, 1, 0); PG8_STAGE(PG8_SA(0, 1), a2 + hstepA, voffA);
            PG8_WAIT_L(8); PG8_BAR; PG8_WAIT_L(0); PG8_MMA(0, 0, At, B0); PG8_BAR; PG8_SCHED;
            PG8_LDB(B1, 1, 1); PG8_STAGE(PG8_SB(1, 0), b3, voffB);
            PG8_BAR; PG8_WAIT_L(0); PG8_MMA(0, 1, At, B1); PG8_BAR;
            PG8_LDA(At, 1, 1); PG8_STAGE(PG8_SA(1, 0), a3, voffA);
            PG8_BAR; PG8_WAIT_L(0); PG8_MMA(1, 0, At, B0); PG8_BAR; PG8_SCHED;
            PG8_STAGE(PG8_SB(1, 1), b3 + hstepB, voffB);
            PG8_WAIT_V(6); PG8_BAR; PG8_MMA(1, 1, At, B1); PG8_BAR;
            }
        }
        if constexpr (ALIGN_EPI) { if (wr == 0) PG8_BAR; }
        if constexpr (!Epi::AFTER_DRAIN) { if constexpr (I8) { _Pragma("nounroll") for (int er_ = 0; er_ < REP_EPI8; ++er_) { f32x4 facc[2][2][4][2]; dequant<Epi::PERM>(acc, facc, (const PG8_LAS float*)(lds + STAGE_BYTES + (ui & 1) * 2048), wr, wc, fr, fq); E(facc, cur, wr, wc, fr, fq); } } else { E(acc, cur, wr, wc, fr, fq); } S.done(cur); }
        if (!has_next) break;
#pragma unroll
        for (int a = 0; a < 2; ++a)
#pragma unroll
            for (int b = 0; b < 2; ++b)
#pragma unroll
                for (int m = 0; m < 4; ++m)
#pragma unroll
                    for (int n = 0; n < 2; ++n) acc[a][b][m][n] = (acc_t){0, 0, 0, 0};
        cur = nxt; cA = nA; cB = nB; ++ui;
        if constexpr (ALIGN_EPI) { if (wr == 1) PG8_BAR; }
    }
    PG8_WAIT_V(0);
    if constexpr (!ALIGN_EPI) { if (wr == 0) PG8_BAR; }
    PG8_BAR;
    if constexpr (Epi::AFTER_DRAIN) { E.fused(acc, cur, wr, wc, fr, fq, lds, wid, lane); S.done(cur); }
#undef PG8_SA
#undef PG8_SB
#undef PG8_STAGE
#undef PG8_LDA
#undef PG8_LDB
#undef PG8_MMA
#undef PG8_WAIT_V
#undef PG8_WAIT_L
#undef PG8_BAR
#undef PG8_SCHED
}
}
#define GAS __attribute__((address_space(1)))
#define LAS __attribute__((address_space(3)))
typedef unsigned short bf16;
typedef unsigned v4u __attribute__((ext_vector_type(4)));
typedef float f32x4 __attribute__((ext_vector_type(4)));
typedef short bf16x8 __attribute__((ext_vector_type(8)));
typedef GAS unsigned gu32;
typedef GAS unsigned long long gu64;
#define RLX_AGENT __ATOMIC_RELAXED, __HIP_MEMORY_SCOPE_AGENT
#define LDS_WAIT() asm volatile("s_waitcnt lgkmcnt(0)" ::: "memory")
#define VM_WAIT() asm volatile("s_waitcnt vmcnt(0)" ::: "memory")
__device__ __forceinline__ unsigned long long rt() { return __builtin_amdgcn_s_memrealtime(); }
__device__ __forceinline__ unsigned f2bf(float f) { unsigned u = __builtin_bit_cast(unsigned, f); return (u + 0x7fffu + ((u >> 16) & 1u)) >> 16; }
__device__ __forceinline__ unsigned pk2(float lo, float hi) { return f2bf(lo) | (f2bf(hi) << 16); }

#define XB_TMO      128
#define XB_XCNT(j)  (256  + 64 * (j))
#define XB_XSUB(j)  (1280 + 64 * (j))
#define XB_XGEN(j)  (2304 + 64 * (j))
#define XB_TOP      3328
#define XB_TOPGEN   3392
#define XCD_BAR_WORDS 3456
#define XB_SPIN_CAP (1u << 22)

__device__ __forceinline__ unsigned xb_ld(unsigned* p)              { return __hip_atomic_load(p, __ATOMIC_RELAXED, __HIP_MEMORY_SCOPE_AGENT); }
__device__ __forceinline__ unsigned xb_add(unsigned* p, unsigned v) { return __hip_atomic_fetch_add(p, v, __ATOMIC_RELAXED, __HIP_MEMORY_SCOPE_AGENT); }
__device__ __forceinline__ unsigned xb_xcc_id() { return (unsigned)__builtin_amdgcn_s_getreg((3 << 11) | 20) & 0xFu; }
#define XB_SPIN(cond, bar) do { unsigned _sp = 0; while (cond) { __builtin_amdgcn_s_sleep(1); \
    if ((++_sp & 255u) == 0u) { if (xb_ld(&(bar)[XB_TMO])) break; if (_sp > XB_SPIN_CAP) { atomicAdd(&(bar)[XB_TMO], 1u); break; } } } } while (0)

struct XcdBarrier {
    unsigned* bar; unsigned x;
    volatile LAS unsigned* st;
};

__device__ __forceinline__ XcdBarrier xcd_barrier_post(unsigned* bar, volatile LAS unsigned* st) {
    XcdBarrier b; b.bar = bar; b.x = xb_xcc_id(); b.st = st;
    if (threadIdx.x == 0) (void)xb_add(&bar[XB_XCNT(b.x)], 1u);
    return b;
}
__device__ __forceinline__ void xcd_barrier_complete(unsigned* bar, unsigned x, unsigned& nloc, unsigned& nx) {
    const unsigned G = gridDim.x * gridDim.y * gridDim.z;
    unsigned sum, cnt, mine, sp = 0u;
    for (;;) {
        sum = 0u; cnt = 0u; mine = 0u;
#pragma unroll
        for (unsigned j = 0; j < 16; ++j) { const unsigned c = xb_ld(&bar[XB_XCNT(j)]); sum += c; cnt += (c > 0u) ? 1u : 0u; mine = (j == x) ? c : mine; }
        if (sum == G) break;
        __builtin_amdgcn_s_sleep(1);
        if ((++sp & 255u) == 0u) { if (xb_ld(&bar[XB_TMO])) break; if (sp > XB_SPIN_CAP) { atomicAdd(&bar[XB_TMO], 1u); break; } }
    }
    nloc = mine > 0u ? mine : 1u; nx = cnt > 0u ? cnt : 1u;
}

__device__ __forceinline__ void xcd_barrier(const XcdBarrier& b) {
    asm volatile("s_waitcnt vmcnt(0)" ::: "memory");
    __syncthreads();
    if (threadIdx.x == 0) {
        unsigned* bar = b.bar;
        __builtin_amdgcn_s_waitcnt(0);
        unsigned nloc = b.st[0], nx = b.st[1];
        if (nloc == 0u) { xcd_barrier_complete(bar, b.x, nloc, nx); b.st[0] = nloc; b.st[1] = nx; }
        const unsigned old = xb_add(&bar[XB_XSUB(b.x)], 1u);
        const unsigned gen = old / nloc;
        if (old + 1u == (gen + 1u) * nloc) {
            __builtin_amdgcn_fence(__ATOMIC_RELEASE, "agent");
            asm volatile("s_waitcnt vmcnt(0)" ::: "memory");
            const unsigned og = xb_add(&bar[XB_TOP], 1u);
            const unsigned tg = og / nx;
            if (og + 1u == (tg + 1u) * nx) xb_add(&bar[XB_TOPGEN], 1u);
            else XB_SPIN(xb_ld(&bar[XB_TOPGEN]) == tg, bar);
            __builtin_amdgcn_fence(__ATOMIC_ACQUIRE, "agent");
            xb_add(&bar[XB_XGEN(b.x)], 1u);
            asm volatile("s_waitcnt vmcnt(0)" ::: "memory");
        } else {
            XB_SPIN(xb_ld(&bar[XB_XGEN(b.x)]) == gen, bar);
            __builtin_amdgcn_fence(__ATOMIC_ACQUIRE, "agent");
            asm volatile("s_waitcnt vmcnt(0)" ::: "memory");
        }
    }
    __syncthreads();
}

constexpr int NWAVES = 8;
constexpr int GRID = 256;
constexpr int BATCH = 2, T = 8192, D = 1024, M = BATCH * T;
constexpr int HG_H = 8;
constexpr int SB_H = 16, SB_D = 64;
constexpr int FFD = 2816, FFE = 3584, NE = 8;
constexpr int MROWS = 2 * M + NE * 256, MRT = MROWS / 256;
constexpr float EPS = 1e-6f;
constexpr float QSCALE = 0.125f * 1.44269504089f;

constexpr size_t MiB = 1u << 20;
constexpr size_t WS_CTL = 0, CTL_ZERO_BYTES = 1 * MiB;
constexpr size_t WS_TAB = 1 * MiB;
constexpr size_t TAB_LB = WS_TAB, TAB_HIST = WS_TAB + 16384, TAB_TILE = WS_TAB + 32768, TAB_TOKE = WS_TAB + 65536, TAB_TOKG = WS_TAB + 262144, TAB_TOKP = WS_TAB + 524288;
constexpr size_t WS_WIN = 8 * MiB, WS_WOUT = 24 * MiB, WS_WQ = 28 * MiB, WS_WK = 32 * MiB, WS_WV = 34 * MiB, WS_WO = 36 * MiB, WS_WGU = 40 * MiB, WS_WDN = 62 * MiB;
constexpr size_t WS_WMGU = 80 * MiB, WS_WMDN = 192 * MiB, WS_WMDN2 = 80 * MiB;
constexpr size_t WS_WMGU_UNUSED_ = 0;
constexpr size_t WS_XN = 248 * MiB;
constexpr size_t WS_K = 280 * MiB, WS_VT = 312 * MiB;
constexpr size_t WS_S = 344 * MiB;
constexpr size_t WS_QS = WS_S, WS_KK = WS_S + 32 * MiB, WS_VV = WS_S + 64 * MiB, WS_GG = WS_S + 96 * MiB, WS_LF = WS_S + 128 * MiB, WS_OR = WS_S + 192 * MiB, WS_OG = WS_S + 256 * MiB;
constexpr size_t WS_HB = WS_S;
constexpr size_t WS_XP = WS_S, WS_HM = WS_S + 68 * MiB, WS_Y = WS_S + 306 * MiB;
constexpr int MOE_RKS = 2, MOE_RKL = FFE / MOE_RKS;
constexpr size_t WS_Y0 = WS_XP;
constexpr size_t WS_YR = WS_Y, YR_STRIDE = (size_t)NE * 256 * D;
constexpr size_t WS_Q = WS_S, WS_AO = WS_S + 32 * MiB;
constexpr size_t WS_END0 = WS_S + 442 * MiB;
constexpr size_t WS_XQ = WS_XN, WS_SA = WS_XN + 16 * MiB, WS_SAP = WS_XN + 17 * MiB, WS_SB = WS_XN + 18 * MiB, WS_SBM = WS_XN + 19 * MiB;
constexpr size_t WS_XPQ = WS_XP;
constexpr size_t WS_WM8 = WS_END0, WS_W8 = WS_END0 + 56 * MiB;
constexpr int W8_ROWS = (int)((WS_WDN - WS_WIN) / 2048), WM8_ROWS = NE * 2 * FFE;
constexpr size_t WS_END = WS_W8 + 27 * MiB;
static_assert(WS_HM + (size_t)MROWS * FFE * 2 <= WS_Y && WS_YR + (size_t)MOE_RKS * YR_STRIDE * 2 <= WS_END0 && (size_t)W8_ROWS * D <= 27 * MiB && WS_END <= 896 * MiB && WS_XP + (size_t)MROWS * D * 2 <= WS_HM, "MoE scratch map");
static_assert(WS_WDN + (size_t)2 * D * FFD * 2 <= WS_WMGU && WS_WMGU + (size_t)NE * 2 * FFE * D * 2 <= WS_WMDN && WS_WMDN + (size_t)NE * D * FFE * 2 <= WS_XN, "weight map");
constexpr int CW_BAR = 4096;
constexpr int CW_ZTAB = 16384;

constexpr int RING_OFF = 0, RING_BYTES = 131072;
constexpr int LDSCTL_OFF = 135168, MISC_OFF = LDSCTL_OFF + 320;
constexpr int LDS_BYTES = 147456;

struct Args { const float* in[18]; float* out; unsigned char* ws; int ph_lo, ph_hi; };
typedef const __attribute__((address_space(4))) Args* CArgsP;
__device__ __forceinline__ CArgsP kargs() { CArgsP p = (CArgsP)__builtin_amdgcn_kernarg_segment_ptr(); asm volatile("" : "+s"(p)); return p; }
__device__ __forceinline__ int lg(int v) { asm volatile("" : "+s"(v)); return v; }
__device__ __forceinline__ unsigned char* wsbase() { return kargs()->ws; }
typedef float f32x2 __attribute__((ext_vector_type(2)));
struct Frame;
#define PHASE_LOCALS const int blk = lg((int)blockIdx.x); Frame F = F_; { int t_ = F_.tid; asm volatile("" : "+v"(t_)); F.tid = t_; F.lane = t_ & 63; F.wave = lg(F_.wave); F.vcu = lg(F_.vcu); F.G = lg(F_.G); } (void)blk;
struct Frame {
    LAS unsigned char* lds;
    volatile LAS unsigned* MISC;
    int tid, lane, wave;
    int vcu, G;
};

__device__ __forceinline__ float wave_sum(float v) {
#pragma unroll
    for (int o = 1; o < 64; o <<= 1) v += __shfl_xor(v, o);
    return v;
}
__device__ __forceinline__ float bf_lo(unsigned u) { return __uint_as_float(u << 16); }
__device__ __forceinline__ float bf_hi(unsigned u) { return __uint_as_float(u & 0xffff0000u); }
__device__ __forceinline__ float bf2f(bf16 b) { return __uint_as_float((unsigned)b << 16); }
typedef __bf16 bf16x2_t __attribute__((ext_vector_type(2)));
__device__ __forceinline__ unsigned cvtpk(float lo, float hi) { f32x2 v = {lo, hi}; bf16x2_t b = __builtin_convertvector(v, bf16x2_t); return __builtin_bit_cast(unsigned, b); }

struct CItem { const float* W; const float* gain; bf16* WT; int pitch, ldk, k0, drow0, ktm; float scale; };
__device__ __forceinline__ CItem cmat(int r, const float* W, int pitch, int c0, int nc, const float* gain, float scale, bf16* WT, int ldk, int il, int ktm = 0) {
    const int nb = nc / 64, kb = r / nb, n0 = (r % nb) * 64;
    CItem c; c.W = W + c0 + n0; c.gain = gain; c.WT = WT; c.pitch = pitch; c.ldk = ldk; c.k0 = kb * 64; c.scale = scale; c.ktm = ktm;
    c.drow0 = il == 0 ? n0 : (n0 >> 7) * 256 + (il - 1) * 128 + (n0 & 127);
    return c;
}
constexpr int CONV_DENSE_ITEMS = 2 * (256 + 256 + 704), CONV_MOE_PER = 896, CONV_MOE_ITEMS = 8 * CONV_MOE_PER;
__device__ __forceinline__ CItem conv_decode(int it, bool dense, int ml, unsigned char* ws_) {
#define in (kargs()->in)
    int r = it;
    if (dense) {
        if (r < CONV_DENSE_ITEMS) {
#pragma unroll
            for (int l = 0; l < 2; ++l) {
                if (r < 256) return cmat(r, in[6] + (size_t)l * D * D, D, 0, D, nullptr, 1.0f, (bf16*)(ws_ + WS_WOUT) + (size_t)l * D * D, D, 0); r -= 256;
                if (r < 256) return cmat(r, in[10] + (size_t)l * D * D, D, 0, D, nullptr, 1.0f, (bf16*)(ws_ + WS_WO) + (size_t)l * D * D, D, 0); r -= 256;
                if (l == 0) { if (r < 704) return cmat(r, in[12], D, 0, D, nullptr, 1.0f, (bf16*)(ws_ + WS_WDN), FFD, 0, D); r -= 704; }
            }
            return cmat(r, in[12] + (size_t)FFD * D, D, 0, D, nullptr, 1.0f, (bf16*)(ws_ + WS_WDN) + (size_t)D * FFD, FFD, 0, D);
        }
        r -= CONV_DENSE_ITEMS;
    }
    const int e = r / CONV_MOE_PER, loc = r % CONV_MOE_PER; const size_t eo = (size_t)(ml * NE + e) * D * FFE;
    { CItem c = cmat(loc, in[16] + eo, D, 0, D, nullptr, 1.0f, (bf16*)(ws_ + (ml == 0 ? WS_WMDN : WS_WMDN2)), FFE, 0, NE * D); c.drow0 += e * D; return c; }
#undef in
}
__device__ __forceinline__ void conv_load(const CItem& c, int lane, f32x4 (&v)[16]) {
    const float* p = c.W + (size_t)(c.k0 + (lane >> 4)) * c.pitch + 4 * (lane & 15);
#pragma unroll
    for (int i = 0; i < 16; ++i) v[i] = __builtin_nontemporal_load((const GAS f32x4*)(p + (size_t)(4 * i) * c.pitch));
}
__device__ __forceinline__ void conv_store(const CItem& c, int lane, const f32x4 (&v)[16], LAS float* scr) {
    const int kr = lane >> 4, nc4 = 4 * (lane & 15);
#pragma unroll
    for (int i = 0; i < 16; ++i) { const float g = c.gain ? c.gain[c.k0 + 4 * i + kr] * c.scale : c.scale; LAS float* p = scr + (4 * i + kr) * 65 + nc4;
        p[0] = v[i].x * g; p[1] = v[i].y * g; p[2] = v[i].z * g; p[3] = v[i].w * g; }
    LDS_WAIT(); asm volatile("" ::: "memory");
    const int ch = lane & 7;
#pragma unroll
    for (int j = 0; j < 8; ++j) { const int n = (lane >> 3) + 8 * j; const LAS float* s = scr + (8 * ch) * 65 + n;
        v4u o; o.x = pk2(s[0 * 65], s[1 * 65]); o.y = pk2(s[2 * 65], s[3 * 65]); o.z = pk2(s[4 * 65], s[5 * 65]); o.w = pk2(s[6 * 65], s[7 * 65]);
        bf16* dp = c.ktm ? c.WT + ((size_t)(c.k0 >> 6) * c.ktm + (c.drow0 + n)) * 64 + 8 * ch : c.WT + (size_t)(c.drow0 + n) * c.ldk + c.k0 + 8 * ch;
        *(GAS v4u*)dp = o; }
    LDS_WAIT(); asm volatile("" ::: "memory");
}
__device__ __forceinline__ void conv_all(Frame& F_, bool dense, int ml) {
    PHASE_LOCALS
    unsigned char* const ws_ = kargs()->ws;
    LAS float* scr = (LAS float*)(F.lds + RING_OFF + F.wave * 16640);
    const int gw = F.vcu * NWAVES + F.wave, NGW = F.G * NWAVES, n = (dense ? CONV_DENSE_ITEMS : 0) + CONV_MOE_ITEMS;
    int it = gw;
    if (it >= n) return;
    CItem cur = conv_decode(it, dense, ml, ws_); f32x4 v[16]; conv_load(cur, F.lane, v);
    for (;;) {
        const int itn = it + NGW; const bool more = itn < n;
        CItem nxt = cur; f32x4 vn[16];
        if (more) { nxt = conv_decode(itn, dense, ml, ws_); conv_load(nxt, F.lane, vn); }
        conv_store(cur, F.lane, v, scr);
        if (!more) break;
        cur = nxt; it = itn;
#pragma unroll
        for (int i = 0; i < 16; ++i) v[i] = vn[i];
    }
}

__device__ __forceinline__ void conv_one_moe_down(int item, int ml, unsigned char* ws_, LAS unsigned char* ldsb, int wave, int lane) {
    const CItem c = conv_decode(item, false, ml, ws_); f32x4 v[16]; conv_load(c, lane, v);
    conv_store(c, lane, v, (LAS float*)(ldsb + wave * 16640));
}
__device__ __forceinline__ void store_xn(bf16* XN, int m, int lane, const f32x4 (&v)[4], float rstd) {
    GAS unsigned long long* o8 = (GAS unsigned long long*)(XN + (size_t)m * D) + lane;
#pragma unroll
    for (int j = 0; j < 4; ++j) o8[64 * j] = (unsigned long long)pk2(v[j].x * rstd, v[j].y * rstd) | ((unsigned long long)pk2(v[j].z * rstd, v[j].w * rstd) << 32);
}
__device__ __forceinline__ void store_xq(unsigned char* ws_, int m, int lane, const f32x4 (&v)[4], float rstd) {
    float am = 0.f;
#pragma unroll
    for (int j = 0; j < 4; ++j) am = fmaxf(fmaxf(am, fmaxf(fabsf(v[j].x), fabsf(v[j].y))), fmaxf(fabsf(v[j].z), fabsf(v[j].w)));
#pragma unroll
    for (int o = 1; o < 64; o <<= 1) am = fmaxf(am, __shfl_xor(am, o));
    am *= rstd;
    const float inv = am > 0.f ? 127.0f / am : 0.f, k = rstd * inv;
    GAS unsigned* o4 = (GAS unsigned*)(ws_ + WS_XQ + (size_t)m * D) + lane;
#pragma unroll
    for (int j = 0; j < 4; ++j) { const int a = (int)rintf(v[j].x * k), b = (int)rintf(v[j].y * k), c = (int)rintf(v[j].z * k), d = (int)rintf(v[j].w * k);
        o4[64 * j] = (unsigned)(a & 255) | ((unsigned)(b & 255) << 8) | ((unsigned)(c & 255) << 16) | ((unsigned)(d & 255) << 24); }
    if (lane == 0) ((GAS float*)(ws_ + WS_SA))[m] = am * (1.0f / 127.0f);
}
struct C8Item { const float* W; const float* gain; unsigned char* D8; float* SBp; int pitch; float scale; };
__device__ __forceinline__ C8Item c8mat(int r, const float* W, int pitch, int c0, const float* gain, float scale, unsigned char* W8base, float* SBbase, int row0, int il) {
    const int n0 = r * 64, drow = row0 + (il == 0 ? n0 : (n0 >> 7) * 256 + (il - 1) * 128 + (n0 & 127));
    C8Item c; c.W = W + c0 + n0; c.gain = gain; c.pitch = pitch; c.scale = scale; c.D8 = W8base + (size_t)drow * D; c.SBp = SBbase + drow; return c;
}
constexpr int C8_DENSE_ITEMS = 2 * (64 + 16 + 44 + 44) + 16 + 16, C8_MOE_ITEMS = 16 * 56;
constexpr int R_WIN = 0, R_WQ = (int)((WS_WQ - WS_WIN) / 2048), R_WK = (int)((WS_WK - WS_WIN) / 2048), R_WV = (int)((WS_WV - WS_WIN) / 2048), R_WGU = (int)((WS_WGU - WS_WIN) / 2048);
__device__ __forceinline__ C8Item conv8_decode(int it, bool dense, int ml, unsigned char* ws_) {
#define in (kargs()->in)
    int r = it; unsigned char* W8 = ws_ + WS_W8; float* SBd = (float*)(ws_ + WS_SB);
    if (dense) {
        if (r < C8_DENSE_ITEMS) {
#pragma unroll
            for (int l = 0; l < 2; ++l) {
                if (r < 64) return c8mat(r, in[3] + (size_t)l * D * 4 * D, 4 * D, 0, in[1] + l * D, 1.0f, W8, SBd, R_WIN + l * 4 * D, 0); r -= 64;
                if (r < 16) return c8mat(r, in[9] + (size_t)l * D * D, D, 0, in[1] + (2 + l) * D, QSCALE, W8, SBd, R_WQ + l * D, 0); r -= 16;
                if (r < 44) return c8mat(r, in[11] + (size_t)l * D * 2 * FFD, 2 * FFD, 0, in[2] + (2 * l) * D, 1.0f, W8, SBd, R_WGU + l * 2 * FFD, 1); r -= 44;
                if (r < 44) return c8mat(r, in[11] + (size_t)l * D * 2 * FFD, 2 * FFD, FFD, in[2] + (2 * l) * D, 1.0f, W8, SBd, R_WGU + l * 2 * FFD, 2); r -= 44;
            }
            if (r < 16) return c8mat(r, in[8], 2 * D, 0, in[7], 1.0f, W8, SBd, R_WK, 0); r -= 16;
            return c8mat(r, in[8], 2 * D, D, in[7], 1.0f, W8, SBd, R_WV, 0);
        }
        r -= C8_DENSE_ITEMS;
    }
    const int q = r / 56, loc = r % 56, ty = q >> 3, e = q & 7;
    return c8mat(loc, in[14 + ty] + (size_t)(ml * NE + e) * D * FFE, FFE, 0, in[2] + (2 * ml + 1) * D, 1.0f, ws_ + WS_WM8, (float*)(ws_ + WS_SBM), e * 2 * FFE, 1 + ty);
#undef in
}
__device__ __forceinline__ void conv8_all(Frame& F_, bool dense, int ml) {
    PHASE_LOCALS
    unsigned char* const ws_ = kargs()->ws;
    LAS bf16* TT = (LAS bf16*)(F.lds + RING_OFF);
    LAS float* CM = (LAS float*)(F.lds + RING_OFF + 132096);
    LAS float* CMX = CM + 512;
    const int n8 = (dense ? C8_DENSE_ITEMS : 0) + C8_MOE_ITEMS, lane = F.lane, kr = lane >> 4, nc4 = 4 * (lane & 15), kb = 128 * F.wave;
    for (int it = F.vcu; it < n8; it += F.G) {
        const C8Item c = conv8_decode(it, dense, ml, ws_);
        float cm0 = 0.f, cm1 = 0.f, cm2 = 0.f, cm3 = 0.f;
#pragma nounroll
        for (int hf = 0; hf < 2; ++hf) {
            f32x4 v[16];
            { const float* p0 = c.W + (size_t)(kb + 64 * hf + kr) * c.pitch + nc4; const size_t st = (size_t)4 * c.pitch;
#pragma unroll
            for (int i = 0; i < 16; ++i) v[i] = __builtin_nontemporal_load((const GAS f32x4*)(p0 + i * st)); }
#pragma unroll
            for (int i = 0; i < 16; ++i) { const int k = kb + 64 * hf + 4 * i + kr; const float g = c.gain ? c.gain[k] * c.scale : c.scale;
                const unsigned b0 = f2bf(v[i].x * g), b1 = f2bf(v[i].y * g), b2 = f2bf(v[i].z * g), b3 = f2bf(v[i].w * g);
                cm0 = fmaxf(cm0, fabsf(__uint_as_float(b0 << 16))); cm1 = fmaxf(cm1, fabsf(__uint_as_float(b1 << 16))); cm2 = fmaxf(cm2, fabsf(__uint_as_float(b2 << 16))); cm3 = fmaxf(cm3, fabsf(__uint_as_float(b3 << 16)));
                TT[(nc4 + 0) * 1032 + k] = (bf16)b0; TT[(nc4 + 1) * 1032 + k] = (bf16)b1; TT[(nc4 + 2) * 1032 + k] = (bf16)b2; TT[(nc4 + 3) * 1032 + k] = (bf16)b3; }
        }
        cm0 = fmaxf(cm0, __shfl_xor(cm0, 16)); cm0 = fmaxf(cm0, __shfl_xor(cm0, 32)); cm1 = fmaxf(cm1, __shfl_xor(cm1, 16)); cm1 = fmaxf(cm1, __shfl_xor(cm1, 32));
        cm2 = fmaxf(cm2, __shfl_xor(cm2, 16)); cm2 = fmaxf(cm2, __shfl_xor(cm2, 32)); cm3 = fmaxf(cm3, __shfl_xor(cm3, 16)); cm3 = fmaxf(cm3, __shfl_xor(cm3, 32));
        if (lane < 16) { LAS float* p = CM + F.wave * 64 + nc4; p[0] = cm0; p[1] = cm1; p[2] = cm2; p[3] = cm3; }
        __syncthreads();
        if (F.tid < 64) { float m = 0.f;
#pragma unroll
            for (int w = 0; w < 8; ++w) m = fmaxf(m, CM[w * 64 + F.tid]);
            CMX[F.tid] = m; c.SBp[F.tid] = m * (1.0f / 127.0f); }
        __syncthreads();
#pragma unroll 2
        for (int j = 0; j < 8; ++j) { const int idx = j * 512 + F.tid, n = idx >> 6, ch = idx & 63; const float m = CMX[n], inv = m > 0.f ? 127.0f / m : 0.f;
            const v4u a = *(const LAS v4u*)(TT + n * 1032 + 16 * ch), b = *(const LAS v4u*)(TT + n * 1032 + 16 * ch + 8);
            const unsigned wv[8] = {a.x, a.y, a.z, a.w, b.x, b.y, b.z, b.w}; unsigned q[4];
#pragma unroll
            for (int t = 0; t < 4; ++t) { const int q0 = (int)rintf(bf_lo(wv[2 * t]) * inv), q1 = (int)rintf(bf_hi(wv[2 * t]) * inv), q2 = (int)rintf(bf_lo(wv[2 * t + 1]) * inv), q3 = (int)rintf(bf_hi(wv[2 * t + 1]) * inv);
                q[t] = (unsigned)(q0 & 255) | ((unsigned)(q1 & 255) << 8) | ((unsigned)(q2 & 255) << 16) | ((unsigned)(q3 & 255) << 24); }
            *(GAS v4u*)(c.D8 + (size_t)n * D + 16 * ch) = (v4u){q[0], q[1], q[2], q[3]}; }
        __syncthreads();
    }
}
__device__ __forceinline__ float row_rstd(const f32x4 (&v)[4]) {
    float s = 0.f;
#pragma unroll
    for (int j = 0; j < 4; ++j) s += (v[j].x * v[j].x + v[j].y * v[j].y) + (v[j].z * v[j].z + v[j].w * v[j].w);
    return 1.0f / sqrtf(wave_sum(s) * (1.0f / D) + EPS);
}
__device__ __forceinline__ void norm_phase(Frame& F_, const float* X, bool route, const float* router  , const float* rgain  ) {
    PHASE_LOCALS
    unsigned char* const ws_ = kargs()->ws;
    LAS float* RGT = (LAS float*)(F.lds + RING_OFF);
    LAS int* hist = (LAS int*)(F.lds + RING_OFF + 32768);
    if (route) {
        for (int i = F.tid; i < D * NE; i += NWAVES * 64) { const int k = i >> 3, e = i & 7; RGT[e * D + k] = router[i] * rgain[k]; }
        if (F.tid < NE) hist[F.tid] = 0;
        __syncthreads();
    }
#pragma nounroll
    for (int i4 = 0; i4 < 8; i4 += 4) {
        f32x4 vv[4][4];
#pragma unroll
        for (int t = 0; t < 4; ++t) { const GAS f32x4* xr = (const GAS f32x4*)(X + (size_t)(blk * 64 + F.wave * 8 + i4 + t) * D) + F.lane;
#pragma unroll
            for (int j = 0; j < 4; ++j) vv[t][j] = xr[64 * j]; }
        __builtin_amdgcn_sched_barrier(0);
#pragma unroll
        for (int t = 0; t < 4; ++t) {
        const int m = blk * 64 + F.wave * 8 + i4 + t;
        f32x4 (&v)[4] = vv[t];
        const float rstd = row_rstd(v);
        store_xq(ws_, m, F.lane, v, rstd);
        if (route) {
            float lg[NE];
#pragma unroll
            for (int e = 0; e < NE; ++e) { float s = 0.f;
#pragma unroll
                for (int j = 0; j < 4; ++j) { const f32x4 r = *(const LAS f32x4*)(RGT + e * D + 4 * F.lane + 256 * j); s += (v[j].x * r.x + v[j].y * r.y) + (v[j].z * r.z + v[j].w * r.w); }
                lg[e] = wave_sum(s) * rstd; }
            float b0 = -3.0e38f, b1 = -3.0e38f; int i0 = 0, i1 = 0;
#pragma unroll
            for (int e = 0; e < NE; ++e) { if (lg[e] > b0) { b1 = b0; i1 = i0; b0 = lg[e]; i0 = e; } else if (lg[e] > b1) { b1 = lg[e]; i1 = e; } }
            if (F.lane == 0) { const float ex = __expf(b1 - b0), g0 = 1.0f / (1.0f + ex);
                ((GAS int*)(ws_ + TAB_TOKE))[2 * m] = i0; ((GAS int*)(ws_ + TAB_TOKE))[2 * m + 1] = i1;
                ((GAS float*)(ws_ + TAB_TOKG))[2 * m] = g0; ((GAS float*)(ws_ + TAB_TOKG))[2 * m + 1] = ex * g0;
                atomicAdd((int*)(hist + i0), 1); atomicAdd((int*)(hist + i1), 1); }
        }
        }
    }
    if (route) { __syncthreads(); if (F.tid < NE) ((GAS int*)(ws_ + TAB_HIST))[blk * NE + F.tid] = hist[F.tid]; }
}
__device__ __forceinline__ void scatter_phase(Frame& F_) {
    PHASE_LOCALS
    unsigned char* const ws_ = kargs()->ws;
    LAS int* h = (LAS int*)(F.lds + RING_OFF);
    LAS int* pre = h + 2048; LAS int* tot = pre + 8; LAS int* pst = tot + 8; LAS int* pos = pst + 16;
    const GAS int* HIST = (const GAS int*)(ws_ + TAB_HIST);
    for (int i = F.tid; i < GRID * NE; i += NWAVES * 64) h[i] = HIST[i];
    __syncthreads();
    if (F.tid < NE) { int p = 0, t = 0; for (int b = 0; b < GRID; ++b) { const int v = h[b * NE + F.tid]; p += (b < blk) ? v : 0; t += v; } pre[F.tid] = p; tot[F.tid] = t; }
    __syncthreads();
    if (F.tid == 0) { int s = 0; for (int e = 0; e < NE; ++e) { pst[e] = s; s += (tot[e] + 255) & ~255; } pst[NE] = s; }
    __syncthreads();
    if (F.wave == 0) {
        const int m = blk * 64 + F.lane;
        const int e0 = ((const GAS int*)(ws_ + TAB_TOKE))[2 * m], e1 = ((const GAS int*)(ws_ + TAB_TOKE))[2 * m + 1];
        int p0 = 0, p1 = 0; const unsigned long long lt = (1ull << F.lane) - 1ull;
#pragma unroll
        for (int e = 0; e < NE; ++e) { const unsigned long long mk = __ballot(e0 == e || e1 == e); const int rk = __popcll(mk & lt) + pst[e] + pre[e];
            if (e0 == e) p0 = rk; if (e1 == e) p1 = rk; }
        ((GAS int*)(ws_ + TAB_TOKP))[2 * m] = p0; ((GAS int*)(ws_ + TAB_TOKP))[2 * m + 1] = p1;
        pos[2 * F.lane] = p0; pos[2 * F.lane + 1] = p1;
    }
    if (blk == 0) { GAS int* TE = (GAS int*)(ws_ + TAB_TILE);
        LAS unsigned long long* wm = (LAS unsigned long long*)(pos + 128);
        const int nrt = pst[NE] >> 8, rt = F.tid;
        int e = NE - 1; bool full = false;
        if (rt < nrt) {
#pragma unroll
            for (int q = NE - 1; q >= 0; --q) if (rt * 256 < pst[q + 1]) e = q;
            TE[rt] = e; full = (rt + 1) * 256 <= pst[e] + tot[e]; }
        const unsigned long long bm = __ballot(full);
        if (F.lane == 0 && F.wave < 3) wm[F.wave] = bm;
        __syncthreads();
        if (rt < nrt) { int nfb = __popcll(bm & ((1ull << F.lane) - 1ull)); if (F.wave > 0) nfb += __popcll(wm[0]); if (F.wave > 1) nfb += __popcll(wm[1]);
            if (full) { TE[176 + nfb] = rt; TE[384 + rt] = -1; } else { TE[352 + rt - nfb] = rt; TE[384 + rt] = rt - nfb; }
            if (rt == nrt - 1) { const int nf = nfb + (full ? 1 : 0); TE[160] = nrt; TE[336] = nf; TE[368] = nrt - nf; } }
    }
    __syncthreads();
    const unsigned char* XQ = ws_ + WS_XQ; unsigned char* XPQ = ws_ + WS_XPQ;
    for (int i = 0; i < 8; ++i) { const int tl = F.wave * 8 + i, m = blk * 64 + tl, d0 = pos[2 * tl], d1 = pos[2 * tl + 1];
        const v4u a = *((const GAS v4u*)(XQ + (size_t)m * D) + F.lane);
        *((GAS v4u*)(XPQ + (size_t)d0 * D) + F.lane) = a; *((GAS v4u*)(XPQ + (size_t)d1 * D) + F.lane) = a;
        if (F.lane == 0) { const float sc = ((const GAS float*)(ws_ + WS_SA))[m]; ((GAS float*)(ws_ + WS_SAP))[d0] = sc; ((GAS float*)(ws_ + WS_SAP))[d1] = sc; } }
}
__device__ __forceinline__ void add_y(f32x4 (&a)[4], const unsigned char* ws_, int p, int j, int lane) {
    if (j < 0) { const GAS unsigned long long* y = (const GAS unsigned long long*)((const bf16*)(ws_ + WS_Y0) + (size_t)p * D) + lane;
#pragma unroll
        for (int c = 0; c < 4; ++c) { const unsigned long long w = y[64 * c]; a[c] = (f32x4){bf_lo((unsigned)w), bf_hi((unsigned)w), bf_lo((unsigned)(w >> 32)), bf_hi((unsigned)(w >> 32))}; } }
    else {
#pragma unroll
        for (int c = 0; c < 4; ++c) a[c] = (f32x4){0.f, 0.f, 0.f, 0.f};
#pragma unroll
        for (int k = 0; k < MOE_RKS; ++k) { const GAS unsigned long long* y = (const GAS unsigned long long*)((const bf16*)(ws_ + WS_YR) + (size_t)k * YR_STRIDE + (size_t)(j * 256 + (p & 255)) * D) + lane;
#pragma unroll
            for (int c = 0; c < 4; ++c) { const unsigned long long w = y[64 * c]; a[c] += (f32x4){bf_lo((unsigned)w), bf_hi((unsigned)w), bf_lo((unsigned)(w >> 32)), bf_hi((unsigned)(w >> 32))}; } } }
}
__device__ __forceinline__ void combine_phase(Frame& F_, float* X, bool last, const float* fgain) {
    PHASE_LOCALS
    unsigned char* const ws_ = kargs()->ws;
    int pp0 = 0, pp1 = 0, jj0 = -1, jj1 = -1; float gg0 = 0.f, gg1 = 0.f;
    if (F.lane < 8) { const int ml = blk * 64 + F.wave * 8 + F.lane;
        pp0 = ((const GAS int*)(ws_ + TAB_TOKP))[2 * ml]; pp1 = ((const GAS int*)(ws_ + TAB_TOKP))[2 * ml + 1];
        gg0 = ((const GAS float*)(ws_ + TAB_TOKG))[2 * ml]; gg1 = ((const GAS float*)(ws_ + TAB_TOKG))[2 * ml + 1];
        jj0 = ((const GAS int*)(ws_ + TAB_TILE))[384 + (pp0 >> 8)]; jj1 = ((const GAS int*)(ws_ + TAB_TILE))[384 + (pp1 >> 8)]; }
    for (int i = 0; i < 8; ++i) {
        const int m = blk * 64 + F.wave * 8 + i;
        const int p0 = __shfl(pp0, i), p1 = __shfl(pp1, i), j0 = __shfl(jj0, i), j1 = __shfl(jj1, i);
        const float g0 = __shfl(gg0, i), g1 = __shfl(gg1, i);
        GAS f32x4* xr = (GAS f32x4*)(X + (size_t)m * D) + F.lane;
        f32x4 v[4], a0[4], a1[4];
#pragma unroll
        for (int j = 0; j < 4; ++j) v[j] = xr[64 * j];
        add_y(a0, ws_, __builtin_amdgcn_readfirstlane(p0), __builtin_amdgcn_readfirstlane(j0), F.lane); add_y(a1, ws_, __builtin_amdgcn_readfirstlane(p1), __builtin_amdgcn_readfirstlane(j1), F.lane);
#pragma unroll
        for (int j = 0; j < 4; ++j) v[j] = v[j] + g0 * a0[j] + g1 * a1[j];
        const float rstd = row_rstd(v);
        if (last) {
#pragma unroll
            for (int j = 0; j < 4; ++j) { const f32x4 g = *((const GAS f32x4*)fgain + F.lane + 64 * j); xr[64 * j] = v[j] * rstd * g; }
        } else {
#pragma unroll
            for (int j = 0; j < 4; ++j) xr[64 * j] = v[j];
            store_xq(ws_, m, F.lane, v, rstd);
        }
    }
}

#define MFMA16(a, b, c) __builtin_amdgcn_mfma_f32_16x16x32_bf16((a), (b), (c), 0, 0, 0)
constexpr int HL_QH = 0, HL_KH = 17408, HL_KHT = 34816, HL_VT = 53248, HL_AS = 71680, HL_SPT = 80896, HL_QT = 115712, HL_EGM = 117760, HL_EGL = 118272, HL_PART = 118784;
constexpr size_t WS_LS = WS_OR, WS_SI = WS_OR + 16 * MiB, WS_GS = WS_OR + 32 * MiB;
template <int MODE> __device__ __forceinline__ void hgrn_chunks(Frame& F_, const float* gnorm) {
    PHASE_LOCALS
    unsigned char* const ws_ = kargs()->ws;
    const bf16* QS = (const bf16*)(ws_ + WS_QS); const bf16* VV = (const bf16*)(ws_ + WS_VV); const bf16* GG = (const bf16*)(ws_ + WS_GG);
    const _Float16* LF = (const _Float16*)(ws_ + WS_LF); bf16* OG = (bf16*)(ws_ + WS_OG);
    const int u = blk, bh = u >> 4, sc = u & 15, b = bh >> 3, h = bh & 7;
    const int tid = F.tid, lane = F.lane, w = F.wave, l15 = lane & 15, q = lane >> 4, d = tid & 127, tq = tid >> 7;
    LAS unsigned char* lds = F.lds + RING_OFF;
    LAS bf16* QH = (LAS bf16*)(lds + HL_QH); LAS bf16* KH = (LAS bf16*)(lds + HL_KH); LAS bf16* KHT = (LAS bf16*)(lds + HL_KHT); LAS bf16* VT = (LAS bf16*)(lds + HL_VT);
    LAS bf16* AS = (LAS bf16*)(lds + HL_AS); LAS bf16* SPT = (LAS bf16*)(lds + HL_SPT);
    LAS float* QT = (LAS float*)(lds + HL_QT); LAS float* EGM = (LAS float*)(lds + HL_EGM); LAS float* EGL = (LAS float*)(lds + HL_EGL); LAS float* PART = (LAS float*)(lds + HL_PART);
    if (MODE == 1) { for (int i = tid; i < 9216 / 4; i += NWAVES * 64) ((LAS unsigned*)AS)[i] = 0u; }
    f32x4 U[8];
    if (MODE == 1) { const float* si = (const float*)(ws_ + WS_SI) + (size_t)u * 16384 + 16 * w + l15;
#pragma unroll
        for (int dt = 0; dt < 8; ++dt)
#pragma unroll
            for (int rg = 0; rg < 4; ++rg) U[dt][rg] = si[(16 * dt + 4 * q + rg) * 128]; }
    else {
#pragma unroll
        for (int dt = 0; dt < 8; ++dt) U[dt] = (f32x4){0.f, 0.f, 0.f, 0.f}; }
    float gsum = 0.f;
    const float gn = (MODE == 1) ? gnorm[16 * w + l15] : 0.f;
    const size_t row0 = (size_t)b * T + (size_t)sc * 512;
    bf16 rq[16], rv[16]; _Float16 rl[16];
    { const size_t base = (row0 + 16 * tq) * D + h * 128 + d;
#pragma unroll
        for (int i = 0; i < 16; ++i) { const size_t off = base + (size_t)i * D; rq[i] = (MODE == 1) ? QS[off] : (bf16)0; rv[i] = VV[off]; rl[i] = LF[off]; } }
#pragma nounroll
    for (int c = 0; c < 8; ++c) {
        float qv[16], kv[16], vv[16], g[16];
#pragma unroll
        for (int i = 0; i < 16; ++i) { qv[i] = (MODE == 1) ? bf2f(rq[i]) : 0.f; vv[i] = bf2f(rv[i]); g[i] = (float)rl[i]; kv[i] = 1.0f - __expf(g[i]); }
        { const int cn = c < 7 ? c + 1 : 7; const size_t base = (row0 + cn * 64 + 16 * tq) * D + h * 128 + d;
#pragma unroll
            for (int i = 0; i < 16; ++i) { const size_t off = base + (size_t)i * D; if (MODE == 1) rq[i] = QS[off]; rv[i] = VV[off]; rl[i] = LF[off]; } }
        bf16 rg_[16];
        if (MODE == 1) {
#pragma unroll
            for (int ti = 0; ti < 4; ++ti)
#pragma unroll
                for (int rg = 0; rg < 4; ++rg) rg_[4 * ti + rg] = GG[(row0 + c * 64 + 16 * ti + 4 * q + rg) * D + h * 128 + 16 * w + l15]; }
        __builtin_amdgcn_sched_barrier(0);
#pragma unroll
        for (int i = 1; i < 16; ++i) g[i] += g[i - 1];
        QT[tq * 128 + d] = g[15];
        __syncthreads();
        { const float t0 = QT[d], t1 = QT[128 + d], t2 = QT[256 + d], t3 = QT[384 + d];
            const float basev = tq == 0 ? 0.f : (tq == 1 ? t0 : (tq == 2 ? t0 + t1 : t0 + t1 + t2));
            const float Gm = t0 + t1, Gl = (t0 + t1) + (t2 + t3), ref = (MODE == 1) ? Gm : Gl;
            unsigned kp[8], vp[8];
#pragma unroll
            for (int i = 0; i < 16; i += 2) {
                const float G0 = basev + g[i], G1 = basev + g[i + 1];
                const float kh0 = kv[i] * __expf(fminf(ref - G0, 80.f)), kh1 = kv[i + 1] * __expf(fminf(ref - G1, 80.f));
                kp[i >> 1] = cvtpk(kh0, kh1); vp[i >> 1] = cvtpk(vv[i], vv[i + 1]);
                if (MODE == 1) { const float qh0 = qv[i] * __expf(fminf(G0 - ref, 80.f)), qh1 = qv[i + 1] * __expf(fminf(G1 - ref, 80.f));
                    const unsigned qp = cvtpk(qh0, qh1); QH[(16 * tq + i) * 136 + d] = (bf16)(qp & 0xffffu); QH[(16 * tq + i + 1) * 136 + d] = (bf16)(qp >> 16);
                    KH[(16 * tq + i) * 136 + d] = (bf16)(kp[i >> 1] & 0xffffu); KH[(16 * tq + i + 1) * 136 + d] = (bf16)(kp[i >> 1] >> 16); } }
            *(LAS v4u*)(KHT + d * 72 + 16 * tq) = (v4u){kp[0], kp[1], kp[2], kp[3]}; *(LAS v4u*)(KHT + d * 72 + 16 * tq + 8) = (v4u){kp[4], kp[5], kp[6], kp[7]};
            *(LAS v4u*)(VT + d * 72 + 16 * tq) = (v4u){vp[0], vp[1], vp[2], vp[3]}; *(LAS v4u*)(VT + d * 72 + 16 * tq + 8) = (v4u){vp[4], vp[5], vp[6], vp[7]};
            if (tq == 0) { if (MODE == 1) { EGM[d] = __expf(Gm); EGL[d] = __expf(Gl - Gm); } else { EGL[d] = __expf(Gl); gsum += Gl; } } }
        __syncthreads();
        if (MODE == 1) for (int rb_ = 0; rb_ < REP_HCB; ++rb_) {
            for (int tix = w; tix < 10; tix += 8) { const int ti = tix >= 6 ? 3 : (tix >= 3 ? 2 : (tix >= 1 ? 1 : 0)), si = tix - ti * (ti + 1) / 2;
                f32x4 a = (f32x4){0.f, 0.f, 0.f, 0.f};
#pragma unroll
                for (int ks = 0; ks < 4; ++ks) a = MFMA16(*(const LAS bf16x8*)(QH + (16 * ti + l15) * 136 + 32 * ks + 8 * q), *(const LAS bf16x8*)(KH + (16 * si + l15) * 136 + 32 * ks + 8 * q), a);
#pragma unroll
                for (int rg = 0; rg < 4; ++rg) { const int t = 16 * ti + 4 * q + rg, sI = 16 * si + l15; AS[t * 72 + sI] = (bf16)(cvtpk(sI <= t ? a[rg] : 0.f, 0.f) & 0xffffu); } }
#pragma unroll
            for (int dt = 0; dt < 8; ++dt) { const f32x4 eg = *(const LAS f32x4*)(EGM + 16 * dt + 4 * q); if (rb_ == 0) U[dt] = U[dt] * eg;
                *(LAS unsigned long long*)(SPT + (16 * w + l15) * 136 + 16 * dt + 4 * q) = (unsigned long long)cvtpk(U[dt][0], U[dt][1]) | ((unsigned long long)cvtpk(U[dt][2], U[dt][3]) << 32); }
            __syncthreads();
        }
        bf16x8 Vf[2];
#pragma unroll
        for (int kk = 0; kk < 2; ++kk) Vf[kk] = *(const LAS bf16x8*)(VT + (16 * w + l15) * 72 + 32 * kk + 8 * q);
        if (MODE == 1) for (int rc_ = 0; rc_ < REP_HCC; ++rc_) { if (rc_) __syncthreads();
            bf16x8 Sf[4];
#pragma unroll
            for (int ks = 0; ks < 4; ++ks) Sf[ks] = *(const LAS bf16x8*)(SPT + (16 * w + l15) * 136 + 32 * ks + 8 * q);
            f32x4 o[4];
#pragma unroll
            for (int ti = 0; ti < 4; ++ti) { f32x4 a = (f32x4){0.f, 0.f, 0.f, 0.f};
#pragma unroll
                for (int kk = 0; kk < 2; ++kk) if (kk <= (ti >> 1)) a = MFMA16(*(const LAS bf16x8*)(AS + (16 * ti + l15) * 72 + 32 * kk + 8 * q), Vf[kk], a);
#pragma unroll
                for (int ks = 0; ks < 4; ++ks) a = MFMA16(*(const LAS bf16x8*)(QH + (16 * ti + l15) * 136 + 32 * ks + 8 * q), Sf[ks], a);
                o[ti] = a; }
#pragma unroll
            for (int ti = 0; ti < 4; ++ti)
#pragma unroll
                for (int rg = 0; rg < 4; ++rg) { float p = o[ti][rg] * o[ti][rg]; p += __shfl_xor(p, 1); p += __shfl_xor(p, 2); p += __shfl_xor(p, 4); p += __shfl_xor(p, 8);
                    if (l15 == 0) PART[w * 64 + 16 * ti + 4 * q + rg] = p; }
            __syncthreads();
#pragma unroll
            for (int ti = 0; ti < 4; ++ti)
#pragma unroll
                for (int rg = 0; rg < 4; ++rg) { const int t = 16 * ti + 4 * q + rg; float ss = 0.f;
#pragma unroll
                    for (int ww = 0; ww < 8; ++ww) ss += PART[ww * 64 + t];
                    const float rs = __builtin_amdgcn_rsqf(ss * (1.0f / 128.0f) + EPS);
                    const size_t off = (row0 + c * 64 + t) * D + h * 128 + 16 * w + l15;
                    OG[off] = (bf16)(cvtpk(o[ti][rg] * rs * gn * bf2f(rg_[4 * ti + rg]), 0.f) & 0xffffu); }
        }
        if (MODE == 0) {
#pragma unroll
            for (int dt = 0; dt < 8; ++dt) U[dt] = U[dt] * *(const LAS f32x4*)(EGL + 16 * dt + 4 * q); }
#pragma unroll
        for (int dt = 0; dt < 8; ++dt)
#pragma unroll
            for (int kk = 0; kk < 2; ++kk) U[dt] = MFMA16(*(const LAS bf16x8*)(KHT + (16 * dt + l15) * 72 + 32 * kk + 8 * q), Vf[kk], U[dt]);
        if (MODE == 1) {
#pragma unroll
            for (int dt = 0; dt < 8; ++dt) U[dt] = U[dt] * *(const LAS f32x4*)(EGL + 16 * dt + 4 * q); }
    }
    if (MODE == 0) { float* ls = (float*)(ws_ + WS_LS) + (size_t)u * 16384 + 16 * w + l15;
#pragma unroll
        for (int dt = 0; dt < 8; ++dt)
#pragma unroll
            for (int rg = 0; rg < 4; ++rg) ls[(16 * dt + 4 * q + rg) * 128] = U[dt][rg];
        if (tq == 0) ((float*)(ws_ + WS_GS))[u * 128 + d] = gsum; }
    __syncthreads();
}
__device__ __forceinline__ void hgrn_scan(Frame& F_) {
    PHASE_LOCALS
    unsigned char* const ws_ = kargs()->ws;
    const float* LS = (const float*)(ws_ + WS_LS); const float* GS = (const float*)(ws_ + WS_GS); float* SI = (float*)(ws_ + WS_SI);
    const int x = (blk * NWAVES * 64 + F.tid) * 2, bh = x >> 14, de = x & 16383, dd = de >> 7;
    f32x2 S = (f32x2){0.f, 0.f};
#pragma unroll
    for (int sc = 0; sc < 16; ++sc) { const int u = bh * 16 + sc;
        *(GAS f32x2*)(SI + (size_t)u * 16384 + de) = S;
        const float dec = __expf(GS[u * 128 + dd]); const f32x2 ls = *(const GAS f32x2*)(LS + (size_t)u * 16384 + de);
        S = dec * S + ls; }
}
typedef float f32x16 __attribute__((ext_vector_type(16)));
#define MFMA32(a, b, c) __builtin_amdgcn_mfma_f32_32x32x16_bf16((a), (b), (c), 0, 0, 0)
#define PACK8(x, s) __builtin_bit_cast(bf16x8, (v4u){cvtpk((x)[8 * (s)], (x)[8 * (s) + 1]), cvtpk((x)[8 * (s) + 2], (x)[8 * (s) + 3]), cvtpk((x)[8 * (s) + 4], (x)[8 * (s) + 5]), cvtpk((x)[8 * (s) + 6], (x)[8 * (s) + 7])})
__device__ __forceinline__ int swap23(int x) { return (x & ~12) | ((x & 4) << 1) | ((x & 8) >> 1); }
__device__ __forceinline__ void attn_mfma(Frame& F_, int cv_first, int cv_count) {
    PHASE_LOCALS
    unsigned char* const ws_ = kargs()->ws;
    const bf16* Q = (const bf16*)(ws_ + WS_Q); const bf16* K = (const bf16*)(ws_ + WS_K); const bf16* VT = (const bf16*)(ws_ + WS_VT); bf16* AO = (bf16*)(ws_ + WS_AO);
    const int lane = F.lane, r = lane & 31, hh = lane >> 5;
    bf16x8 Tf[2];
    { const int kout = swap23(r);
#pragma unroll
        for (int s = 0; s < 2; ++s)
#pragma unroll
            for (int j = 0; j < 8; ++j) Tf[s][j] = (16 * s + 8 * hh + j >= kout) ? (short)0xBF80 : (short)0; }
    const int gw = blk * NWAVES + F.wave, bh = gw >> 6, qa = gw & 63, b = bh >> 4, h = bh & 15;
    const bf16* Kb = K + (size_t)bh * 256 * 2048 + lane * 8;
    const bf16* Vb = VT + (size_t)bh * 256 * 2048 + lane * 8;
    bf16x8 Qp[4], Kp[4], Vp[4];
    { const int qt0 = qa; const bf16* qp = Q + (size_t)(b * T + qt0 * 32 + r) * D + h * 64 + 8 * hh; const bf16* kp = Kb + (size_t)qt0 * 2048; const bf16* vp = Vb + (size_t)qt0 * 2048;
#pragma unroll
        for (int x = 0; x < 4; ++x) { Qp[x] = *(const GAS bf16x8*)(qp + 16 * x); Kp[x] = *(const GAS bf16x8*)(kp + 512 * x); Vp[x] = *(const GAS bf16x8*)(vp + 512 * x); } }
#pragma nounroll
    for (int it = 0; it < 4; ++it) {
        const int qt = (it == 0) ? qa : (it == 1) ? 127 - qa : (it == 2) ? 128 + qa : 255 - qa, q0 = qt * 32;
        bf16x8 Qf[4], Kf[4], Vf[4], Kn[4], Vn[4];
#pragma unroll
        for (int x = 0; x < 4; ++x) { Qf[x] = Qp[x]; Kf[x] = Kp[x]; Vf[x] = Vp[x]; }
        { const int qn = (it == 0) ? 127 - qa : (it == 1) ? 128 + qa : 255 - qa;
            const bf16* qp = Q + (size_t)(b * T + qn * 32 + r) * D + h * 64 + 8 * hh; const bf16* kp = Kb + (size_t)qn * 2048; const bf16* vp = Vb + (size_t)qn * 2048;
#pragma unroll
            for (int x = 0; x < 4; ++x) { Qp[x] = *(const GAS bf16x8*)(qp + 16 * x); Kp[x] = *(const GAS bf16x8*)(kp + 512 * x); Vp[x] = *(const GAS bf16x8*)(vp + 512 * x); } }
        __builtin_amdgcn_sched_barrier(0);
        f32x16 O0, O1;
#pragma unroll
        for (int i = 0; i < 16; ++i) { O0[i] = 0.f; O1[i] = 0.f; }
        float R = 0.f;
        for (int kb = qt; kb >= 0; --kb) {
            { const int kn = kb > 0 ? kb - 1 : 0; const bf16* kp = Kb + (size_t)kn * 2048; const bf16* vp = Vb + (size_t)kn * 2048;
#pragma unroll
                for (int x = 0; x < 4; ++x) { Kn[x] = *(const GAS bf16x8*)(kp + 512 * x); Vn[x] = *(const GAS bf16x8*)(vp + 512 * x); } }
            __builtin_amdgcn_sched_barrier(0);
            f32x16 S;
#pragma unroll
            for (int i = 0; i < 16; ++i) S[i] = 0.f;
#pragma unroll
            for (int ks = 0; ks < 4; ++ks) S = MFMA32(Kf[ks], Qf[ks], S);
            f32x16 L;
            const bool diag = (kb == qt);
#pragma unroll
            for (int i = 0; i < 16; ++i) { const float z = fminf(S[i], 126.0f); S[i] = z; L[i] = __builtin_amdgcn_logf(1.0f + __builtin_amdgcn_exp2f(z)); }
            if (diag) {
#pragma unroll
                for (int i = 0; i < 16; ++i) { const int kl = (i & 3) + 4 * ((i >> 2) & 1) + 16 * (i >> 3) + 8 * hh; if (kl >= r) L[i] = 0.f; }
            }
            const bf16x8 L0 = PACK8(L, 0), L1 = PACK8(L, 1);
            const float z0 = S[0];
            S = MFMA32(Tf[0], L0, S); S = MFMA32(Tf[1], L1, S);
            const float tot = __shfl(z0 - S[0], r);
#pragma unroll
            for (int i = 0; i < 16; ++i) S[i] = __builtin_amdgcn_exp2f(S[i] + R);
            if (diag) {
#pragma unroll
                for (int i = 0; i < 16; ++i) { const int kl = (i & 3) + 4 * ((i >> 2) & 1) + 16 * (i >> 3) + 8 * hh; if (kl >= r) S[i] = 0.f; }
            }
            R -= tot;
            const bf16x8 P0 = PACK8(S, 0), P1 = PACK8(S, 1);
            O0 = MFMA32(Vf[0], P0, O0); O0 = MFMA32(Vf[1], P1, O0);
            O1 = MFMA32(Vf[2], P0, O1); O1 = MFMA32(Vf[3], P1, O1);
            if (__builtin_amdgcn_ballot_w64(R >= -150.0f) == 0ull) break;
#pragma unroll
            for (int x = 0; x < 4; ++x) { Kf[x] = Kn[x]; Vf[x] = Vn[x]; }
        }
        bf16* op = AO + (size_t)(b * T + q0 + r) * D + h * 64 + 4 * hh;
#pragma unroll
        for (int g = 0; g < 4; ++g) {
            *(GAS unsigned long long*)(op + 8 * g) = (unsigned long long)cvtpk(O0[4 * g], O0[4 * g + 1]) | ((unsigned long long)cvtpk(O0[4 * g + 2], O0[4 * g + 3]) << 32);
            *(GAS unsigned long long*)(op + 32 + 8 * g) = (unsigned long long)cvtpk(O1[4 * g], O1[4 * g + 1]) | ((unsigned long long)cvtpk(O1[4 * g + 2], O1[4 * g + 3]) << 32); }
        if ((it & 1) == (F.wave >> 2)) { const int ci = gw + (it >> 1) * (F.G * NWAVES);     if (ci < cv_count) conv_one_moe_down(cv_first + ci, 1, ws_, F.lds + RING_OFF, F.wave, lane); }
    }
}

__device__ __forceinline__ void prologue(Frame& F_) {
    PHASE_LOCALS
    unsigned char* const ws_ = kargs()->ws;
#define in (kargs()->in)
    if (blk == 0) { GAS float* LB = (GAS float*)(ws_ + TAB_LB); const float* raw = in[4];
        for (int c = F.tid; c < D; c += NWAVES * 64) { const float a = raw[c], b = raw[D + c], mx = fmaxf(a, b), ea = __expf(a - mx), eb = __expf(b - mx); LB[c] = 0.f; LB[D + c] = eb / (ea + eb); } }
    conv8_all(F, true, 0);
    conv_all(F, true, 0);
    __syncthreads();
    norm_phase(F, in[0], false, nullptr, nullptr);
#undef in
}

#ifndef REP_PRO
#define REP_PRO 1
#endif
#ifndef REP_HGRN
#define REP_HGRN 1
#endif
#ifndef REP_HG0
#define REP_HG0 1
#endif
#ifndef REP_HG1
#define REP_HG1 1
#endif
#ifndef REP_ATTN
#define REP_ATTN 1
#endif
#ifndef REP_NORM
#define REP_NORM 1
#endif
#ifndef REP_CONV
#define REP_CONV 1
#endif
#ifndef REP_MDOWN
#define REP_MDOWN 1
#endif
#ifndef REP_MGU
#define REP_MGU 1
#endif
#ifndef REP_OUTP
#define REP_OUTP 1
#endif
#ifndef REP_DDOWN
#define REP_DDOWN 1
#endif
#ifndef REP_BAR
#define REP_BAR 1
#endif
#ifndef REP_SCAT
#define REP_SCAT 1
#endif
#ifndef REP_WIN
#define REP_WIN 1
#endif
#ifndef REP_DGU
#define REP_DGU 1
#endif
#ifndef REP_QKV
#define REP_QKV 1
#endif
#define REPEAT(n) _Pragma("nounroll") for (int rep_ = 0; rep_ < (n); ++rep_)

constexpr int NPH = 1 + (5 + 1 + 3) + (5 + 1 + 4) + (3 + 1 + 3) + (3 + 1 + 4);
__global__ void __launch_bounds__(NWAVES * 64, 2) yoco_fwd(Args) {
    extern __shared__ __attribute__((aligned(16))) unsigned char lds[];
    Frame F;
    F.lds = (LAS unsigned char*)lds;
    F.MISC = (volatile LAS unsigned*)(F.lds + MISC_OFF);
    F.tid = threadIdx.x; F.lane = F.tid & 63; F.wave = __builtin_amdgcn_readfirstlane(F.tid >> 6);
    F.G = gridDim.x; { const int bx = blockIdx.x; F.vcu = (F.G % 8 == 0) ? (bx % 8) * (F.G / 8) + bx / 8 : bx; }
    for (int u = F.tid; u < (LDS_BYTES - LDSCTL_OFF) / 4; u += NWAVES * 64) ((LAS unsigned*)(F.lds + LDSCTL_OFF))[u] = 0u;
    __syncthreads();
    const int lo = kargs()->ph_lo, hi = kargs()->ph_hi;
    XcdBarrier bar; bar.bar = (unsigned*)(kargs()->ws + WS_CTL) + CW_BAR; bar.x = 0; bar.st = nullptr;
    if (hi - lo > 1) bar = xcd_barrier_post((unsigned*)(kargs()->ws + WS_CTL) + CW_BAR, F.MISC + 8);
    int ph = 0;
#define PH_ON (ph >= lo && ph < hi)
#define PH_END do { if (ph >= lo && ph + 1 < hi) { XcdBarrier b2_; b2_.bar = (unsigned*)(wsbase() + WS_CTL) + CW_BAR; b2_.st = bar.st; b2_.x = lg((int)__builtin_amdgcn_readfirstlane(bar.x)); xcd_barrier(b2_); } ++ph; } while (0)
#define in (kargs()->in)
#define X (kargs()->out)
#define XQB ((const bf16*)(wsbase() + WS_XQ))
#define W8P(off) ((const bf16*)(wsbase() + WS_W8 + ((off) - WS_WIN) / 2))
#define SBP(off) ((const float*)(wsbase() + WS_SB) + ((off) - WS_WIN) / 2048)
#define SAPTR ((const float*)(wsbase() + WS_SA))
#define ws (wsbase())

    if (PH_ON) REPEAT(REP_PRO) { prologue(F); __syncthreads(); }
    PH_END;
#pragma nounroll
    for (int layer = 0; layer < 4; ++layer) {
        const bool hg = layer < 2, moe = (layer & 1) != 0;
        const int fi = layer >> 1;
        if (hg) {
            if (PH_ON) {
                const size_t wo = WS_WIN + (size_t)layer * 4 * D * D * 2;
                pg8::Gemm g{XQB, W8P(wo), M, 4 * D, D / 2, D / 2, 0, 0, 0, 0, SAPTR, SBP(wo)}; pg8::StaticOrder S; S.init(M, 4 * D, lg(F.G), lg((int)blockIdx.x));
                pg8::EpiHgrnIn E{(bf16*)(ws + WS_QS), (_Float16*)(ws + WS_LF), (const float*)(ws + TAB_LB) + layer * D};
                static_assert(WS_VV == WS_QS + 2 * 2 * pg8::EpiHgrnIn::SEGSTRIDE && WS_GG == WS_QS + 3 * 2 * pg8::EpiHgrnIn::SEGSTRIDE, "segment buffers are 32 MiB apart");
                REPEAT(REP_WIN) { pg8::gemm_phase<pg8::EpiHgrnIn, pg8::StaticOrder, true, true, true>(F.lds + RING_OFF, g, S, E); __syncthreads(); }
            }
            PH_END;
            if (PH_ON) REPEAT(REP_HGRN * REP_HG0) hgrn_chunks<0>(F, nullptr);
            PH_END;
            if (PH_ON) REPEAT(REP_HGRN) hgrn_scan(F);
            PH_END;
            if (PH_ON) REPEAT(REP_HGRN * REP_HG1) hgrn_chunks<1>(F, in[5] + layer * 128);
            PH_END;
        } else {
            if (PH_ON) {
                const int nw = (layer == 2) ? 3 : 1;
#pragma nounroll
                for (int w = 0; w < nw * REP_QKV; ++w) {
                    pg8::Gemm g; pg8::EpiBf16P E; pg8::StaticOrder S;
                    if (w % nw == 0) { const size_t wo = WS_WQ + (size_t)(layer - 2) * D * D * 2; g = pg8::Gemm{XQB, W8P(wo), M, D, D / 2, D / 2, 0, 0, 0, 0, SAPTR, SBP(wo)}; E = pg8::EpiBf16P{(bf16*)(ws + WS_Q), D, 0}; }
                    else if (w % nw == 1) { g = pg8::Gemm{XQB, W8P(WS_WK), M, D, D / 2, D / 2, 0, 0, 0, 0, SAPTR, SBP(WS_WK)}; E = pg8::EpiBf16P{(bf16*)(ws + WS_K), D, 1}; }
                    else { g = pg8::Gemm{W8P(WS_WV), XQB, D, M, D / 2, D / 2, 0, 0, 0, 0, SBP(WS_WV), SAPTR}; E = pg8::EpiBf16P{(bf16*)(ws + WS_VT), M, 2}; }
                    S.init(g.M, g.N, lg(F.G), lg((int)blockIdx.x));
                    pg8::gemm_phase<pg8::EpiBf16P, pg8::StaticOrder, true, true, true>(F.lds + RING_OFF, g, S, E);
                    __syncthreads();
                }
            }
            PH_END;
            if (PH_ON) REPEAT(REP_ATTN) attn_mfma(F, (layer - 2) * (CONV_MOE_ITEMS / 2), CONV_MOE_ITEMS / 2);
            PH_END;
        }
        if (PH_ON) {
            const float* xin = (layer == 0) ? in[0] : X;
            pg8::Gemm g{hg ? (const bf16*)(ws + WS_OG) : (const bf16*)(ws + WS_AO), hg ? (const bf16*)(ws + WS_WOUT) + (size_t)layer * D * D : (const bf16*)(ws + WS_WO) + (size_t)(layer - 2) * D * D, M, D, D, D};
            pg8::StaticOrder S; S.init(M, D, lg(F.G), lg((int)blockIdx.x));
            REPEAT(REP_OUTP) { pg8::EpiResid E{xin, rep_ == 0 ? X : (float*)(ws + WS_OR), D};
                pg8::gemm_phase<pg8::EpiResid, pg8::StaticOrder, true, true>(F.lds + RING_OFF, g, S, E); __syncthreads(); }
        }
        PH_END;
        if (PH_ON) REPEAT(REP_NORM) { norm_phase(F, X, moe, in[13] + (size_t)fi * D * NE, in[2] + layer * D); __syncthreads(); }
        PH_END;
        if (moe) { if (PH_ON) REPEAT(REP_SCAT) { scatter_phase(F); __syncthreads(); } PH_END; }
        if (PH_ON) {
            const int nrt = moe ? __builtin_amdgcn_readfirstlane(((const GAS int*)(ws + TAB_TILE))[160]) : M / 256;
            const size_t wo = WS_WGU + (size_t)fi * 2 * FFD * D * 2;
            pg8::Gemm g{moe ? (const bf16*)(ws + WS_XPQ) : XQB, moe ? (const bf16*)(ws + WS_WM8) : W8P(wo), nrt * 256, moe ? 2 * FFE : 2 * FFD, D / 2, D / 2, 0, 0, 0, 0,
                        moe ? (const float*)(ws + WS_SAP) : SAPTR, moe ? (const float*)(ws + WS_SBM) : SBP(wo)};
            pg8::MoeOrder S; S.init(nrt, (moe ? 2 * FFE : 2 * FFD) / 256, 1, D / 2, lg(F.G), lg((int)blockIdx.x), moe ? (const int*)(ws + TAB_TILE) : (const int*)(ws + WS_CTL) + CW_ZTAB, nullptr, 0);
            pg8::EpiSwiglu E{moe ? (bf16*)(ws + WS_HM) : (bf16*)(ws + WS_HB), moe ? MROWS : M};
            REPEAT(moe ? REP_MGU : REP_DGU) { pg8::gemm_phase<pg8::EpiSwiglu, pg8::MoeOrder, true, true, true>(F.lds + RING_OFF, g, S, E); __syncthreads(); }
        }
        PH_END;
        if (PH_ON) {
            const int* TE = (const int*)(ws + TAB_TILE);
#pragma nounroll
            for (int w = 0; w < (moe ? 2 : 1); ++w) {
                const int nrt = moe ? __builtin_amdgcn_readfirstlane(((const GAS int*)TE)[w == 0 ? 336 : 368]) : M / 256;
                const int ksn = (moe && w == 1) ? MOE_RKS : 1, kl = moe ? (w == 1 ? MOE_RKL : FFE) : FFD;
                pg8::Gemm g{moe ? (const bf16*)(ws + WS_HM) : (const bf16*)(ws + WS_HB), moe ? (const bf16*)(ws + (layer == 1 ? WS_WMDN : WS_WMDN2)) : (const bf16*)(ws + WS_WDN) + (size_t)fi * D * FFD, nrt * 256, D, moe ? FFE : FFD, kl,
                            64, 64, (long)(moe ? MROWS : M) * 128, (long)(moe ? NE * D : D) * 128};
                pg8::MoeOrder S; S.init(nrt, D / 256, ksn, kl, lg(F.G), lg((int)blockIdx.x), moe ? TE : (const int*)(ws + WS_CTL) + CW_ZTAB, moe ? TE + (w == 0 ? 176 : 352) : nullptr, w);
                if (moe) { REPEAT(REP_MDOWN) { pg8::EpiDownMoe E{(bf16*)(ws + (w == 0 ? WS_Y0 : WS_YR)), YR_STRIDE, kl, D};
                    pg8::gemm_phase<pg8::EpiDownMoe, pg8::MoeOrder, true, true>(F.lds + RING_OFF, g, S, E); __syncthreads(); } }
                else { REPEAT(REP_DDOWN) { pg8::EpiDown E{X, rep_ == 0 ? X : (float*)(ws + WS_OR), nullptr, 0, kl, D};
                    pg8::gemm_phase<pg8::EpiDown, pg8::MoeOrder, true, true>(F.lds + RING_OFF, g, S, E); __syncthreads(); } }
            }
        }
        PH_END;
        if (PH_ON) {
            if (moe) { combine_phase(F, X, layer == 3, in[17]); if (layer == 1) REPEAT(REP_CONV) { __syncthreads(); conv8_all(F, false, 1); } }
            else norm_phase(F, X, false, nullptr, nullptr);
        }
        PH_END;
    }
#undef PH_ON
#undef PH_END
#undef in
#undef X
#undef ws
#undef XQB
#undef W8P
#undef SBP
#undef SAPTR
}

#ifndef MK_PER_PHASE
#define MK_PER_PHASE 0
#endif
extern "C" void kernel_launch(void* const* d_in, const int* in_sizes, int n_in, void* d_out, int out_size, void* d_ws, size_t ws_size, hipStream_t stream) {
    static int ok = 0;
    if (ok == 0) {
        if (n_in != 18 || in_sizes[0] != M * D || out_size != M * D || ws_size < WS_END) { fprintf(stderr, "kernel_launch: unexpected shapes / workspace (n_in %d, ws %zu, need %zu); nothing launched\n", n_in, ws_size, (size_t)WS_END); ok = -1; return; }
        if (hipFuncSetAttribute((const void*)yoco_fwd, hipFuncAttributeMaxDynamicSharedMemorySize, LDS_BYTES) != hipSuccess) { fprintf(stderr, "kernel_launch: hipFuncSetAttribute failed\n"); ok = -1; return; }
        int per_cu = 0;
        if (hipOccupancyMaxActiveBlocksPerMultiprocessor(&per_cu, (const void*)yoco_fwd, NWAVES * 64, LDS_BYTES) != hipSuccess || per_cu < 1) fprintf(stderr, "kernel_launch: note: occupancy query reports %d workgroups per CU\n", per_cu);
        (void)hipGetLastError();
        ok = 1;
    }
    if (ok < 0) return;
    (void)hipMemsetAsync((char*)d_ws + WS_CTL, 0, CTL_ZERO_BYTES, stream);
    Args a{};
    for (int i = 0; i < 18; ++i) a.in[i] = (const float*)d_in[i];
    a.out = (float*)d_out; a.ws = (unsigned char*)d_ws;
#if MK_PER_PHASE
    for (int p = 0; p < NPH; ++p) { a.ph_lo = p; a.ph_hi = p + 1; hipLaunchKernelGGL(yoco_fwd, dim3(GRID), dim3(NWAVES * 64), LDS_BYTES, stream, a); }
#else
    a.ph_lo = 0; a.ph_hi = NPH; hipLaunchKernelGGL(yoco_fwd, dim3(GRID), dim3(NWAVES * 64), LDS_BYTES, stream, a);
#endif
}
```

```cpp
#include <hip/hip_runtime.h>
#include <cstdio>
#include <cstdint>
#ifndef REP_EPI8
#define REP_EPI8 1
#endif
#ifndef REP_HCC
#define REP_HCC 1
#endif
#ifndef REP_HCB
#define REP_HCB 1
#endif
namespace pg8 {
#define PG8_LAS __attribute__((address_space(3)))
typedef unsigned short bf16_t;
typedef short bf16x8 __attribute__((ext_vector_type(8)));
typedef float f32x4 __attribute__((ext_vector_type(4)));
typedef unsigned u32x4 __attribute__((ext_vector_type(4)));
constexpr int BM = 256, BK = 64, HALF = 128, HTB = HALF * BK * 2  , STAGE_BYTES = 8 * HTB, NXCD = 8, WGM = 4;

__host__ __device__ __forceinline__ int lds_byte(int r, int c) { const int st = (r >> 4) * 2 + (c >> 5), rr = r & 15, cc = c & 31, ob = rr * 64 + cc * 2; return st * 1024 + (ob ^ (((ob >> 9) & 1) << 5)); }
__host__ __device__ __forceinline__ void stage_rc(int b, int& R, int& C) { const int st = b / 1024, sb = b % 1024, swz = sb ^ (((sb >> 9) & 1) << 5); R = (st >> 1) * 16 + swz / 64; C = (st & 1) * 32 + (swz % 64) / 2; }
__host__ __device__ __forceinline__ int perm32(int rho) { const int n = rho >> 4, i = rho & 15; return 8 * (i >> 2) + 4 * n + (i & 3); }

struct Unit { int pm, pn, pc, ko, po; };
struct Gemm { const bf16_t* A; const bf16_t* Bt; int M, N, K, KL; int pA = 0, pB = 0; long ksA = 0, ksB = 0; const float* sA = nullptr; const float* sB = nullptr; };

struct StaticOrder {
    int nM, nN, nwg, G, c;
    __host__ __device__ void init(int M, int N, int G_, int c_) { nM = M / BM; nN = N / BM; nwg = nM * nN; G = G_; c = c_; }
    __host__ __device__ bool next(int i, Unit& u) const {
        const long L = (long)i * G + c; if (L >= nwg) return false;
        int wgid = (int)L; { const int q = nwg / NXCD, r = nwg % NXCD, xcd = wgid % NXCD, off = wgid / NXCD; wgid = (xcd < r ? xcd * (q + 1) : r * (q + 1) + (xcd - r) * q) + off; }
        const int nig = WGM * nN, gid = wgid / nig, fm = gid * WGM, gsz = (nM - fm) < WGM ? (nM - fm) : WGM;
        u.pm = fm + ((wgid % nig) % gsz); u.pn = (wgid % nig) / gsz; u.pc = u.pn; u.ko = 0; u.po = u.pm; return true;
    }
    __device__ __forceinline__ void a_ready(const Unit&) const {}
    __device__ __forceinline__ void done(const Unit&) const {}
};

__device__ __forceinline__ unsigned cvt_pk_bf16(float lo, float hi) { unsigned r; asm volatile("v_cvt_pk_bf16_f32 %0, %1, %2" : "=v"(r) : "v"(lo), "v"(hi)); return r; }
typedef float f32x2 __attribute__((ext_vector_type(2)));

typedef int i32x4 __attribute__((ext_vector_type(4)));
template <bool I8> struct AccSel { typedef f32x4 type; };
template <> struct AccSel<true> { typedef i32x4 type; };
__device__ __forceinline__ f32x4 mma16(bf16x8 a, bf16x8 b, f32x4 c) { return __builtin_amdgcn_mfma_f32_16x16x32_bf16(a, b, c, 0, 0, 0); }
__device__ __forceinline__ i32x4 mma16(bf16x8 a, bf16x8 b, i32x4 c) { return __builtin_amdgcn_mfma_i32_16x16x64_i8(__builtin_bit_cast(i32x4, a), __builtin_bit_cast(i32x4, b), c, 0, 0, 0); }
template <bool PERM> __device__ __forceinline__ void dequant(const f32x4 (&)[2][2][4][2], f32x4 (&)[2][2][4][2], const PG8_LAS float*, int, int, int, int) {}
template <bool PERM> __device__ __forceinline__ void dequant(const i32x4 (&acc)[2][2][4][2], f32x4 (&f)[2][2][4][2], const PG8_LAS float* SL, int wr, int wc, int fr, int fq) {
    const PG8_LAS float* sa = SL + wr * 64 + fr; const PG8_LAS float* sb = SL + 256 + wc * 32 + (PERM ? 8 * fq : 4 * fq);
    f32x4 cs[2][2];
#pragma unroll
    for (int bj = 0; bj < 2; ++bj)
#pragma unroll
        for (int n = 0; n < 2; ++n) cs[bj][n] = *(const PG8_LAS f32x4*)(sb + bj * HALF + (PERM ? 4 * n : 16 * n));
#pragma unroll
    for (int ai = 0; ai < 2; ++ai)
#pragma unroll
        for (int m = 0; m < 4; ++m) { const float rs = sa[ai * HALF + m * 16];
#pragma unroll
            for (int bj = 0; bj < 2; ++bj)
#pragma unroll
                for (int n = 0; n < 2; ++n) { const i32x4 a = acc[ai][bj][m][n]; f[ai][bj][m][n] = (f32x4){(float)a[0], (float)a[1], (float)a[2], (float)a[3]} * (cs[bj][n] * rs); } }
}
__device__ __forceinline__ float fsigmoid(float x) { return __builtin_amdgcn_rcpf(1.0f + __builtin_amdgcn_exp2f(-1.44269504089f * x)); }
__device__ __forceinline__ float fsilu(float x) { return x * fsigmoid(x); }

struct EpiResid {
    static constexpr bool PERM = false, AFTER_DRAIN = false;
    const float* base; float* out; int ldc;
    __device__ __forceinline__ void operator()(const f32x4 (&acc)[2][2][4][2], const Unit& u, int wr, int wc, int fr, int fq) const {
        const int row0 = u.pm * BM + wr * 64 + fr, col0 = u.pc * BM + wc * 32 + 4 * fq;
#pragma unroll
        for (int ai = 0; ai < 2; ++ai)
#pragma unroll
            for (int m = 0; m < 4; ++m) { const size_t off = (size_t)(row0 + ai * HALF + m * 16) * ldc + col0;
#pragma unroll
                for (int bj = 0; bj < 2; ++bj)
#pragma unroll
                    for (int n = 0; n < 2; ++n) { f32x4 b = (f32x4){0.f, 0.f, 0.f, 0.f}; if (base) b = *(const f32x4*)(base + off + bj * HALF + n * 16); *(f32x4*)(out + off + bj * HALF + n * 16) = b + acc[ai][bj][m][n]; } }
    }
};
struct EpiF32 {
    static constexpr bool PERM = false, AFTER_DRAIN = false;
    float* out; int ldc;
    __device__ __forceinline__ void operator()(const f32x4 (&acc)[2][2][4][2], const Unit& u, int wr, int wc, int fr, int fq) const {
        const int row0 = u.pm * BM + wr * 64 + fr, col0 = u.pc * BM + wc * 32 + 4 * fq;
#pragma unroll
        for (int ai = 0; ai < 2; ++ai)
#pragma unroll
            for (int m = 0; m < 4; ++m) { const size_t off = (size_t)(row0 + ai * HALF + m * 16) * ldc + col0;
#pragma unroll
                for (int bj = 0; bj < 2; ++bj)
#pragma unroll
                    for (int n = 0; n < 2; ++n) *(f32x4*)(out + off + bj * HALF + n * 16) = acc[ai][bj][m][n]; }
    }
};
struct EpiBf16P {
    static constexpr bool PERM = true, AFTER_DRAIN = false;
    bf16_t* O; int ldc, mode;
    __device__ __forceinline__ void operator()(const f32x4 (&acc)[2][2][4][2], const Unit& u, int wr, int wc, int fr, int fq) const {
        const int row0 = u.pm * BM + wr * 64 + fr, col0 = u.pc * BM + wc * 32 + 8 * fq;
#pragma unroll
        for (int ai = 0; ai < 2; ++ai)
#pragma unroll
            for (int m = 0; m < 4; ++m) { const int row = row0 + ai * HALF + m * 16;
#pragma unroll
                for (int bj = 0; bj < 2; ++bj) { const f32x4 v0 = acc[ai][bj][m][0], v1 = acc[ai][bj][m][1]; const int col = col0 + bj * HALF;
                    u32x4 w; w.x = cvt_pk_bf16(v0[0], v0[1]); w.y = cvt_pk_bf16(v0[2], v0[3]); w.z = cvt_pk_bf16(v1[0], v1[1]); w.w = cvt_pk_bf16(v1[2], v1[3]);
                    size_t off;
                    if (mode == 0) off = (size_t)row * ldc + col;
                    else if (mode == 1) { const int b = row >> 13, key = row & 8191, kk = key & 31, rr = (kk & ~12) | ((kk & 4) << 1) | ((kk & 8) >> 1), h = col >> 6;
                        off = ((size_t)((((b * 16 + h) * 256 + (key >> 5)) * 4 + ((col & 63) >> 4)) * 64 + ((col & 15) >> 3) * 32 + rr)) * 8; }
                    else { const int h = row >> 6, d = row & 63, b = col >> 13, key = col & 8191;
                        off = ((size_t)((((b * 16 + h) * 256 + (key >> 5)) * 4 + (d >> 5) * 2 + ((key & 31) >> 4)) * 64 + ((key & 15) >> 3) * 32 + (d & 31))) * 8; }
                    *(u32x4*)(O + off) = w; } }
    }
};
struct EpiSwiglu {
    static constexpr bool PERM = true, AFTER_DRAIN = false;
    bf16_t* H; int rows;
    __device__ __forceinline__ void operator()(const f32x4 (&acc)[2][2][4][2], const Unit& u, int wr, int wc, int fr, int fq) const {
        const int row0 = u.pm * BM + wr * 64 + fr, kt = u.pc * 2 + (wc >> 1), c64 = (wc & 1) * 32 + 8 * fq;
#pragma unroll
        for (int ai = 0; ai < 2; ++ai)
#pragma unroll
            for (int m = 0; m < 4; ++m) { bf16_t* rowp = H + ((size_t)kt * rows + (row0 + ai * HALF + m * 16)) * 64 + c64;
                float h[8];
#pragma unroll
                for (int n = 0; n < 2; ++n)
#pragma unroll
                    for (int j = 0; j < 4; ++j) h[4 * n + j] = fsilu(acc[ai][0][m][n][j]) * acc[ai][1][m][n][j];
                u32x4 w; w.x = cvt_pk_bf16(h[0], h[1]); w.y = cvt_pk_bf16(h[2], h[3]); w.z = cvt_pk_bf16(h[4], h[5]); w.w = cvt_pk_bf16(h[6], h[7]);
                *(u32x4*)rowp = w; }
    }
};
struct EpiHgrnIn {
    static constexpr bool PERM = true, AFTER_DRAIN = false;
    bf16_t* QS; _Float16* LF; const float* lb;
    static constexpr size_t SEGSTRIDE = (size_t)16 << 20;
    __device__ __forceinline__ void operator()(const f32x4 (&acc)[2][2][4][2], const Unit& u, int wr, int wc, int fr, int fq) const {
        const int seg = u.pc >> 2;
        const int row0 = u.pm * BM + wr * 64 + fr, col0 = (u.pc & 3) * BM + wc * 32 + 8 * fq;
        bf16_t* O = QS + (size_t)seg * SEGSTRIDE;
        float lbv[2][8];
        if (seg == 1) {
#pragma unroll
            for (int bj = 0; bj < 2; ++bj) { const f32x4 a = *(const f32x4*)(lb + col0 + bj * HALF), b = *(const f32x4*)(lb + col0 + bj * HALF + 4);
#pragma unroll
                for (int j = 0; j < 4; ++j) { lbv[bj][j] = a[j]; lbv[bj][4 + j] = b[j]; } }
        }
#pragma unroll
        for (int ai = 0; ai < 2; ++ai)
#pragma unroll
            for (int m = 0; m < 4; ++m) { const size_t roff = (size_t)(row0 + ai * HALF + m * 16) * 1024 + col0;
#pragma unroll
                for (int bj = 0; bj < 2; ++bj) {
                    float v[8];
#pragma unroll
                    for (int n = 0; n < 2; ++n)
#pragma unroll
                        for (int j = 0; j < 4; ++j) v[4 * n + j] = acc[ai][bj][m][n][j];
                    if (seg == 1) {
                        typedef _Float16 f16x2 __attribute__((ext_vector_type(2)));
                        float lf[8];
#pragma unroll
                        for (int j = 0; j < 8; ++j) { const float sg = fsigmoid(v[j]); const float f = lbv[bj][j] + (1.0f - lbv[bj][j]) * sg; lf[j] = 0.69314718056f * __builtin_amdgcn_logf(fmaxf(f, 1e-30f)); }
                        u32x4 hw;
                        hw.x = __builtin_bit_cast(unsigned, (f16x2){(_Float16)lf[0], (_Float16)lf[1]}); hw.y = __builtin_bit_cast(unsigned, (f16x2){(_Float16)lf[2], (_Float16)lf[3]});
                        hw.z = __builtin_bit_cast(unsigned, (f16x2){(_Float16)lf[4], (_Float16)lf[5]}); hw.w = __builtin_bit_cast(unsigned, (f16x2){(_Float16)lf[6], (_Float16)lf[7]});
                        *(u32x4*)(LF + roff + bj * HALF) = hw;
                    } else {
                        if (seg != 2) {
#pragma unroll
                            for (int j = 0; j < 8; ++j) v[j] = fsilu(v[j]); }
                        u32x4 w; w.x = cvt_pk_bf16(v[0], v[1]); w.y = cvt_pk_bf16(v[2], v[3]); w.z = cvt_pk_bf16(v[4], v[5]); w.w = cvt_pk_bf16(v[6], v[7]);
                        *(u32x4*)(O + roff + bj * HALF) = w; } } }
    }
};
struct EpiDown {
    static constexpr bool PERM = false, AFTER_DRAIN = false;
    const float* base; float* out; bf16_t* y; size_t ystride; int kl, ldc;
    __device__ __forceinline__ void operator()(const f32x4 (&acc)[2][2][4][2], const Unit& u, int wr, int wc, int fr, int fq) const {
        const int col0 = u.pc * BM + wc * 32 + 4 * fq;
        if (out) {
            const int row0 = u.pm * BM + wr * 64 + fr;
#pragma unroll
            for (int ai = 0; ai < 2; ++ai)
#pragma unroll
                for (int m = 0; m < 4; ++m) { const size_t off = (size_t)(row0 + ai * HALF + m * 16) * ldc + col0;
#pragma unroll
                    for (int bj = 0; bj < 2; ++bj)
#pragma unroll
                        for (int n = 0; n < 2; ++n) { const f32x4 b = *(const f32x4*)(base + off + bj * HALF + n * 16); *(f32x4*)(out + off + bj * HALF + n * 16) = b + acc[ai][bj][m][n]; } }
        } else {
            const int row0 = u.po * BM + wr * 64 + fr; bf16_t* Y = y + (size_t)(u.ko / kl) * ystride;
            typedef unsigned u32x2 __attribute__((ext_vector_type(2)));
#pragma unroll
            for (int ai = 0; ai < 2; ++ai)
#pragma unroll
                for (int m = 0; m < 4; ++m) { const size_t off = (size_t)(row0 + ai * HALF + m * 16) * ldc + col0;
#pragma unroll
                    for (int bj = 0; bj < 2; ++bj)
#pragma unroll
                        for (int n = 0; n < 2; ++n) { const f32x4 v = acc[ai][bj][m][n]; u32x2 w; w.x = cvt_pk_bf16(v[0], v[1]); w.y = cvt_pk_bf16(v[2], v[3]); *(u32x2*)(Y + off + bj * HALF + n * 16) = w; } }
        }
    }
};
struct EpiDownMoe {
    static constexpr bool PERM = true, AFTER_DRAIN = false;
    bf16_t* y; size_t ystride; int kl, ldc;
    __device__ __forceinline__ void operator()(const f32x4 (&acc)[2][2][4][2], const Unit& u, int wr, int wc, int fr, int fq) const {
        const int row0 = u.po * BM + wr * 64 + fr, col0 = u.pc * BM + wc * 32 + 8 * fq; bf16_t* Y = y + (size_t)(u.ko / kl) * ystride;
#pragma unroll
        for (int ai = 0; ai < 2; ++ai)
#pragma unroll
            for (int m = 0; m < 4; ++m) { bf16_t* rowp = Y + (size_t)(row0 + ai * HALF + m * 16) * ldc + col0;
#pragma unroll
                for (int bj = 0; bj < 2; ++bj) { const f32x4 v0 = acc[ai][bj][m][0], v1 = acc[ai][bj][m][1];
                    u32x4 w; w.x = cvt_pk_bf16(v0[0], v0[1]); w.y = cvt_pk_bf16(v0[2], v0[3]); w.z = cvt_pk_bf16(v1[0], v1[1]); w.w = cvt_pk_bf16(v1[2], v1[3]);
                    *(u32x4*)(rowp + bj * HALF) = w; } }
    }
};
struct MoeOrder {
    StaticOrder so; const int* tile_e; const int* list; int nN, KL, compact, rev;
    __device__ void init(int nrt, int nN_, int KS, int KL_, int G_, int c_, const int* te, const int* li, int compact_, int rev_ = 0) { compact = compact_; rev = rev_; so.nM = nrt; so.nN = nN_ * KS; so.nwg = nrt * nN_ * KS; so.G = G_; so.c = c_; tile_e = te; list = li; nN = nN_; KL = KL_; }
    __device__ bool next(int i, Unit& u) const { if (!so.next(i, u)) return false;
        if (list) u.pm = __builtin_amdgcn_readfirstlane(list[rev ? so.nM - 1 - u.pm : u.pm]);
        if (!compact) u.po = u.pm;
        const int e = __builtin_amdgcn_readfirstlane(tile_e[u.pm]); const int ks = u.pc / nN, pl = u.pc - ks * nN;
        u.pn = e * nN + pl; u.pc = pl; u.ko = ks * KL; return true; }
    __device__ __forceinline__ void a_ready(const Unit&) const {}
    __device__ __forceinline__ void done(const Unit&) const {}
};
template <class Epi, class Sched, bool ALIGN_EPI = false, bool SP2 = false, bool I8 = false>
__device__ __forceinline__ void gemm_phase(PG8_LAS unsigned char* lds, const Gemm g, const Sched& S, const Epi& E) {
    int tid_ = threadIdx.x; asm volatile("" : "+v"(tid_));
    const int tid = tid_, wid = __builtin_amdgcn_readfirstlane(tid >> 6), lane = tid & 63, wr = wid >> 2, wc = wid & 3, fr = lane & 15, fq = lane >> 4;
    const int K = g.K  , nt = g.KL / BK  ;
    const int pitA = g.pA ? g.pA : K, pitB = g.pB ? g.pB : K;
    unsigned voffA[2], voffB[2];
#pragma unroll
    for (int i = 0; i < 2; ++i) { int R, C; stage_rc(tid * 16 + i * 8192, R, C); const int Rb = Epi::PERM ? ((R & ~31) + perm32(R & 31)) : R;
        voffA[i] = (unsigned)(R * pitA + C) * 2u; voffB[i] = (unsigned)(Rb * pitB + C) * 2u; }
    const size_t kstepA = g.ksA ? (size_t)g.ksA : (size_t)(BK * 2), kstepB = g.ksB ? (size_t)g.ksB : (size_t)(BK * 2);
    const size_t hstepA = (size_t)HALF * pitA * 2, hstepB = (size_t)HALF * pitB * 2;
    const size_t tstepA = 2 * hstepA, tstepB = 2 * hstepB;
    const unsigned ldsw = (unsigned)wid * 1024u;
    const int aoff = lds_byte(wr * 64 + fr, fq * 8), boff = lds_byte(wc * 32 + fr, fq * 8);
#define PG8_SA(b, h) (((b) * 2 + (h)) * HTB)
#define PG8_SB(b, h) ((4 + (b) * 2 + (h)) * HTB)
#define PG8_STAGE(bufoff, gbase, voff) do { _Pragma("unroll") for (int _i = 0; _i < 2; ++_i) \
        __builtin_amdgcn_global_load_lds((const unsigned*)((const char*)(gbase) + (voff)[_i]), (PG8_LAS unsigned*)(lds + (bufoff) + ldsw + _i * 8192), 16, 0, 0); } while (0)
#define PG8_LDA(dst, b, h) do { _Pragma("unroll") for (int m = 0; m < 4; ++m) _Pragma("unroll") for (int k = 0; k < 2; ++k) dst[m][k] = *(const PG8_LAS bf16x8*)(lds + PG8_SA(b, h) + aoff + m * 2048 + k * 1024); } while (0)
#define PG8_LDB(dst, b, h) do { _Pragma("unroll") for (int n = 0; n < 2; ++n) _Pragma("unroll") for (int k = 0; k < 2; ++k) dst[n][k] = *(const PG8_LAS bf16x8*)(lds + PG8_SB(b, h) + boff + n * 2048 + k * 1024); } while (0)
#define PG8_MMA(ai, bj, At, Bt) do { __builtin_amdgcn_s_setprio(1); _Pragma("unroll") for (int m = 0; m < 4; ++m) _Pragma("unroll") for (int n = 0; n < 2; ++n) _Pragma("unroll") for (int k = 0; k < 2; ++k) \
        acc[ai][bj][m][n] = mma16(Bt[n][k], At[m][k], acc[ai][bj][m][n]); __builtin_amdgcn_s_setprio(0); } while (0)
#define PG8_WAIT_V(n) asm volatile("s_waitcnt vmcnt(" #n ")" ::: "memory")
#define PG8_WAIT_L(n) asm volatile("s_waitcnt lgkmcnt(" #n ")" ::: "memory")
#define PG8_BAR __builtin_amdgcn_s_barrier()
#define PG8_SCHED __builtin_amdgcn_sched_barrier(0)
    Unit cur, nxt; int ui = 0;
    if (!S.next(0, cur)) return;
    typedef typename AccSel<I8>::type acc_t;
    acc_t acc[2][2][4][2];
#pragma unroll
    for (int a = 0; a < 2; ++a)
#pragma unroll
        for (int b = 0; b < 2; ++b)
#pragma unroll
            for (int m = 0; m < 4; ++m)
#pragma unroll
                for (int n = 0; n < 2; ++n) acc[a][b][m][n] = (acc_t){0, 0, 0, 0};
    bf16x8 At[4][2], B0[2][2], B1[2][2];
    const char* cA = (const char*)g.A + (size_t)cur.pm * tstepA + (size_t)(cur.ko / BK) * kstepA; const char* cB = (const char*)g.Bt + (size_t)cur.pn * tstepB + (size_t)(cur.ko / BK) * kstepB;
    S.a_ready(cur);
    if constexpr (SP2) {
        PG8_STAGE(PG8_SB(0, 0), cB, voffB); PG8_STAGE(PG8_SB(0, 1), cB + hstepB, voffB); PG8_STAGE(PG8_SA(0, 0), cA, voffA); PG8_STAGE(PG8_SA(0, 1), cA + hstepA, voffA);
        if (wr == 1) PG8_BAR;
        PG8_WAIT_V(2); PG8_BAR;
        PG8_STAGE(PG8_SB(1, 0), cB + kstepB, voffB); PG8_STAGE(PG8_SA(1, 0), cA + kstepA, voffA); PG8_STAGE(PG8_SB(1, 1), cB + hstepB + kstepB, voffB);
        PG8_WAIT_V(6); PG8_BAR;
    } else {
        PG8_STAGE(PG8_SB(0, 0), cB, voffB); PG8_STAGE(PG8_SA(0, 0), cA, voffA); PG8_STAGE(PG8_SB(0, 1), cB + hstepB, voffB); PG8_STAGE(PG8_SA(0, 1), cA + hstepA, voffA);
        if (wr == 1) PG8_BAR;
        PG8_WAIT_V(4); PG8_BAR;
        PG8_STAGE(PG8_SB(1, 0), cB + kstepB, voffB); PG8_STAGE(PG8_SA(1, 0), cA + kstepA, voffA); PG8_STAGE(PG8_SB(1, 1), cB + hstepB + kstepB, voffB);
        PG8_WAIT_V(6); PG8_BAR;
    }
    for (;;) {
        const bool has_next = S.next(ui + 1, nxt);
        if constexpr (I8) {
            const float* sp_ = tid < 256 ? g.sA + cur.pm * BM + tid : g.sB + cur.pn * BM + (tid - 256);
            __builtin_amdgcn_global_load_lds((const unsigned*)sp_, (PG8_LAS unsigned*)(lds + STAGE_BYTES + (ui & 1) * 2048 + wid * 256), 4, 0, 0); }
        const char* nA = has_next ? (const char*)g.A + (size_t)nxt.pm * tstepA + (size_t)(nxt.ko / BK) * kstepA : cA; const char* nB = has_next ? (const char*)g.Bt + (size_t)nxt.pn * tstepB + (size_t)(nxt.ko / BK) * kstepB : cB;
        for (int t = 0; t < nt; t += 2) {
            const bool last = (t == nt - 2);
            const char* a1 = cA + (size_t)(t + 1) * kstepA;
            const char* a2 = last ? nA : cA + (size_t)(t + 2) * kstepA; const char* b2 = last ? nB : cB + (size_t)(t + 2) * kstepB;
            const char* a3 = a2 + kstepA; const char* b3 = b2 + kstepB;
            if (last && has_next) S.a_ready(nxt);
            if constexpr (SP2) {
            PG8_LDB(B0, 0, 0); PG8_LDB(B1, 0, 1); PG8_SCHED; PG8_LDA(At, 0, 0); PG8_STAGE(PG8_SA(1, 1), a1 + hstepA, voffA);
            PG8_WAIT_V(8); PG8_WAIT_L(0); PG8_BAR; PG8_MMA(0, 0, At, B0); PG8_MMA(0, 1, At, B1); PG8_BAR; PG8_SCHED;
            PG8_LDA(At, 0, 1); PG8_STAGE(PG8_SB(0, 0), b2, voffB); PG8_STAGE(PG8_SB(0, 1), b2 + hstepB, voffB); PG8_STAGE(PG8_SA(0, 0), a2, voffA);
            PG8_WAIT_V(8); PG8_WAIT_L(0); PG8_BAR; PG8_MMA(1, 0, At, B0); PG8_MMA(1, 1, At, B1); PG8_BAR; PG8_SCHED;
            PG8_LDB(B0, 1, 0); PG8_LDB(B1, 1, 1); PG8_SCHED; PG8_LDA(At, 1, 0); PG8_STAGE(PG8_SA(0, 1), a2 + hstepA, voffA);
            PG8_WAIT_V(8); PG8_WAIT_L(0); PG8_BAR; PG8_MMA(0, 0, At, B0); PG8_MMA(0, 1, At, B1); PG8_BAR; PG8_SCHED;
            PG8_LDA(At, 1, 1); PG8_STAGE(PG8_SB(1, 0), b3, voffB); PG8_STAGE(PG8_SB(1, 1), b3 + hstepB, voffB); PG8_STAGE(PG8_SA(1, 0), a3, voffA);
            PG8_WAIT_V(8); PG8_WAIT_L(0); PG8_BAR; PG8_MMA(1, 0, At, B0); PG8_MMA(1, 1, At, B1); PG8_BAR; PG8_SCHED;
            } else {
            PG8_LDB(B0, 0, 0); PG8_SCHED; PG8_LDA(At, 0, 0); PG8_STAGE(PG8_SA(1, 1), a1 + hstepA, voffA);
            PG8_WAIT_L(8); PG8_BAR; PG8_WAIT_L(0); PG8_MMA(0, 0, At, B0); PG8_BAR; PG8_SCHED;
            PG8_LDB(B1, 0, 1); PG8_STAGE(PG8_SB(0, 0), b2, voffB);
            PG8_BAR; PG8_WAIT_L(0); PG8_MMA(0, 1, At, B1); PG8_BAR;
            PG8_LDA(At, 0, 1); PG8_STAGE(PG8_SA(0, 0), a2, voffA);
            PG8_BAR; PG8_WAIT_L(0); PG8_MMA(1, 0, At, B0); PG8_BAR; PG8_SCHED;
            PG8_STAGE(PG8_SB(0, 1), b2 + hstepB, voffB);
            PG8_WAIT_V(6); PG8_BAR; PG8_MMA(1, 1, At, B1); PG8_BAR;
            PG8_LDB(B0, 1, 0); PG8_SCHED; PG8_LDA(At, 1, 0); PG8_STAGE(PG8_SA(0, 1), a2 + hstepA, voffA);
            PG8_WAIT_L(8); PG8_BAR; PG8_WAIT_L(0); PG8_MMA(0, 0, At, B0); PG8_BAR; PG8_SCHED;
            PG8_LDB(B1, 1, 1); PG8_STAGE(PG8_SB(1, 0), b3, voffB);
            PG8_BAR; PG8_WAIT_L(0); PG8_MMA(0, 1, At, B1); PG8_BAR;
            PG8_LDA(At, 1, 1); PG8_STAGE(PG8_SA(1, 0), a3, voffA);
            PG8_BAR; PG8_WAIT_L(0); PG8_MMA(1, 0, At, B0); PG8_BAR; PG8_SCHED;
            PG8_STAGE(PG8_SB(1, 1), b3 + hstepB, voffB);
            PG8_WAIT_V(6); PG8_BAR; PG8_MMA(1, 1, At, B1); PG8_BAR;
            }
        }
        if constexpr (ALIGN_EPI) { if (wr == 0) PG8_BAR; }
        if constexpr (!Epi::AFTER_DRAIN) { if constexpr (I8) { _Pragma("nounroll") for (int er_ = 0; er_ < REP_EPI8; ++er_) { f32x4 facc[2][2][4][2]; dequant<Epi::PERM>(acc, facc, (const PG8_LAS float*)(lds + STAGE_BYTES + (ui & 1) * 2048), wr, wc, fr, fq); E(facc, cur, wr, wc, fr, fq); } } else { E(acc, cur, wr, wc, fr, fq); } S.done(cur); }
        if (!has_next) break;
#pragma unroll
        for (int a = 0; a < 2; ++a)
#pragma unroll
            for (int b = 0; b < 2; ++b)
#pragma unroll
                for (int m = 0; m < 4; ++m)
#pragma unroll
                    for (int n = 0; n < 2; ++n) acc[a][b][m][n] = (acc_t){0, 0, 0, 0};
        cur = nxt; cA = nA; cB = nB; ++ui;
        if constexpr (ALIGN_EPI) { if (wr == 1) PG8_BAR; }
    }
    PG8_WAIT_V(0);
    if constexpr (!ALIGN_EPI) { if (wr == 0) PG8_BAR; }
    PG8_BAR;
    if constexpr (Epi::AFTER_DRAIN) { E.fused(acc, cur, wr, wc, fr, fq, lds, wid, lane); S.done(cur); }
#undef PG8_SA
#undef PG8_SB
#undef PG8_STAGE
#undef PG8_LDA
#undef PG8_LDB
#undef PG8_MMA
#undef PG8_WAIT_V
#undef PG8_WAIT_L
#undef PG8_BAR
#undef PG8_SCHED
}
}
#define GAS __attribute__((address_space(1)))
#define LAS __attribute__((address_space(3)))
typedef unsigned short bf16;
typedef unsigned v4u __attribute__((ext_vector_type(4)));
typedef float f32x4 __attribute__((ext_vector_type(4)));
typedef short bf16x8 __attribute__((ext_vector_type(8)));
typedef GAS unsigned gu32;
typedef GAS unsigned long long gu64;
#define RLX_AGENT __ATOMIC_RELAXED, __HIP_MEMORY_SCOPE_AGENT
#define LDS_WAIT() asm volatile("s_waitcnt lgkmcnt(0)" ::: "memory")
#define VM_WAIT() asm volatile("s_waitcnt vmcnt(0)" ::: "memory")
__device__ __forceinline__ unsigned long long rt() { return __builtin_amdgcn_s_memrealtime(); }
__device__ __forceinline__ unsigned f2bf(float f) { unsigned u = __builtin_bit_cast(unsigned, f); return (u + 0x7fffu + ((u >> 16) & 1u)) >> 16; }
__device__ __forceinline__ unsigned pk2(float lo, float hi) { return f2bf(lo) | (f2bf(hi) << 16); }

#define XB_TMO      128
#define XB_XCNT(j)  (256  + 64 * (j))
#define XB_XSUB(j)  (1280 + 64 * (j))
#define XB_XGEN(j)  (2304 + 64 * (j))
#define XB_TOP      3328
#define XB_TOPGEN   3392
#define XCD_BAR_WORDS 3456
#define XB_SPIN_CAP (1u << 22)

__device__ __forceinline__ unsigned xb_ld(unsigned* p)              { return __hip_atomic_load(p, __ATOMIC_RELAXED, __HIP_MEMORY_SCOPE_AGENT); }
__device__ __forceinline__ unsigned xb_add(unsigned* p, unsigned v) { return __hip_atomic_fetch_add(p, v, __ATOMIC_RELAXED, __HIP_MEMORY_SCOPE_AGENT); }
__device__ __forceinline__ unsigned xb_xcc_id() { return (unsigned)__builtin_amdgcn_s_getreg((3 << 11) | 20) & 0xFu; }
#define XB_SPIN(cond, bar) do { unsigned _sp = 0; while (cond) { __builtin_amdgcn_s_sleep(1); \
    if ((++_sp & 255u) == 0u) { if (xb_ld(&(bar)[XB_TMO])) break; if (_sp > XB_SPIN_CAP) { atomicAdd(&(bar)[XB_TMO], 1u); break; } } } } while (0)

struct XcdBarrier {
    unsigned* bar; unsigned x;
    volatile LAS unsigned* st;
};

__device__ __forceinline__ XcdBarrier xcd_barrier_post(unsigned* bar, volatile LAS unsigned* st) {
    XcdBarrier b; b.bar = bar; b.x = xb_xcc_id(); b.st = st;
    if (threadIdx.x == 0) (void)xb_add(&bar[XB_XCNT(b.x)], 1u);
    return b;
}
__device__ __forceinline__ void xcd_barrier_complete(unsigned* bar, unsigned x, unsigned& nloc, unsigned& nx) {
    const unsigned G = gridDim.x * gridDim.y * gridDim.z;
    unsigned sum, cnt, mine, sp = 0u;
    for (;;) {
        sum = 0u; cnt = 0u; mine = 0u;
#pragma unroll
        for (unsigned j = 0; j < 16; ++j) { const unsigned c = xb_ld(&bar[XB_XCNT(j)]); sum += c; cnt += (c > 0u) ? 1u : 0u; mine = (j == x) ? c : mine; }
        if (sum == G) break;
        __builtin_amdgcn_s_sleep(1);
        if ((++sp & 255u) == 0u) { if (xb_ld(&bar[XB_TMO])) break; if (sp > XB_SPIN_CAP) { atomicAdd(&bar[XB_TMO], 1u); break; } }
    }
    nloc = mine > 0u ? mine : 1u; nx = cnt > 0u ? cnt : 1u;
}

__device__ __forceinline__ void xcd_barrier(const XcdBarrier& b) {
    asm volatile("s_waitcnt vmcnt(0)" ::: "memory");
    __syncthreads();
    if (threadIdx.x == 0) {
        unsigned* bar = b.bar;
        __builtin_amdgcn_s_waitcnt(0);
        unsigned nloc = b.st[0], nx = b.st[1];
        if (nloc == 0u) { xcd_barrier_complete(bar, b.x, nloc, nx); b.st[0] = nloc; b.st[1] = nx; }
        const unsigned old = xb_add(&bar[XB_XSUB(b.x)], 1u);
        const unsigned gen = old / nloc;
        if (old + 1u == (gen + 1u) * nloc) {
            __builtin_amdgcn_fence(__ATOMIC_RELEASE, "agent");
            asm volatile("s_waitcnt vmcnt(0)" ::: "memory");
            const unsigned og = xb_add(&bar[XB_TOP], 1u);
            const unsigned tg = og / nx;
            if (og + 1u == (tg + 1u) * nx) xb_add(&bar[XB_TOPGEN], 1u);
            else XB_SPIN(xb_ld(&bar[XB_TOPGEN]) == tg, bar);
            __builtin_amdgcn_fence(__ATOMIC_ACQUIRE, "agent");
            xb_add(&bar[XB_XGEN(b.x)], 1u);
            asm volatile("s_waitcnt vmcnt(0)" ::: "memory");
        } else {
            XB_SPIN(xb_ld(&bar[XB_XGEN(b.x)]) == gen, bar);
            __builtin_amdgcn_fence(__ATOMIC_ACQUIRE, "agent");
            asm volatile("s_waitcnt vmcnt(0)" ::: "memory");
        }
    }
    __syncthreads();
}

constexpr int NWAVES = 8;
constexpr int GRID = 256;
constexpr int BATCH = 2, T = 8192, D = 1024, M = BATCH * T;
constexpr int HG_H = 8;
constexpr int SB_H = 16, SB_D = 64;
constexpr int FFD = 2816, FFE = 3584, NE = 8;
constexpr int MROWS = 2 * M + NE * 256, MRT = MROWS / 256;
constexpr float EPS = 1e-6f;
constexpr float QSCALE = 0.125f * 1.44269504089f;

constexpr size_t MiB = 1u << 20;
constexpr size_t WS_CTL = 0, CTL_ZERO_BYTES = 1 * MiB;
constexpr size_t WS_TAB = 1 * MiB;
constexpr size_t TAB_LB = WS_TAB, TAB_HIST = WS_TAB + 16384, TAB_TILE = WS_TAB + 32768, TAB_TOKE = WS_TAB + 65536, TAB_TOKG = WS_TAB + 262144, TAB_TOKP = WS_TAB + 524288;
constexpr size_t WS_WIN = 8 * MiB, WS_WOUT = 24 * MiB, WS_WQ = 28 * MiB, WS_WK = 32 * MiB, WS_WV = 34 * MiB, WS_WO = 36 * MiB, WS_WGU = 40 * MiB, WS_WDN = 62 * MiB;
constexpr size_t WS_WMGU = 80 * MiB, WS_WMDN = 192 * MiB, WS_WMDN2 = 80 * MiB;
constexpr size_t WS_WMGU_UNUSED_ = 0;
constexpr size_t WS_XN = 248 * MiB;
constexpr size_t WS_K = 280 * MiB, WS_VT = 312 * MiB;
constexpr size_t WS_S = 344 * MiB;
constexpr size_t WS_QS = WS_S, WS_KK = WS_S + 32 * MiB, WS_VV = WS_S + 64 * MiB, WS_GG = WS_S + 96 * MiB, WS_LF = WS_S + 128 * MiB, WS_OR = WS_S + 192 * MiB, WS_OG = WS_S + 256 * MiB;
constexpr size_t WS_HB = WS_S;
constexpr size_t WS_XP = WS_S, WS_HM = WS_S + 68 * MiB, WS_Y = WS_S + 306 * MiB;
constexpr int MOE_RKS = 2, MOE_RKL = FFE / MOE_RKS;
constexpr size_t WS_Y0 = WS_XP;
constexpr size_t WS_YR = WS_Y, YR_STRIDE = (size_t)NE * 256 * D;
constexpr size_t WS_Q = WS_S, WS_AO = WS_S + 32 * MiB;
constexpr size_t WS_END0 = WS_S + 442 * MiB;
constexpr size_t WS_XQ = WS_XN, WS_SA = WS_XN + 16 * MiB, WS_SAP = WS_XN + 17 * MiB, WS_SB = WS_XN + 18 * MiB, WS_SBM = WS_XN + 19 * MiB;
constexpr size_t WS_XPQ = WS_XP;
constexpr size_t WS_WM8 = WS_END0, WS_W8 = WS_END0 + 56 * MiB;
constexpr int W8_ROWS = (int)((WS_WDN - WS_WIN) / 2048), WM8_ROWS = NE * 2 * FFE;
constexpr size_t WS_END = WS_W8 + 27 * MiB;
static_assert(WS_HM + (size_t)MROWS * FFE * 2 <= WS_Y && WS_YR + (size_t)MOE_RKS * YR_STRIDE * 2 <= WS_END0 && (size_t)W8_ROWS * D <= 27 * MiB && WS_END <= 896 * MiB && WS_XP + (size_t)MROWS * D * 2 <= WS_HM, "MoE scratch map");
static_assert(WS_WDN + (size_t)2 * D * FFD * 2 <= WS_WMGU && WS_WMGU + (size_t)NE * 2 * FFE * D * 2 <= WS_WMDN && WS_WMDN + (size_t)NE * D * FFE * 2 <= WS_XN, "weight map");
constexpr int CW_BAR = 4096;
constexpr int CW_ZTAB = 16384;

constexpr int RING_OFF = 0, RING_BYTES = 131072;
constexpr int LDSCTL_OFF = 135168, MISC_OFF = LDSCTL_OFF + 320;
constexpr int LDS_BYTES = 147456;

struct Args { const float* in[18]; float* out; unsigned char* ws; int ph_lo, ph_hi; };
typedef const __attribute__((address_space(4))) Args* CArgsP;
__device__ __forceinline__ CArgsP kargs() { CArgsP p = (CArgsP)__builtin_amdgcn_kernarg_segment_ptr(); asm volatile("" : "+s"(p)); return p; }
__device__ __forceinline__ int lg(int v) { asm volatile("" : "+s"(v)); return v; }
__device__ __forceinline__ unsigned char* wsbase() { return kargs()->ws; }
typedef float f32x2 __attribute__((ext_vector_type(2)));
struct Frame;
#define PHASE_LOCALS const int blk = lg((int)blockIdx.x); Frame F = F_; { int t_ = F_.tid; asm volatile("" : "+v"(t_)); F.tid = t_; F.lane = t_ & 63; F.wave = lg(F_.wave); F.vcu = lg(F_.vcu); F.G = lg(F_.G); } (void)blk;
struct Frame {
    LAS unsigned char* lds;
    volatile LAS unsigned* MISC;
    int tid, lane, wave;
    int vcu, G;
};

__device__ __forceinline__ float wave_sum(float v) {
#pragma unroll
    for (int o = 1; o < 64; o <<= 1) v += __shfl_xor(v, o);
    return v;
}
__device__ __forceinline__ float bf_lo(unsigned u) { return __uint_as_float(u << 16); }
__device__ __forceinline__ float bf_hi(unsigned u) { return __uint_as_float(u & 0xffff0000u); }
__device__ __forceinline__ float bf2f(bf16 b) { return __uint_as_float((unsigned)b << 16); }
typedef __bf16 bf16x2_t __attribute__((ext_vector_type(2)));
__device__ __forceinline__ unsigned cvtpk(float lo, float hi) { f32x2 v = {lo, hi}; bf16x2_t b = __builtin_convertvector(v, bf16x2_t); return __builtin_bit_cast(unsigned, b); }

struct CItem { const float* W; const float* gain; bf16* WT; int pitch, ldk, k0, drow0, ktm; float scale; };
__device__ __forceinline__ CItem cmat(int r, const float* W, int pitch, int c0, int nc, const float* gain, float scale, bf16* WT, int ldk, int il, int ktm = 0) {
    const int nb = nc / 64, kb = r / nb, n0 = (r % nb) * 64;
    CItem c; c.W = W + c0 + n0; c.gain = gain; c.WT = WT; c.pitch = pitch; c.ldk = ldk; c.k0 = kb * 64; c.scale = scale; c.ktm = ktm;
    c.drow0 = il == 0 ? n0 : (n0 >> 7) * 256 + (il - 1) * 128 + (n0 & 127);
    return c;
}
constexpr int CONV_DENSE_ITEMS = 2 * (256 + 256 + 704), CONV_MOE_PER = 896, CONV_MOE_ITEMS = 8 * CONV_MOE_PER;
__device__ __forceinline__ CItem conv_decode(int it, bool dense, int ml, unsigned char* ws_) {
#define in (kargs()->in)
    int r = it;
    if (dense) {
        if (r < CONV_DENSE_ITEMS) {
#pragma unroll
            for (int l = 0; l < 2; ++l) {
                if (r < 256) return cmat(r, in[6] + (size_t)l * D * D, D, 0, D, nullptr, 1.0f, (bf16*)(ws_ + WS_WOUT) + (size_t)l * D * D, D, 0); r -= 256;
                if (r < 256) return cmat(r, in[10] + (size_t)l * D * D, D, 0, D, nullptr, 1.0f, (bf16*)(ws_ + WS_WO) + (size_t)l * D * D, D, 0); r -= 256;
                if (l == 0) { if (r < 704) return cmat(r, in[12], D, 0, D, nullptr, 1.0f, (bf16*)(ws_ + WS_WDN), FFD, 0, D); r -= 704; }
            }
            return cmat(r, in[12] + (size_t)FFD * D, D, 0, D, nullptr, 1.0f, (bf16*)(ws_ + WS_WDN) + (size_t)D * FFD, FFD, 0, D);
        }
        r -= CONV_DENSE_ITEMS;
    }
    const int e = r / CONV_MOE_PER, loc = r % CONV_MOE_PER; const size_t eo = (size_t)(ml * NE + e) * D * FFE;
    { CItem c = cmat(loc, in[16] + eo, D, 0, D, nullptr, 1.0f, (bf16*)(ws_ + (ml == 0 ? WS_WMDN : WS_WMDN2)), FFE, 0, NE * D); c.drow0 += e * D; return c; }
#undef in
}
__device__ __forceinline__ void conv_load(const CItem& c, int lane, f32x4 (&v)[16]) {
    const float* p = c.W + (size_t)(c.k0 + (lane >> 4)) * c.pitch + 4 * (lane & 15);
#pragma unroll
    for (int i = 0; i < 16; ++i) v[i] = __builtin_nontemporal_load((const GAS f32x4*)(p + (size_t)(4 * i) * c.pitch));
}
__device__ __forceinline__ void conv_store(const CItem& c, int lane, const f32x4 (&v)[16], LAS float* scr) {
    const int kr = lane >> 4, nc4 = 4 * (lane & 15);
#pragma unroll
    for (int i = 0; i < 16; ++i) { const float g = c.gain ? c.gain[c.k0 + 4 * i + kr] * c.scale : c.scale; LAS float* p = scr + (4 * i + kr) * 65 + nc4;
        p[0] = v[i].x * g; p[1] = v[i].y * g; p[2] = v[i].z * g; p[3] = v[i].w * g; }
    LDS_WAIT(); asm volatile("" ::: "memory");
    const int ch = lane & 7;
#pragma unroll
    for (int j = 0; j < 8; ++j) { const int n = (lane >> 3) + 8 * j; const LAS float* s = scr + (8 * ch) * 65 + n;
        v4u o; o.x = pk2(s[0 * 65], s[1 * 65]); o.y = pk2(s[2 * 65], s[3 * 65]); o.z = pk2(s[4 * 65], s[5 * 65]); o.w = pk2(s[6 * 65], s[7 * 65]);
        bf16* dp = c.ktm ? c.WT + ((size_t)(c.k0 >> 6) * c.ktm + (c.drow0 + n)) * 64 + 8 * ch : c.WT + (size_t)(c.drow0 + n) * c.ldk + c.k0 + 8 * ch;
        *(GAS v4u*)dp = o; }
    LDS_WAIT(); asm volatile("" ::: "memory");
}
__device__ __forceinline__ void conv_all(Frame& F_, bool dense, int ml) {
    PHASE_LOCALS
    unsigned char* const ws_ = kargs()->ws;
    LAS float* scr = (LAS float*)(F.lds + RING_OFF + F.wave * 16640);
    const int gw = F.vcu * NWAVES + F.wave, NGW = F.G * NWAVES, n = (dense ? CONV_DENSE_ITEMS : 0) + CONV_MOE_ITEMS;
    int it = gw;
    if (it >= n) return;
    CItem cur = conv_decode(it, dense, ml, ws_); f32x4 v[16]; conv_load(cur, F.lane, v);
    for (;;) {
        const int itn = it + NGW; const bool more = itn < n;
        CItem nxt = cur; f32x4 vn[16];
        if (more) { nxt = conv_decode(itn, dense, ml, ws_); conv_load(nxt, F.lane, vn); }
        conv_store(cur, F.lane, v, scr);
        if (!more) break;
        cur = nxt; it = itn;
#pragma unroll
        for (int i = 0; i < 16; ++i) v[i] = vn[i];
    }
}

__device__ __forceinline__ void conv_one_moe_down(int item, int ml, unsigned char* ws_, LAS unsigned char* ldsb, int wave, int lane) {
    const CItem c = conv_decode(item, false, ml, ws_); f32x4 v[16]; conv_load(c, lane, v);
    conv_store(c, lane, v, (LAS float*)(ldsb + wave * 16640));
}
__device__ __forceinline__ void store_xn(bf16* XN, int m, int lane, const f32x4 (&v)[4], float rstd) {
    GAS unsigned long long* o8 = (GAS unsigned long long*)(XN + (size_t)m * D) + lane;
#pragma unroll
    for (int j = 0; j < 4; ++j) o8[64 * j] = (unsigned long long)pk2(v[j].x * rstd, v[j].y * rstd) | ((unsigned long long)pk2(v[j].z * rstd, v[j].w * rstd) << 32);
}
__device__ __forceinline__ void store_xq(unsigned char* ws_, int m, int lane, const f32x4 (&v)[4], float rstd) {
    float am = 0.f;
#pragma unroll
    for (int j = 0; j < 4; ++j) am = fmaxf(fmaxf(am, fmaxf(fabsf(v[j].x), fabsf(v[j].y))), fmaxf(fabsf(v[j].z), fabsf(v[j].w)));
#pragma unroll
    for (int o = 1; o < 64; o <<= 1) am = fmaxf(am, __shfl_xor(am, o));
    am *= rstd;
    const float inv = am > 0.f ? 127.0f / am : 0.f, k = rstd * inv;
    GAS unsigned* o4 = (GAS unsigned*)(ws_ + WS_XQ + (size_t)m * D) + lane;
#pragma unroll
    for (int j = 0; j < 4; ++j) { const int a = (int)rintf(v[j].x * k), b = (int)rintf(v[j].y * k), c = (int)rintf(v[j].z * k), d = (int)rintf(v[j].w * k);
        o4[64 * j] = (unsigned)(a & 255) | ((unsigned)(b & 255) << 8) | ((unsigned)(c & 255) << 16) | ((unsigned)(d & 255) << 24); }
    if (lane == 0) ((GAS float*)(ws_ + WS_SA))[m] = am * (1.0f / 127.0f);
}
struct C8Item { const float* W; const float* gain; unsigned char* D8; float* SBp; int pitch; float scale; };
__device__ __forceinline__ C8Item c8mat(int r, const float* W, int pitch, int c0, const float* gain, float scale, unsigned char* W8base, float* SBbase, int row0, int il) {
    const int n0 = r * 64, drow = row0 + (il == 0 ? n0 : (n0 >> 7) * 256 + (il - 1) * 128 + (n0 & 127));
    C8Item c; c.W = W + c0 + n0; c.gain = gain; c.pitch = pitch; c.scale = scale; c.D8 = W8base + (size_t)drow * D; c.SBp = SBbase + drow; return c;
}
constexpr int C8_DENSE_ITEMS = 2 * (64 + 16 + 44 + 44) + 16 + 16, C8_MOE_ITEMS = 16 * 56;
constexpr int R_WIN = 0, R_WQ = (int)((WS_WQ - WS_WIN) / 2048), R_WK = (int)((WS_WK - WS_WIN) / 2048), R_WV = (int)((WS_WV - WS_WIN) / 2048), R_WGU = (int)((WS_WGU - WS_WIN) / 2048);
__device__ __forceinline__ C8Item conv8_decode(int it, bool dense, int ml, unsigned char* ws_) {
#define in (kargs()->in)
    int r = it; unsigned char* W8 = ws_ + WS_W8; float* SBd = (float*)(ws_ + WS_SB);
    if (dense) {
        if (r < C8_DENSE_ITEMS) {
#pragma unroll
            for (int l = 0; l < 2; ++l) {
                if (r < 64) return c8mat(r, in[3] + (size_t)l * D * 4 * D, 4 * D, 0, in[1] + l * D, 1.0f, W8, SBd, R_WIN + l * 4 * D, 0); r -= 64;
                if (r < 16) return c8mat(r, in[9] + (size_t)l * D * D, D, 0, in[1] + (2 + l) * D, QSCALE, W8, SBd, R_WQ + l * D, 0); r -= 16;
                if (r < 44) return c8mat(r, in[11] + (size_t)l * D * 2 * FFD, 2 * FFD, 0, in[2] + (2 * l) * D, 1.0f, W8, SBd, R_WGU + l * 2 * FFD, 1); r -= 44;
                if (r < 44) return c8mat(r, in[11] + (size_t)l * D * 2 * FFD, 2 * FFD, FFD, in[2] + (2 * l) * D, 1.0f, W8, SBd, R_WGU + l * 2 * FFD, 2); r -= 44;
            }
            if (r < 16) return c8mat(r, in[8], 2 * D, 0, in[7], 1.0f, W8, SBd, R_WK, 0); r -= 16;
            return c8mat(r, in[8], 2 * D, D, in[7], 1.0f, W8, SBd, R_WV, 0);
        }
        r -= C8_DENSE_ITEMS;
    }
    const int q = r / 56, loc = r % 56, ty = q >> 3, e = q & 7;
    return c8mat(loc, in[14 + ty] + (size_t)(ml * NE + e) * D * FFE, FFE, 0, in[2] + (2 * ml + 1) * D, 1.0f, ws_ + WS_WM8, (float*)(ws_ + WS_SBM), e * 2 * FFE, 1 + ty);
#undef in
}
__device__ __forceinline__ void conv8_all(Frame& F_, bool dense, int ml) {
    PHASE_LOCALS
    unsigned char* const ws_ = kargs()->ws;
    LAS bf16* TT = (LAS bf16*)(F.lds + RING_OFF);
    LAS float* CM = (LAS float*)(F.lds + RING_OFF + 132096);
    LAS float* CMX = CM + 512;
    const int n8 = (dense ? C8_DENSE_ITEMS : 0) + C8_MOE_ITEMS, lane = F.lane, kr = lane >> 4, nc4 = 4 * (lane & 15), kb = 128 * F.wave;
#define C8_LOAD(v_, c_, hf_) do { const float* p0_ = (c_).W + (size_t)(kb + 64 * (hf_) + kr) * (c_).pitch + nc4; const size_t st_ = (size_t)4 * (c_).pitch; \
        _Pragma("unroll") for (int i = 0; i < 16; ++i) (v_)[i] = __builtin_nontemporal_load((const GAS f32x4*)(p0_ + i * st_)); } while (0)
#define C8_PUT(v_, c_, hf_) do { _Pragma("unroll") for (int i = 0; i < 16; ++i) { const int k = kb + 64 * (hf_) + 4 * i + kr; const float g = (c_).gain ? (c_).gain[k] * (c_).scale : (c_).scale; \
        const unsigned b0 = f2bf((v_)[i].x * g), b1 = f2bf((v_)[i].y * g), b2 = f2bf((v_)[i].z * g), b3 = f2bf((v_)[i].w * g); \
        cm0 = fmaxf(cm0, fabsf(__uint_as_float(b0 << 16))); cm1 = fmaxf(cm1, fabsf(__uint_as_float(b1 << 16))); cm2 = fmaxf(cm2, fabsf(__uint_as_float(b2 << 16))); cm3 = fmaxf(cm3, fabsf(__uint_as_float(b3 << 16))); \
        TT[(nc4 + 0) * 1032 + k] = (bf16)b0; TT[(nc4 + 1) * 1032 + k] = (bf16)b1; TT[(nc4 + 2) * 1032 + k] = (bf16)b2; TT[(nc4 + 3) * 1032 + k] = (bf16)b3; } } while (0)
    int it = F.vcu;
    if (it >= n8) return;
    C8Item c = conv8_decode(it, dense, ml, ws_);
    f32x4 vA[16], vB[16];
    C8_LOAD(vA, c, 0);
    for (;;) {
        float cm0 = 0.f, cm1 = 0.f, cm2 = 0.f, cm3 = 0.f;
        C8_LOAD(vB, c, 1);
        __builtin_amdgcn_sched_barrier(0);
        C8_PUT(vA, c, 0);
        C8_PUT(vB, c, 1);
        cm0 = fmaxf(cm0, __shfl_xor(cm0, 16)); cm0 = fmaxf(cm0, __shfl_xor(cm0, 32)); cm1 = fmaxf(cm1, __shfl_xor(cm1, 16)); cm1 = fmaxf(cm1, __shfl_xor(cm1, 32));
        cm2 = fmaxf(cm2, __shfl_xor(cm2, 16)); cm2 = fmaxf(cm2, __shfl_xor(cm2, 32)); cm3 = fmaxf(cm3, __shfl_xor(cm3, 16)); cm3 = fmaxf(cm3, __shfl_xor(cm3, 32));
        if (lane < 16) { LAS float* p = CM + F.wave * 64 + nc4; p[0] = cm0; p[1] = cm1; p[2] = cm2; p[3] = cm3; }
        __syncthreads();
        if (F.tid < 64) { float m = 0.f;
#pragma unroll
            for (int w = 0; w < 8; ++w) m = fmaxf(m, CM[w * 64 + F.tid]);
            CMX[F.tid] = m; c.SBp[F.tid] = m * (1.0f / 127.0f); }
        __syncthreads();
        const int itn = it + F.G; const bool more = itn < n8; C8Item cn = c;
        if (more) { cn = conv8_decode(itn, dense, ml, ws_); C8_LOAD(vA, cn, 0); }
        __builtin_amdgcn_sched_barrier(0);
#pragma unroll 2
        for (int j = 0; j < 8; ++j) { const int idx = j * 512 + F.tid, n = idx >> 6, ch = idx & 63; const float m = CMX[n], inv = m > 0.f ? 127.0f / m : 0.f;
            const v4u a = *(const LAS v4u*)(TT + n * 1032 + 16 * ch), b = *(const LAS v4u*)(TT + n * 1032 + 16 * ch + 8);
            const unsigned wv[8] = {a.x, a.y, a.z, a.w, b.x, b.y, b.z, b.w}; unsigned q[4];
#pragma unroll
            for (int t = 0; t < 4; ++t) { const int q0 = (int)rintf(bf_lo(wv[2 * t]) * inv), q1 = (int)rintf(bf_hi(wv[2 * t]) * inv), q2 = (int)rintf(bf_lo(wv[2 * t + 1]) * inv), q3 = (int)rintf(bf_hi(wv[2 * t + 1]) * inv);
                q[t] = (unsigned)(q0 & 255) | ((unsigned)(q1 & 255) << 8) | ((unsigned)(q2 & 255) << 16) | ((unsigned)(q3 & 255) << 24); }
            *(GAS v4u*)(c.D8 + (size_t)n * D + 16 * ch) = (v4u){q[0], q[1], q[2], q[3]}; }
        __syncthreads();
        if (!more) break;
        c = cn; it = itn;
    }
#undef C8_LOAD
#undef C8_PUT
}
__device__ __forceinline__ float row_rstd(const f32x4 (&v)[4]) {
    float s = 0.f;
#pragma unroll
    for (int j = 0; j < 4; ++j) s += (v[j].x * v[j].x + v[j].y * v[j].y) + (v[j].z * v[j].z + v[j].w * v[j].w);
    return 1.0f / sqrtf(wave_sum(s) * (1.0f / D) + EPS);
}
__device__ __forceinline__ void norm_phase(Frame& F_, const float* X, bool route, const float* router  , const float* rgain  ) {
    PHASE_LOCALS
    unsigned char* const ws_ = kargs()->ws;
    LAS float* RGT = (LAS float*)(F.lds + RING_OFF);
    LAS int* hist = (LAS int*)(F.lds + RING_OFF + 32768);
    if (route) {
        for (int i = F.tid; i < D * NE; i += NWAVES * 64) { const int k = i >> 3, e = i & 7; RGT[e * D + k] = router[i] * rgain[k]; }
        if (F.tid < NE) hist[F.tid] = 0;
        __syncthreads();
    }
#pragma nounroll
    for (int i4 = 0; i4 < 8; i4 += 4) {
        f32x4 vv[4][4];
#pragma unroll
        for (int t = 0; t < 4; ++t) { const GAS f32x4* xr = (const GAS f32x4*)(X + (size_t)(blk * 64 + F.wave * 8 + i4 + t) * D) + F.lane;
#pragma unroll
            for (int j = 0; j < 4; ++j) vv[t][j] = xr[64 * j]; }
        __builtin_amdgcn_sched_barrier(0);
#pragma unroll
        for (int t = 0; t < 4; ++t) {
        const int m = blk * 64 + F.wave * 8 + i4 + t;
        f32x4 (&v)[4] = vv[t];
        const float rstd = row_rstd(v);
        store_xq(ws_, m, F.lane, v, rstd);
        if (route) {
            float lg[NE];
#pragma unroll
            for (int e = 0; e < NE; ++e) { float s = 0.f;
#pragma unroll
                for (int j = 0; j < 4; ++j) { const f32x4 r = *(const LAS f32x4*)(RGT + e * D + 4 * F.lane + 256 * j); s += (v[j].x * r.x + v[j].y * r.y) + (v[j].z * r.z + v[j].w * r.w); }
                lg[e] = wave_sum(s) * rstd; }
            float b0 = -3.0e38f, b1 = -3.0e38f; int i0 = 0, i1 = 0;
#pragma unroll
            for (int e = 0; e < NE; ++e) { if (lg[e] > b0) { b1 = b0; i1 = i0; b0 = lg[e]; i0 = e; } else if (lg[e] > b1) { b1 = lg[e]; i1 = e; } }
            if (F.lane == 0) { const float ex = __expf(b1 - b0), g0 = 1.0f / (1.0f + ex);
                ((GAS int*)(ws_ + TAB_TOKE))[2 * m] = i0; ((GAS int*)(ws_ + TAB_TOKE))[2 * m + 1] = i1;
                ((GAS float*)(ws_ + TAB_TOKG))[2 * m] = g0; ((GAS float*)(ws_ + TAB_TOKG))[2 * m + 1] = ex * g0;
                atomicAdd((int*)(hist + i0), 1); atomicAdd((int*)(hist + i1), 1); }
        }
        }
    }
    if (route) { __syncthreads(); if (F.tid < NE) ((GAS int*)(ws_ + TAB_HIST))[blk * NE + F.tid] = hist[F.tid]; }
}
__device__ __forceinline__ void scatter_phase(Frame& F_) {
    PHASE_LOCALS
    unsigned char* const ws_ = kargs()->ws;
    LAS int* h = (LAS int*)(F.lds + RING_OFF);
    LAS int* pre = h + 2048; LAS int* tot = pre + 8; LAS int* pst = tot + 8; LAS int* pos = pst + 16;
    const GAS int* HIST = (const GAS int*)(ws_ + TAB_HIST);
    for (int i = F.tid; i < GRID * NE; i += NWAVES * 64) h[i] = HIST[i];
    __syncthreads();
    if (F.tid < NE) { int p = 0, t = 0; for (int b = 0; b < GRID; ++b) { const int v = h[b * NE + F.tid]; p += (b < blk) ? v : 0; t += v; } pre[F.tid] = p; tot[F.tid] = t; }
    __syncthreads();
    if (F.tid == 0) { int s = 0; for (int e = 0; e < NE; ++e) { pst[e] = s; s += (tot[e] + 255) & ~255; } pst[NE] = s; }
    __syncthreads();
    if (F.wave == 0) {
        const int m = blk * 64 + F.lane;
        const int e0 = ((const GAS int*)(ws_ + TAB_TOKE))[2 * m], e1 = ((const GAS int*)(ws_ + TAB_TOKE))[2 * m + 1];
        int p0 = 0, p1 = 0; const unsigned long long lt = (1ull << F.lane) - 1ull;
#pragma unroll
        for (int e = 0; e < NE; ++e) { const unsigned long long mk = __ballot(e0 == e || e1 == e); const int rk = __popcll(mk & lt) + pst[e] + pre[e];
            if (e0 == e) p0 = rk; if (e1 == e) p1 = rk; }
        ((GAS int*)(ws_ + TAB_TOKP))[2 * m] = p0; ((GAS int*)(ws_ + TAB_TOKP))[2 * m + 1] = p1;
        pos[2 * F.lane] = p0; pos[2 * F.lane + 1] = p1;
    }
    if (blk == 0) { GAS int* TE = (GAS int*)(ws_ + TAB_TILE);
        LAS unsigned long long* wm = (LAS unsigned long long*)(pos + 128);
        const int nrt = pst[NE] >> 8, rt = F.tid;
        int e = NE - 1; bool full = false;
        if (rt < nrt) {
#pragma unroll
            for (int q = NE - 1; q >= 0; --q) if (rt * 256 < pst[q + 1]) e = q;
            TE[rt] = e; full = (rt + 1) * 256 <= pst[e] + tot[e]; }
        const unsigned long long bm = __ballot(full);
        if (F.lane == 0 && F.wave < 3) wm[F.wave] = bm;
        __syncthreads();
        if (rt < nrt) { int nfb = __popcll(bm & ((1ull << F.lane) - 1ull)); if (F.wave > 0) nfb += __popcll(wm[0]); if (F.wave > 1) nfb += __popcll(wm[1]);
            if (full) { TE[176 + nfb] = rt; TE[384 + rt] = -1; } else { TE[352 + rt - nfb] = rt; TE[384 + rt] = rt - nfb; }
            if (rt == nrt - 1) { const int nf = nfb + (full ? 1 : 0); TE[160] = nrt; TE[336] = nf; TE[368] = nrt - nf; } }
    }
    __syncthreads();
    const unsigned char* XQ = ws_ + WS_XQ; unsigned char* XPQ = ws_ + WS_XPQ;
    for (int i = 0; i < 8; ++i) { const int tl = F.wave * 8 + i, m = blk * 64 + tl, d0 = pos[2 * tl], d1 = pos[2 * tl + 1];
        const v4u a = *((const GAS v4u*)(XQ + (size_t)m * D) + F.lane);
        *((GAS v4u*)(XPQ + (size_t)d0 * D) + F.lane) = a; *((GAS v4u*)(XPQ + (size_t)d1 * D) + F.lane) = a;
        if (F.lane == 0) { const float sc = ((const GAS float*)(ws_ + WS_SA))[m]; ((GAS float*)(ws_ + WS_SAP))[d0] = sc; ((GAS float*)(ws_ + WS_SAP))[d1] = sc; } }
}
__device__ __forceinline__ void add_y(f32x4 (&a)[4], const unsigned char* ws_, int p, int j, int lane) {
    if (j < 0) { const GAS unsigned long long* y = (const GAS unsigned long long*)((const bf16*)(ws_ + WS_Y0) + (size_t)p * D) + lane;
#pragma unroll
        for (int c = 0; c < 4; ++c) { const unsigned long long w = y[64 * c]; a[c] = (f32x4){bf_lo((unsigned)w), bf_hi((unsigned)w), bf_lo((unsigned)(w >> 32)), bf_hi((unsigned)(w >> 32))}; } }
    else {
#pragma unroll
        for (int c = 0; c < 4; ++c) a[c] = (f32x4){0.f, 0.f, 0.f, 0.f};
#pragma unroll
        for (int k = 0; k < MOE_RKS; ++k) { const GAS unsigned long long* y = (const GAS unsigned long long*)((const bf16*)(ws_ + WS_YR) + (size_t)k * YR_STRIDE + (size_t)(j * 256 + (p & 255)) * D) + lane;
#pragma unroll
            for (int c = 0; c < 4; ++c) { const unsigned long long w = y[64 * c]; a[c] += (f32x4){bf_lo((unsigned)w), bf_hi((unsigned)w), bf_lo((unsigned)(w >> 32)), bf_hi((unsigned)(w >> 32))}; } } }
}
__device__ __forceinline__ void combine_phase(Frame& F_, float* X, bool last, const float* fgain) {
    PHASE_LOCALS
    unsigned char* const ws_ = kargs()->ws;
    int pp0 = 0, pp1 = 0, jj0 = -1, jj1 = -1; float gg0 = 0.f, gg1 = 0.f;
    if (F.lane < 8) { const int ml = blk * 64 + F.wave * 8 + F.lane;
        pp0 = ((const GAS int*)(ws_ + TAB_TOKP))[2 * ml]; pp1 = ((const GAS int*)(ws_ + TAB_TOKP))[2 * ml + 1];
        gg0 = ((const GAS float*)(ws_ + TAB_TOKG))[2 * ml]; gg1 = ((const GAS float*)(ws_ + TAB_TOKG))[2 * ml + 1];
        jj0 = ((const GAS int*)(ws_ + TAB_TILE))[384 + (pp0 >> 8)]; jj1 = ((const GAS int*)(ws_ + TAB_TILE))[384 + (pp1 >> 8)]; }
    for (int i = 0; i < 8; ++i) {
        const int m = blk * 64 + F.wave * 8 + i;
        const int p0 = __shfl(pp0, i), p1 = __shfl(pp1, i), j0 = __shfl(jj0, i), j1 = __shfl(jj1, i);
        const float g0 = __shfl(gg0, i), g1 = __shfl(gg1, i);
        GAS f32x4* xr = (GAS f32x4*)(X + (size_t)m * D) + F.lane;
        f32x4 v[4], a0[4], a1[4];
#pragma unroll
        for (int j = 0; j < 4; ++j) v[j] = xr[64 * j];
        add_y(a0, ws_, __builtin_amdgcn_readfirstlane(p0), __builtin_amdgcn_readfirstlane(j0), F.lane); add_y(a1, ws_, __builtin_amdgcn_readfirstlane(p1), __builtin_amdgcn_readfirstlane(j1), F.lane);
#pragma unroll
        for (int j = 0; j < 4; ++j) v[j] = v[j] + g0 * a0[j] + g1 * a1[j];
        const float rstd = row_rstd(v);
        if (last) {
#pragma unroll
            for (int j = 0; j < 4; ++j) { const f32x4 g = *((const GAS f32x4*)fgain + F.lane + 64 * j); xr[64 * j] = v[j] * rstd * g; }
        } else {
#pragma unroll
            for (int j = 0; j < 4; ++j) xr[64 * j] = v[j];
            store_xq(ws_, m, F.lane, v, rstd);
        }
    }
}

#define MFMA16(a, b, c) __builtin_amdgcn_mfma_f32_16x16x32_bf16((a), (b), (c), 0, 0, 0)
constexpr int HL_QH = 0, HL_KH = 17408, HL_KHT = 34816, HL_VT = 53248, HL_AS = 71680, HL_SPT = 80896, HL_QT = 115712, HL_EGM = 117760, HL_EGL = 118272, HL_PART = 118784;
constexpr size_t WS_LS = WS_OR, WS_SI = WS_OR + 16 * MiB, WS_GS = WS_OR + 32 * MiB;
template <int MODE> __device__ __forceinline__ void hgrn_chunks(Frame& F_, const float* gnorm) {
    PHASE_LOCALS
    unsigned char* const ws_ = kargs()->ws;
    const bf16* QS = (const bf16*)(ws_ + WS_QS); const bf16* VV = (const bf16*)(ws_ + WS_VV); const bf16* GG = (const bf16*)(ws_ + WS_GG);
    const _Float16* LF = (const _Float16*)(ws_ + WS_LF); bf16* OG = (bf16*)(ws_ + WS_OG);
    const int u = blk, bh = u >> 4, sc = u & 15, b = bh >> 3, h = bh & 7;
    const int tid = F.tid, lane = F.lane, w = F.wave, l15 = lane & 15, q = lane >> 4, d = tid & 127, tq = tid >> 7;
    LAS unsigned char* lds = F.lds + RING_OFF;
    LAS bf16* QH = (LAS bf16*)(lds + HL_QH); LAS bf16* KH = (LAS bf16*)(lds + HL_KH); LAS bf16* KHT = (LAS bf16*)(lds + HL_KHT); LAS bf16* VT = (LAS bf16*)(lds + HL_VT);
    LAS bf16* AS = (LAS bf16*)(lds + HL_AS); LAS bf16* SPT = (LAS bf16*)(lds + HL_SPT);
    LAS float* QT = (LAS float*)(lds + HL_QT); LAS float* EGM = (LAS float*)(lds + HL_EGM); LAS float* EGL = (LAS float*)(lds + HL_EGL); LAS float* PART = (LAS float*)(lds + HL_PART);
    if (MODE == 1) { for (int i = tid; i < 9216 / 4; i += NWAVES * 64) ((LAS unsigned*)AS)[i] = 0u; }
    f32x4 U[8];
    if (MODE == 1) { const float* si = (const float*)(ws_ + WS_SI) + (size_t)u * 16384 + 16 * w + l15;
#pragma unroll
        for (int dt = 0; dt < 8; ++dt)
#pragma unroll
            for (int rg = 0; rg < 4; ++rg) U[dt][rg] = si[(16 * dt + 4 * q + rg) * 128]; }
    else {
#pragma unroll
        for (int dt = 0; dt < 8; ++dt) U[dt] = (f32x4){0.f, 0.f, 0.f, 0.f}; }
    float gsum = 0.f;
    const float gn = (MODE == 1) ? gnorm[16 * w + l15] : 0.f;
    const size_t row0 = (size_t)b * T + (size_t)sc * 512;
    bf16 rq[16], rv[16]; _Float16 rl[16];
    { const size_t base = (row0 + 16 * tq) * D + h * 128 + d;
#pragma unroll
        for (int i = 0; i < 16; ++i) { const size_t off = base + (size_t)i * D; rq[i] = (MODE == 1) ? QS[off] : (bf16)0; rv[i] = VV[off]; rl[i] = LF[off]; } }
#pragma nounroll
    for (int c = 0; c < 8; ++c) {
        float qv[16], kv[16], vv[16], g[16];
#pragma unroll
        for (int i = 0; i < 16; ++i) { qv[i] = (MODE == 1) ? bf2f(rq[i]) : 0.f; vv[i] = bf2f(rv[i]); g[i] = (float)rl[i]; kv[i] = 1.0f - __expf(g[i]); }
        { const int cn = c < 7 ? c + 1 : 7; const size_t base = (row0 + cn * 64 + 16 * tq) * D + h * 128 + d;
#pragma unroll
            for (int i = 0; i < 16; ++i) { const size_t off = base + (size_t)i * D; if (MODE == 1) rq[i] = QS[off]; rv[i] = VV[off]; rl[i] = LF[off]; } }
        bf16 rg_[16];
        if (MODE == 1) {
#pragma unroll
            for (int ti = 0; ti < 4; ++ti)
#pragma unroll
                for (int rg = 0; rg < 4; ++rg) rg_[4 * ti + rg] = GG[(row0 + c * 64 + 16 * ti + 4 * q + rg) * D + h * 128 + 16 * w + l15]; }
        __builtin_amdgcn_sched_barrier(0);
#pragma unroll
        for (int i = 1; i < 16; ++i) g[i] += g[i - 1];
        QT[tq * 128 + d] = g[15];
        __syncthreads();
        { const float t0 = QT[d], t1 = QT[128 + d], t2 = QT[256 + d], t3 = QT[384 + d];
            const float basev = tq == 0 ? 0.f : (tq == 1 ? t0 : (tq == 2 ? t0 + t1 : t0 + t1 + t2));
            const float Gm = t0 + t1, Gl = (t0 + t1) + (t2 + t3), ref = (MODE == 1) ? Gm : Gl;
            unsigned kp[8], vp[8];
#pragma unroll
            for (int i = 0; i < 16; i += 2) {
                const float G0 = basev + g[i], G1 = basev + g[i + 1];
                const float kh0 = kv[i] * __expf(fminf(ref - G0, 80.f)), kh1 = kv[i + 1] * __expf(fminf(ref - G1, 80.f));
                kp[i >> 1] = cvtpk(kh0, kh1); vp[i >> 1] = cvtpk(vv[i], vv[i + 1]);
                if (MODE == 1) { const float qh0 = qv[i] * __expf(fminf(G0 - ref, 80.f)), qh1 = qv[i + 1] * __expf(fminf(G1 - ref, 80.f));
                    const unsigned qp = cvtpk(qh0, qh1); QH[(16 * tq + i) * 136 + d] = (bf16)(qp & 0xffffu); QH[(16 * tq + i + 1) * 136 + d] = (bf16)(qp >> 16);
                    KH[(16 * tq + i) * 136 + d] = (bf16)(kp[i >> 1] & 0xffffu); KH[(16 * tq + i + 1) * 136 + d] = (bf16)(kp[i >> 1] >> 16); } }
            *(LAS v4u*)(KHT + d * 72 + 16 * tq) = (v4u){kp[0], kp[1], kp[2], kp[3]}; *(LAS v4u*)(KHT + d * 72 + 16 * tq + 8) = (v4u){kp[4], kp[5], kp[6], kp[7]};
            *(LAS v4u*)(VT + d * 72 + 16 * tq) = (v4u){vp[0], vp[1], vp[2], vp[3]}; *(LAS v4u*)(VT + d * 72 + 16 * tq + 8) = (v4u){vp[4], vp[5], vp[6], vp[7]};
            if (tq == 0) { if (MODE == 1) { EGM[d] = __expf(Gm); EGL[d] = __expf(Gl - Gm); } else { EGL[d] = __expf(Gl); gsum += Gl; } } }
        __syncthreads();
        if (MODE == 1) for (int rb_ = 0; rb_ < REP_HCB; ++rb_) {
            for (int tix = w; tix < 10; tix += 8) { const int ti = tix >= 6 ? 3 : (tix >= 3 ? 2 : (tix >= 1 ? 1 : 0)), si = tix - ti * (ti + 1) / 2;
                f32x4 a = (f32x4){0.f, 0.f, 0.f, 0.f};
#pragma unroll
                for (int ks = 0; ks < 4; ++ks) a = MFMA16(*(const LAS bf16x8*)(QH + (16 * ti + l15) * 136 + 32 * ks + 8 * q), *(const LAS bf16x8*)(KH + (16 * si + l15) * 136 + 32 * ks + 8 * q), a);
#pragma unroll
                for (int rg = 0; rg < 4; ++rg) { const int t = 16 * ti + 4 * q + rg, sI = 16 * si + l15; AS[t * 72 + sI] = (bf16)(cvtpk(sI <= t ? a[rg] : 0.f, 0.f) & 0xffffu); } }
#pragma unroll
            for (int dt = 0; dt < 8; ++dt) { const f32x4 eg = *(const LAS f32x4*)(EGM + 16 * dt + 4 * q); if (rb_ == 0) U[dt] = U[dt] * eg;
                *(LAS unsigned long long*)(SPT + (16 * w + l15) * 136 + 16 * dt + 4 * q) = (unsigned long long)cvtpk(U[dt][0], U[dt][1]) | ((unsigned long long)cvtpk(U[dt][2], U[dt][3]) << 32); }
            __syncthreads();
        }
        bf16x8 Vf[2];
#pragma unroll
        for (int kk = 0; kk < 2; ++kk) Vf[kk] = *(const LAS bf16x8*)(VT + (16 * w + l15) * 72 + 32 * kk + 8 * q);
        if (MODE == 1) for (int rc_ = 0; rc_ < REP_HCC; ++rc_) { if (rc_) __syncthreads();
            bf16x8 Sf[4];
#pragma unroll
            for (int ks = 0; ks < 4; ++ks) Sf[ks] = *(const LAS bf16x8*)(SPT + (16 * w + l15) * 136 + 32 * ks + 8 * q);
            f32x4 o[4];
#pragma unroll
            for (int ti = 0; ti < 4; ++ti) { f32x4 a = (f32x4){0.f, 0.f, 0.f, 0.f};
#pragma unroll
                for (int kk = 0; kk < 2; ++kk) if (kk <= (ti >> 1)) a = MFMA16(*(const LAS bf16x8*)(AS + (16 * ti + l15) * 72 + 32 * kk + 8 * q), Vf[kk], a);
#pragma unroll
                for (int ks = 0; ks < 4; ++ks) a = MFMA16(*(const LAS bf16x8*)(QH + (16 * ti + l15) * 136 + 32 * ks + 8 * q), Sf[ks], a);
                o[ti] = a; }
#pragma unroll
            for (int ti = 0; ti < 4; ++ti)
#pragma unroll
                for (int rg = 0; rg < 4; ++rg) { float p = o[ti][rg] * o[ti][rg]; p += __shfl_xor(p, 1); p += __shfl_xor(p, 2); p += __shfl_xor(p, 4); p += __shfl_xor(p, 8);
                    if (l15 == 0) PART[w * 64 + 16 * ti + 4 * q + rg] = p; }
            __syncthreads();
#pragma unroll
            for (int ti = 0; ti < 4; ++ti)
#pragma unroll
                for (int rg = 0; rg < 4; ++rg) { const int t = 16 * ti + 4 * q + rg; float ss = 0.f;
#pragma unroll
                    for (int ww = 0; ww < 8; ++ww) ss += PART[ww * 64 + t];
                    const float rs = __builtin_amdgcn_rsqf(ss * (1.0f / 128.0f) + EPS);
                    const size_t off = (row0 + c * 64 + t) * D + h * 128 + 16 * w + l15;
                    OG[off] = (bf16)(cvtpk(o[ti][rg] * rs * gn * bf2f(rg_[4 * ti + rg]), 0.f) & 0xffffu); }
        }
        if (MODE == 0) {
#pragma unroll
            for (int dt = 0; dt < 8; ++dt) U[dt] = U[dt] * *(const LAS f32x4*)(EGL + 16 * dt + 4 * q); }
#pragma unroll
        for (int dt = 0; dt < 8; ++dt)
#pragma unroll
            for (int kk = 0; kk < 2; ++kk) U[dt] = MFMA16(*(const LAS bf16x8*)(KHT + (16 * dt + l15) * 72 + 32 * kk + 8 * q), Vf[kk], U[dt]);
        if (MODE == 1) {
#pragma unroll
            for (int dt = 0; dt < 8; ++dt) U[dt] = U[dt] * *(const LAS f32x4*)(EGL + 16 * dt + 4 * q); }
    }
    if (MODE == 0) { float* ls = (float*)(ws_ + WS_LS) + (size_t)u * 16384 + 16 * w + l15;
#pragma unroll
        for (int dt = 0; dt < 8; ++dt)
#pragma unroll
            for (int rg = 0; rg < 4; ++rg) ls[(16 * dt + 4 * q + rg) * 128] = U[dt][rg];
        if (tq == 0) ((float*)(ws_ + WS_GS))[u * 128 + d] = gsum; }
    __syncthreads();
}
__device__ __forceinline__ void hgrn_scan(Frame& F_) {
    PHASE_LOCALS
    unsigned char* const ws_ = kargs()->ws;
    const float* LS = (const float*)(ws_ + WS_LS); const float* GS = (const float*)(ws_ + WS_GS); float* SI = (float*)(ws_ + WS_SI);
    const int x = (blk * NWAVES * 64 + F.tid) * 2, bh = x >> 14, de = x & 16383, dd = de >> 7;
    f32x2 S = (f32x2){0.f, 0.f};
#pragma unroll
    for (int sc = 0; sc < 16; ++sc) { const int u = bh * 16 + sc;
        *(GAS f32x2*)(SI + (size_t)u * 16384 + de) = S;
        const float dec = __expf(GS[u * 128 + dd]); const f32x2 ls = *(const GAS f32x2*)(LS + (size_t)u * 16384 + de);
        S = dec * S + ls; }
}
typedef float f32x16 __attribute__((ext_vector_type(16)));
#define MFMA32(a, b, c) __builtin_amdgcn_mfma_f32_32x32x16_bf16((a), (b), (c), 0, 0, 0)
#define PACK8(x, s) __builtin_bit_cast(bf16x8, (v4u){cvtpk((x)[8 * (s)], (x)[8 * (s) + 1]), cvtpk((x)[8 * (s) + 2], (x)[8 * (s) + 3]), cvtpk((x)[8 * (s) + 4], (x)[8 * (s) + 5]), cvtpk((x)[8 * (s) + 6], (x)[8 * (s) + 7])})
__device__ __forceinline__ int swap23(int x) { return (x & ~12) | ((x & 4) << 1) | ((x & 8) >> 1); }
__device__ __forceinline__ void attn_mfma(Frame& F_, int cv_first, int cv_count) {
    PHASE_LOCALS
    unsigned char* const ws_ = kargs()->ws;
    const bf16* Q = (const bf16*)(ws_ + WS_Q); const bf16* K = (const bf16*)(ws_ + WS_K); const bf16* VT = (const bf16*)(ws_ + WS_VT); bf16* AO = (bf16*)(ws_ + WS_AO);
    const int lane = F.lane, r = lane & 31, hh = lane >> 5;
    bf16x8 Tf[2];
    { const int kout = swap23(r);
#pragma unroll
        for (int s = 0; s < 2; ++s)
#pragma unroll
            for (int j = 0; j < 8; ++j) Tf[s][j] = (16 * s + 8 * hh + j >= kout) ? (short)0xBF80 : (short)0; }
    const int gw = blk * NWAVES + F.wave, bh = gw >> 6, qa = gw & 63, b = bh >> 4, h = bh & 15;
    const bf16* Kb = K + (size_t)bh * 256 * 2048 + lane * 8;
    const bf16* Vb = VT + (size_t)bh * 256 * 2048 + lane * 8;
    bf16x8 Qp[4], Kp[4], Vp[4];
    { const int qt0 = qa; const bf16* qp = Q + (size_t)(b * T + qt0 * 32 + r) * D + h * 64 + 8 * hh; const bf16* kp = Kb + (size_t)qt0 * 2048; const bf16* vp = Vb + (size_t)qt0 * 2048;
#pragma unroll
        for (int x = 0; x < 4; ++x) { Qp[x] = *(const GAS bf16x8*)(qp + 16 * x); Kp[x] = *(const GAS bf16x8*)(kp + 512 * x); Vp[x] = *(const GAS bf16x8*)(vp + 512 * x); } }
#pragma nounroll
    for (int it = 0; it < 4; ++it) {
        const int qt = (it == 0) ? qa : (it == 1) ? 127 - qa : (it == 2) ? 128 + qa : 255 - qa, q0 = qt * 32;
        bf16x8 Qf[4], Kf[4], Vf[4], Kn[4], Vn[4];
#pragma unroll
        for (int x = 0; x < 4; ++x) { Qf[x] = Qp[x]; Kf[x] = Kp[x]; Vf[x] = Vp[x]; }
        { const int qn = (it == 0) ? 127 - qa : (it == 1) ? 128 + qa : 255 - qa;
            const bf16* qp = Q + (size_t)(b * T + qn * 32 + r) * D + h * 64 + 8 * hh; const bf16* kp = Kb + (size_t)qn * 2048; const bf16* vp = Vb + (size_t)qn * 2048;
#pragma unroll
            for (int x = 0; x < 4; ++x) { Qp[x] = *(const GAS bf16x8*)(qp + 16 * x); Kp[x] = *(const GAS bf16x8*)(kp + 512 * x); Vp[x] = *(const GAS bf16x8*)(vp + 512 * x); } }
        __builtin_amdgcn_sched_barrier(0);
        f32x16 O0, O1;
#pragma unroll
        for (int i = 0; i < 16; ++i) { O0[i] = 0.f; O1[i] = 0.f; }
        float R = 0.f;
        for (int kb = qt; kb >= 0; --kb) {
            { const int kn = kb > 0 ? kb - 1 : 0; const bf16* kp = Kb + (size_t)kn * 2048; const bf16* vp = Vb + (size_t)kn * 2048;
#pragma unroll
                for (int x = 0; x < 4; ++x) { Kn[x] = *(const GAS bf16x8*)(kp + 512 * x); Vn[x] = *(const GAS bf16x8*)(vp + 512 * x); } }
            __builtin_amdgcn_sched_barrier(0);
            f32x16 S;
#pragma unroll
            for (int i = 0; i < 16; ++i) S[i] = 0.f;
#pragma unroll
            for (int ks = 0; ks < 4; ++ks) S = MFMA32(Kf[ks], Qf[ks], S);
            f32x16 L;
            const bool diag = (kb == qt);
#pragma unroll
            for (int i = 0; i < 16; ++i) { const float z = fminf(S[i], 126.0f); S[i] = z; L[i] = __builtin_amdgcn_logf(1.0f + __builtin_amdgcn_exp2f(z)); }
            if (diag) {
#pragma unroll
                for (int i = 0; i < 16; ++i) { const int kl = (i & 3) + 4 * ((i >> 2) & 1) + 16 * (i >> 3) + 8 * hh; if (kl >= r) L[i] = 0.f; }
            }
            const bf16x8 L0 = PACK8(L, 0), L1 = PACK8(L, 1);
            const float z0 = S[0];
            S = MFMA32(Tf[0], L0, S); S = MFMA32(Tf[1], L1, S);
            const float tot = __shfl(z0 - S[0], r);
#pragma unroll
            for (int i = 0; i < 16; ++i) S[i] = __builtin_amdgcn_exp2f(S[i] + R);
            if (diag) {
#pragma unroll
                for (int i = 0; i < 16; ++i) { const int kl = (i & 3) + 4 * ((i >> 2) & 1) + 16 * (i >> 3) + 8 * hh; if (kl >= r) S[i] = 0.f; }
            }
            R -= tot;
            const bf16x8 P0 = PACK8(S, 0), P1 = PACK8(S, 1);
            O0 = MFMA32(Vf[0], P0, O0); O0 = MFMA32(Vf[1], P1, O0);
            O1 = MFMA32(Vf[2], P0, O1); O1 = MFMA32(Vf[3], P1, O1);
            if (__builtin_amdgcn_ballot_w64(R >= -150.0f) == 0ull) break;
#pragma unroll
            for (int x = 0; x < 4; ++x) { Kf[x] = Kn[x]; Vf[x] = Vn[x]; }
        }
        bf16* op = AO + (size_t)(b * T + q0 + r) * D + h * 64 + 4 * hh;
#pragma unroll
        for (int g = 0; g < 4; ++g) {
            *(GAS unsigned long long*)(op + 8 * g) = (unsigned long long)cvtpk(O0[4 * g], O0[4 * g + 1]) | ((unsigned long long)cvtpk(O0[4 * g + 2], O0[4 * g + 3]) << 32);
            *(GAS unsigned long long*)(op + 32 + 8 * g) = (unsigned long long)cvtpk(O1[4 * g], O1[4 * g + 1]) | ((unsigned long long)cvtpk(O1[4 * g + 2], O1[4 * g + 3]) << 32); }
        if ((it & 1) == 0) { const int ci = gw + (it >> 1) * (F.G * NWAVES); if (ci < cv_count) conv_one_moe_down(cv_first + ci, 1, ws_, F.lds + RING_OFF, F.wave, lane); }
    }
}

__device__ __forceinline__ void prologue(Frame& F_) {
    PHASE_LOCALS
    unsigned char* const ws_ = kargs()->ws;
#define in (kargs()->in)
    if (blk == 0) { GAS float* LB = (GAS float*)(ws_ + TAB_LB); const float* raw = in[4];
        for (int c = F.tid; c < D; c += NWAVES * 64) { const float a = raw[c], b = raw[D + c], mx = fmaxf(a, b), ea = __expf(a - mx), eb = __expf(b - mx); LB[c] = 0.f; LB[D + c] = eb / (ea + eb); } }
    conv8_all(F, true, 0);
    conv_all(F, true, 0);
    __syncthreads();
    norm_phase(F, in[0], false, nullptr, nullptr);
#undef in
}

#ifndef REP_PRO
#define REP_PRO 1
#endif
#ifndef REP_HGRN
#define REP_HGRN 1
#endif
#ifndef REP_HG0
#define REP_HG0 1
#endif
#ifndef REP_HG1
#define REP_HG1 1
#endif
#ifndef REP_ATTN
#define REP_ATTN 1
#endif
#ifndef REP_NORM
#define REP_NORM 1
#endif
#ifndef REP_CONV
#define REP_CONV 1
#endif
#ifndef REP_MDOWN
#define REP_MDOWN 1
#endif
#ifndef REP_MGU
#define REP_MGU 1
#endif
#ifndef REP_OUTP
#define REP_OUTP 1
#endif
#ifndef REP_DDOWN
#define REP_DDOWN 1
#endif
#ifndef REP_BAR
#define REP_BAR 1
#endif
#ifndef REP_SCAT
#define REP_SCAT 1
#endif
#ifndef REP_WIN
#define REP_WIN 1
#endif
#ifndef REP_DGU
#define REP_DGU 1
#endif
#ifndef REP_QKV
#define REP_QKV 1
#endif
#define REPEAT(n) _Pragma("nounroll") for (int rep_ = 0; rep_ < (n); ++rep_)

constexpr int NPH = 1 + (5 + 1 + 3) + (5 + 1 + 4) + (3 + 1 + 3) + (3 + 1 + 4);
__global__ void __launch_bounds__(NWAVES * 64, 2) yoco_fwd(Args) {
    extern __shared__ __attribute__((aligned(16))) unsigned char lds[];
    Frame F;
    F.lds = (LAS unsigned char*)lds;
    F.MISC = (volatile LAS unsigned*)(F.lds + MISC_OFF);
    F.tid = threadIdx.x; F.lane = F.tid & 63; F.wave = __builtin_amdgcn_readfirstlane(F.tid >> 6);
    F.G = gridDim.x; { const int bx = blockIdx.x; F.vcu = (F.G % 8 == 0) ? (bx % 8) * (F.G / 8) + bx / 8 : bx; }
    for (int u = F.tid; u < (LDS_BYTES - LDSCTL_OFF) / 4; u += NWAVES * 64) ((LAS unsigned*)(F.lds + LDSCTL_OFF))[u] = 0u;
    __syncthreads();
    const int lo = kargs()->ph_lo, hi = kargs()->ph_hi;
    XcdBarrier bar; bar.bar = (unsigned*)(kargs()->ws + WS_CTL) + CW_BAR; bar.x = 0; bar.st = nullptr;
    if (hi - lo > 1) bar = xcd_barrier_post((unsigned*)(kargs()->ws + WS_CTL) + CW_BAR, F.MISC + 8);
    int ph = 0;
#define PH_ON (ph >= lo && ph < hi)
#define PH_END do { if (ph >= lo && ph + 1 < hi) { XcdBarrier b2_; b2_.bar = (unsigned*)(wsbase() + WS_CTL) + CW_BAR; b2_.st = bar.st; b2_.x = lg((int)__builtin_amdgcn_readfirstlane(bar.x)); xcd_barrier(b2_); } ++ph; } while (0)
#define in (kargs()->in)
#define X (kargs()->out)
#define XQB ((const bf16*)(wsbase() + WS_XQ))
#define W8P(off) ((const bf16*)(wsbase() + WS_W8 + ((off) - WS_WIN) / 2))
#define SBP(off) ((const float*)(wsbase() + WS_SB) + ((off) - WS_WIN) / 2048)
#define SAPTR ((const float*)(wsbase() + WS_SA))
#define ws (wsbase())

    if (PH_ON) REPEAT(REP_PRO) { prologue(F); __syncthreads(); }
    PH_END;
#pragma nounroll
    for (int layer = 0; layer < 4; ++layer) {
        const bool hg = layer < 2, moe = (layer & 1) != 0;
        const int fi = layer >> 1;
        if (hg) {
            if (PH_ON) {
                const size_t wo = WS_WIN + (size_t)layer * 4 * D * D * 2;
                pg8::Gemm g{XQB, W8P(wo), M, 4 * D, D / 2, D / 2, 0, 0, 0, 0, SAPTR, SBP(wo)}; pg8::StaticOrder S; S.init(M, 4 * D, lg(F.G), lg((int)blockIdx.x));
                pg8::EpiHgrnIn E{(bf16*)(ws + WS_QS), (_Float16*)(ws + WS_LF), (const float*)(ws + TAB_LB) + layer * D};
                static_assert(WS_VV == WS_QS + 2 * 2 * pg8::EpiHgrnIn::SEGSTRIDE && WS_GG == WS_QS + 3 * 2 * pg8::EpiHgrnIn::SEGSTRIDE, "segment buffers are 32 MiB apart");
                REPEAT(REP_WIN) { pg8::gemm_phase<pg8::EpiHgrnIn, pg8::StaticOrder, true, true, true>(F.lds + RING_OFF, g, S, E); __syncthreads(); }
            }
            PH_END;
            if (PH_ON) REPEAT(REP_HGRN * REP_HG0) hgrn_chunks<0>(F, nullptr);
            PH_END;
            if (PH_ON) REPEAT(REP_HGRN) hgrn_scan(F);
            PH_END;
            if (PH_ON) REPEAT(REP_HGRN * REP_HG1) hgrn_chunks<1>(F, in[5] + layer * 128);
            PH_END;
        } else {
            if (PH_ON) {
                const int nw = (layer == 2) ? 3 : 1;
#pragma nounroll
                for (int w = 0; w < nw * REP_QKV; ++w) {
                    pg8::Gemm g; pg8::EpiBf16P E; pg8::StaticOrder S;
                    if (w % nw == 0) { const size_t wo = WS_WQ + (size_t)(layer - 2) * D * D * 2; g = pg8::Gemm{XQB, W8P(wo), M, D, D / 2, D / 2, 0, 0, 0, 0, SAPTR, SBP(wo)}; E = pg8::EpiBf16P{(bf16*)(ws + WS_Q), D, 0}; }
                    else if (w % nw == 1) { g = pg8::Gemm{XQB, W8P(WS_WK), M, D, D / 2, D / 2, 0, 0, 0, 0, SAPTR, SBP(WS_WK)}; E = pg8::EpiBf16P{(bf16*)(ws + WS_K), D, 1}; }
                    else { g = pg8::Gemm{W8P(WS_WV), XQB, D, M, D / 2, D / 2, 0, 0, 0, 0, SBP(WS_WV), SAPTR}; E = pg8::EpiBf16P{(bf16*)(ws + WS_VT), M, 2}; }
                    S.init(g.M, g.N, lg(F.G), lg((int)blockIdx.x));
                    pg8::gemm_phase<pg8::EpiBf16P, pg8::StaticOrder, true, true, true>(F.lds + RING_OFF, g, S, E);
                    __syncthreads();
                }
            }
            PH_END;
            if (PH_ON) REPEAT(REP_ATTN) attn_mfma(F, (layer - 2) * (CONV_MOE_ITEMS / 2), CONV_MOE_ITEMS / 2);
            PH_END;
        }
        if (PH_ON) {
            const float* xin = (layer == 0) ? in[0] : X;
            pg8::Gemm g{hg ? (const bf16*)(ws + WS_OG) : (const bf16*)(ws + WS_AO), hg ? (const bf16*)(ws + WS_WOUT) + (size_t)layer * D * D : (const bf16*)(ws + WS_WO) + (size_t)(layer - 2) * D * D, M, D, D, D};
            pg8::StaticOrder S; S.init(M, D, lg(F.G), lg((int)blockIdx.x));
            REPEAT(REP_OUTP) { pg8::EpiResid E{xin, rep_ == 0 ? X : (float*)(ws + WS_OR), D};
                pg8::gemm_phase<pg8::EpiResid, pg8::StaticOrder, true, true>(F.lds + RING_OFF, g, S, E); __syncthreads(); }
        }
        PH_END;
        if (PH_ON) REPEAT(REP_NORM) { norm_phase(F, X, moe, in[13] + (size_t)fi * D * NE, in[2] + layer * D); __syncthreads(); }
        PH_END;
        if (moe) { if (PH_ON) REPEAT(REP_SCAT) { scatter_phase(F); __syncthreads(); } PH_END; }
        if (PH_ON) {
            const int nrt = moe ? __builtin_amdgcn_readfirstlane(((const GAS int*)(ws + TAB_TILE))[160]) : M / 256;
            const size_t wo = WS_WGU + (size_t)fi * 2 * FFD * D * 2;
            pg8::Gemm g{moe ? (const bf16*)(ws + WS_XPQ) : XQB, moe ? (const bf16*)(ws + WS_WM8) : W8P(wo), nrt * 256, moe ? 2 * FFE : 2 * FFD, D / 2, D / 2, 0, 0, 0, 0,
                        moe ? (const float*)(ws + WS_SAP) : SAPTR, moe ? (const float*)(ws + WS_SBM) : SBP(wo)};
            pg8::MoeOrder S; S.init(nrt, (moe ? 2 * FFE : 2 * FFD) / 256, 1, D / 2, lg(F.G), lg((int)blockIdx.x), moe ? (const int*)(ws + TAB_TILE) : (const int*)(ws + WS_CTL) + CW_ZTAB, nullptr, 0);
            pg8::EpiSwiglu E{moe ? (bf16*)(ws + WS_HM) : (bf16*)(ws + WS_HB), moe ? MROWS : M};
            REPEAT(moe ? REP_MGU : REP_DGU) { pg8::gemm_phase<pg8::EpiSwiglu, pg8::MoeOrder, true, true, true>(F.lds + RING_OFF, g, S, E); __syncthreads(); }
        }
        PH_END;
        if (PH_ON) {
            const int* TE = (const int*)(ws + TAB_TILE);
#pragma nounroll
            for (int w = 0; w < (moe ? 2 : 1); ++w) {
                const int nrt = moe ? __builtin_amdgcn_readfirstlane(((const GAS int*)TE)[w == 0 ? 336 : 368]) : M / 256;
                const int ksn = (moe && w == 1) ? MOE_RKS : 1, kl = moe ? (w == 1 ? MOE_RKL : FFE) : FFD;
                pg8::Gemm g{moe ? (const bf16*)(ws + WS_HM) : (const bf16*)(ws + WS_HB), moe ? (const bf16*)(ws + (layer == 1 ? WS_WMDN : WS_WMDN2)) : (const bf16*)(ws + WS_WDN) + (size_t)fi * D * FFD, nrt * 256, D, moe ? FFE : FFD, kl,
                            64, 64, (long)(moe ? MROWS : M) * 128, (long)(moe ? NE * D : D) * 128};
                pg8::MoeOrder S; S.init(nrt, D / 256, ksn, kl, lg(F.G), lg((int)blockIdx.x), moe ? TE : (const int*)(ws + WS_CTL) + CW_ZTAB, moe ? TE + (w == 0 ? 176 : 352) : nullptr, w);
                if (moe) { REPEAT(REP_MDOWN) { pg8::EpiDownMoe E{(bf16*)(ws + (w == 0 ? WS_Y0 : WS_YR)), YR_STRIDE, kl, D};
                    pg8::gemm_phase<pg8::EpiDownMoe, pg8::MoeOrder, true, true>(F.lds + RING_OFF, g, S, E); __syncthreads(); } }
                else { REPEAT(REP_DDOWN) { pg8::EpiDown E{X, rep_ == 0 ? X : (float*)(ws + WS_OR), nullptr, 0, kl, D};
                    pg8::gemm_phase<pg8::EpiDown, pg8::MoeOrder, true, true>(F.lds + RING_OFF, g, S, E); __syncthreads(); } }
            }
        }
        PH_END;
        if (PH_ON) {
            if (moe) { combine_phase(F, X, layer == 3, in[17]); if (layer == 1) REPEAT(REP_CONV) { __syncthreads(); conv8_all(F, false, 1); } }
            else norm_phase(F, X, false, nullptr, nullptr);
        }
        PH_END;
    }
#undef PH_ON
#undef PH_END
#undef in
#undef X
#undef ws
#undef XQB
#undef W8P
#undef SBP
#undef SAPTR
}

#ifndef MK_PER_PHASE
#define MK_PER_PHASE 0
#endif
extern "C" void kernel_launch(void* const* d_in, const int* in_sizes, int n_in, void* d_out, int out_size, void* d_ws, size_t ws_size, hipStream_t stream) {
    static int ok = 0;
    if (ok == 0) {
        if (n_in != 18 || in_sizes[0] != M * D || out_size != M * D || ws_size < WS_END) { fprintf(stderr, "kernel_launch: unexpected shapes / workspace (n_in %d, ws %zu, need %zu); nothing launched\n", n_in, ws_size, (size_t)WS_END); ok = -1; return; }
        if (hipFuncSetAttribute((const void*)yoco_fwd, hipFuncAttributeMaxDynamicSharedMemorySize, LDS_BYTES) != hipSuccess) { fprintf(stderr, "kernel_launch: hipFuncSetAttribute failed\n"); ok = -1; return; }
        int per_cu = 0;
        if (hipOccupancyMaxActiveBlocksPerMultiprocessor(&per_cu, (const void*)yoco_fwd, NWAVES * 64, LDS_BYTES) != hipSuccess || per_cu < 1) fprintf(stderr, "kernel_launch: note: occupancy query reports %d workgroups per CU\n", per_cu);
        (void)hipGetLastError();
        ok = 1;
    }
    if (ok < 0) return;
    (void)hipMemsetAsync((char*)d_ws + WS_CTL, 0, CTL_ZERO_BYTES, stream);
    Args a{};
    for (int i = 0; i < 18; ++i) a.in[i] = (const float*)d_in[i];
    a.out = (float*)d_out; a.ws = (unsigned char*)d_ws;
#if MK_PER_PHASE
    for (int p = 0; p < NPH; ++p) { a.ph_lo = p; a.ph_hi = p + 1; hipLaunchKernelGGL(yoco_fwd, dim3(GRID), dim3(NWAVES * 64), LDS_BYTES, stream, a); }
#else
    a.ph_lo = 0; a.ph_hi = NPH; hipLaunchKernelGGL(yoco_fwd, dim3(GRID), dim3(NWAVES * 64), LDS_BYTES, stream, a);
#endif
}
```

```cpp
#include <hip/hip_runtime.h>
#include <cstdio>
#include <cstdint>
#ifndef REP_EPI8
#define REP_EPI8 1
#endif
#ifndef REP_HCC
#define REP_HCC 1
#endif
#ifndef REP_HCB
#define REP_HCB 1
#endif
namespace pg8 {
#define PG8_LAS __attribute__((address_space(3)))
typedef unsigned short bf16_t;
typedef short bf16x8 __attribute__((ext_vector_type(8)));
typedef float f32x4 __attribute__((ext_vector_type(4)));
typedef unsigned u32x4 __attribute__((ext_vector_type(4)));
constexpr int BM = 256, BK = 64, HALF = 128, HTB = HALF * BK * 2  , STAGE_BYTES = 8 * HTB, NXCD = 8, WGM = 4;

__host__ __device__ __forceinline__ int lds_byte(int r, int c) { const int st = (r >> 4) * 2 + (c >> 5), rr = r & 15, cc = c & 31, ob = rr * 64 + cc * 2; return st * 1024 + (ob ^ (((ob >> 9) & 1) << 5)); }
__host__ __device__ __forceinline__ void stage_rc(int b, int& R, int& C) { const int st = b / 1024, sb = b % 1024, swz = sb ^ (((sb >> 9) & 1) << 5); R = (st >> 1) * 16 + swz / 64; C = (st & 1) * 32 + (swz % 64) / 2; }
__host__ __device__ __forceinline__ int perm32(int rho) { const int n = rho >> 4, i = rho & 15; return 8 * (i >> 2) + 4 * n + (i & 3); }

struct Unit { int pm, pn, pc, ko, po; };
struct Gemm { const bf16_t* A; const bf16_t* Bt; int M, N, K, KL; int pA = 0, pB = 0; long ksA = 0, ksB = 0; const float* sA = nullptr; const float* sB = nullptr; };

struct StaticOrder {
    int nM, nN, nwg, G, c;
    __host__ __device__ void init(int M, int N, int G_, int c_) { nM = M / BM; nN = N / BM; nwg = nM * nN; G = G_; c = c_; }
    __host__ __device__ bool next(int i, Unit& u) const {
        const long L = (long)i * G + c; if (L >= nwg) return false;
        int wgid = (int)L; { const int q = nwg / NXCD, r = nwg % NXCD, xcd = wgid % NXCD, off = wgid / NXCD; wgid = (xcd < r ? xcd * (q + 1) : r * (q + 1) + (xcd - r) * q) + off; }
        const int nig = WGM * nN, gid = wgid / nig, fm = gid * WGM, gsz = (nM - fm) < WGM ? (nM - fm) : WGM;
        u.pm = fm + ((wgid % nig) % gsz); u.pn = (wgid % nig) / gsz; u.pc = u.pn; u.ko = 0; u.po = u.pm; return true;
    }
    __device__ __forceinline__ void a_ready(const Unit&) const {}
    __device__ __forceinline__ void done(const Unit&) const {}
};

__device__ __forceinline__ unsigned cvt_pk_bf16(float lo, float hi) { unsigned r; asm volatile("v_cvt_pk_bf16_f32 %0, %1, %2" : "=v"(r) : "v"(lo), "v"(hi)); return r; }
typedef float f32x2 __attribute__((ext_vector_type(2)));

typedef int i32x4 __attribute__((ext_vector_type(4)));
template <bool I8> struct AccSel { typedef f32x4 type; };
template <> struct AccSel<true> { typedef i32x4 type; };
__device__ __forceinline__ f32x4 mma16(bf16x8 a, bf16x8 b, f32x4 c) { return __builtin_amdgcn_mfma_f32_16x16x32_bf16(a, b, c, 0, 0, 0); }
__device__ __forceinline__ i32x4 mma16(bf16x8 a, bf16x8 b, i32x4 c) { return __builtin_amdgcn_mfma_i32_16x16x64_i8(__builtin_bit_cast(i32x4, a), __builtin_bit_cast(i32x4, b), c, 0, 0, 0); }
template <bool PERM> __device__ __forceinline__ void dequant(const f32x4 (&)[2][2][4][2], f32x4 (&)[2][2][4][2], const PG8_LAS float*, int, int, int, int) {}
template <bool PERM> __device__ __forceinline__ void dequant(const i32x4 (&acc)[2][2][4][2], f32x4 (&f)[2][2][4][2], const PG8_LAS float* SL, int wr, int wc, int fr, int fq) {
    const PG8_LAS float* sa = SL + wr * 64 + fr; const PG8_LAS float* sb = SL + 256 + wc * 32 + (PERM ? 8 * fq : 4 * fq);
    f32x4 cs[2][2];
#pragma unroll
    for (int bj = 0; bj < 2; ++bj)
#pragma unroll
        for (int n = 0; n < 2; ++n) cs[bj][n] = *(const PG8_LAS f32x4*)(sb + bj * HALF + (PERM ? 4 * n : 16 * n));
#pragma unroll
    for (int ai = 0; ai < 2; ++ai)
#pragma unroll
        for (int m = 0; m < 4; ++m) { const float rs = sa[ai * HALF + m * 16];
#pragma unroll
            for (int bj = 0; bj < 2; ++bj)
#pragma unroll
                for (int n = 0; n < 2; ++n) { const i32x4 a = acc[ai][bj][m][n]; f[ai][bj][m][n] = (f32x4){(float)a[0], (float)a[1], (float)a[2], (float)a[3]} * (cs[bj][n] * rs); } }
}
__device__ __forceinline__ float fsigmoid(float x) { return __builtin_amdgcn_rcpf(1.0f + __builtin_amdgcn_exp2f(-1.44269504089f * x)); }
__device__ __forceinline__ float fsilu(float x) { return x * fsigmoid(x); }

struct EpiResid {
    static constexpr bool PERM = false, AFTER_DRAIN = false;
    const float* base; float* out; int ldc;
    __device__ __forceinline__ void operator()(const f32x4 (&acc)[2][2][4][2], const Unit& u, int wr, int wc, int fr, int fq) const {
        const int row0 = u.pm * BM + wr * 64 + fr, col0 = u.pc * BM + wc * 32 + 4 * fq;
#pragma unroll
        for (int ai = 0; ai < 2; ++ai)
#pragma unroll
            for (int m = 0; m < 4; ++m) { const size_t off = (size_t)(row0 + ai * HALF + m * 16) * ldc + col0;
#pragma unroll
                for (int bj = 0; bj < 2; ++bj)
#pragma unroll
                    for (int n = 0; n < 2; ++n) { f32x4 b = (f32x4){0.f, 0.f, 0.f, 0.f}; if (base) b = *(const f32x4*)(base + off + bj * HALF + n * 16); *(f32x4*)(out + off + bj * HALF + n * 16) = b + acc[ai][bj][m][n]; } }
    }
};
struct EpiF32 {
    static constexpr bool PERM = false, AFTER_DRAIN = false;
    float* out; int ldc;
    __device__ __forceinline__ void operator()(const f32x4 (&acc)[2][2][4][2], const Unit& u, int wr, int wc, int fr, int fq) const {
        const int row0 = u.pm * BM + wr * 64 + fr, col0 = u.pc * BM + wc * 32 + 4 * fq;
#pragma unroll
        for (int ai = 0; ai < 2; ++ai)
#pragma unroll
            for (int m = 0; m < 4; ++m) { const size_t off = (size_t)(row0 + ai * HALF + m * 16) * ldc + col0;
#pragma unroll
                for (int bj = 0; bj < 2; ++bj)
#pragma unroll
                    for (int n = 0; n < 2; ++n) *(f32x4*)(out + off + bj * HALF + n * 16) = acc[ai][bj][m][n]; }
    }
};
struct EpiBf16P {
    static constexpr bool PERM = true, AFTER_DRAIN = false;
    bf16_t* O; int ldc, mode;
    __device__ __forceinline__ void operator()(const f32x4 (&acc)[2][2][4][2], const Unit& u, int wr, int wc, int fr, int fq) const {
        const int row0 = u.pm * BM + wr * 64 + fr, col0 = u.pc * BM + wc * 32 + 8 * fq;
#pragma unroll
        for (int ai = 0; ai < 2; ++ai)
#pragma unroll
            for (int m = 0; m < 4; ++m) { const int row = row0 + ai * HALF + m * 16;
#pragma unroll
                for (int bj = 0; bj < 2; ++bj) { const f32x4 v0 = acc[ai][bj][m][0], v1 = acc[ai][bj][m][1]; const int col = col0 + bj * HALF;
                    u32x4 w; w.x = cvt_pk_bf16(v0[0], v0[1]); w.y = cvt_pk_bf16(v0[2], v0[3]); w.z = cvt_pk_bf16(v1[0], v1[1]); w.w = cvt_pk_bf16(v1[2], v1[3]);
                    size_t off;
                    if (mode == 0) off = (size_t)row * ldc + col;
                    else if (mode == 1) { const int b = row >> 13, key = row & 8191, kk = key & 31, rr = (kk & ~12) | ((kk & 4) << 1) | ((kk & 8) >> 1), h = col >> 6;
                        off = ((size_t)((((b * 16 + h) * 256 + (key >> 5)) * 4 + ((col & 63) >> 4)) * 64 + ((col & 15) >> 3) * 32 + rr)) * 8; }
                    else { const int h = row >> 6, d = row & 63, b = col >> 13, key = col & 8191;
                        off = ((size_t)((((b * 16 + h) * 256 + (key >> 5)) * 4 + (d >> 5) * 2 + ((key & 31) >> 4)) * 64 + ((key & 15) >> 3) * 32 + (d & 31))) * 8; }
                    *(u32x4*)(O + off) = w; } }
    }
};
struct EpiSwiglu {
    static constexpr bool PERM = true, AFTER_DRAIN = false;
    bf16_t* H; int rows;
    __device__ __forceinline__ void operator()(const f32x4 (&acc)[2][2][4][2], const Unit& u, int wr, int wc, int fr, int fq) const {
        const int row0 = u.pm * BM + wr * 64 + fr, kt = u.pc * 2 + (wc >> 1), c64 = (wc & 1) * 32 + 8 * fq;
#pragma unroll
        for (int ai = 0; ai < 2; ++ai)
#pragma unroll
            for (int m = 0; m < 4; ++m) { bf16_t* rowp = H + ((size_t)kt * rows + (row0 + ai * HALF + m * 16)) * 64 + c64;
                float h[8];
#pragma unroll
                for (int n = 0; n < 2; ++n)
#pragma unroll
                    for (int j = 0; j < 4; ++j) h[4 * n + j] = fsilu(acc[ai][0][m][n][j]) * acc[ai][1][m][n][j];
                u32x4 w; w.x = cvt_pk_bf16(h[0], h[1]); w.y = cvt_pk_bf16(h[2], h[3]); w.z = cvt_pk_bf16(h[4], h[5]); w.w = cvt_pk_bf16(h[6], h[7]);
                *(u32x4*)rowp = w; }
    }
};
struct EpiHgrnIn {
    static constexpr bool PERM = true, AFTER_DRAIN = false;
    bf16_t* QS; _Float16* LF; const float* lb;
    static constexpr size_t SEGSTRIDE = (size_t)16 << 20;
    __device__ __forceinline__ void operator()(const f32x4 (&acc)[2][2][4][2], const Unit& u, int wr, int wc, int fr, int fq) const {
        const int seg = u.pc >> 2;
        const int row0 = u.pm * BM + wr * 64 + fr, col0 = (u.pc & 3) * BM + wc * 32 + 8 * fq;
        bf16_t* O = QS + (size_t)seg * SEGSTRIDE;
        float lbv[2][8];
        if (seg == 1) {
#pragma unroll
            for (int bj = 0; bj < 2; ++bj) { const f32x4 a = *(const f32x4*)(lb + col0 + bj * HALF), b = *(const f32x4*)(lb + col0 + bj * HALF + 4);
#pragma unroll
                for (int j = 0; j < 4; ++j) { lbv[bj][j] = a[j]; lbv[bj][4 + j] = b[j]; } }
        }
#pragma unroll
        for (int ai = 0; ai < 2; ++ai)
#pragma unroll
            for (int m = 0; m < 4; ++m) { const size_t roff = (size_t)(row0 + ai * HALF + m * 16) * 1024 + col0;
#pragma unroll
                for (int bj = 0; bj < 2; ++bj) {
                    float v[8];
#pragma unroll
                    for (int n = 0; n < 2; ++n)
#pragma unroll
                        for (int j = 0; j < 4; ++j) v[4 * n + j] = acc[ai][bj][m][n][j];
                    if (seg == 1) {
                        typedef _Float16 f16x2 __attribute__((ext_vector_type(2)));
                        float lf[8];
#pragma unroll
                        for (int j = 0; j < 8; ++j) { const float sg = fsigmoid(v[j]); const float f = lbv[bj][j] + (1.0f - lbv[bj][j]) * sg; lf[j] = 0.69314718056f * __builtin_amdgcn_logf(fmaxf(f, 1e-30f)); }
                        u32x4 hw;
                        hw.x = __builtin_bit_cast(unsigned, (f16x2){(_Float16)lf[0], (_Float16)lf[1]}); hw.y = __builtin_bit_cast(unsigned, (f16x2){(_Float16)lf[2], (_Float16)lf[3]});
                        hw.z = __builtin_bit_cast(unsigned, (f16x2){(_Float16)lf[4], (_Float16)lf[5]}); hw.w = __builtin_bit_cast(unsigned, (f16x2){(_Float16)lf[6], (_Float16)lf[7]});
                        *(u32x4*)(LF + roff + bj * HALF) = hw;
                    } else {
                        if (seg != 2) {
#pragma unroll
                            for (int j = 0; j < 8; ++j) v[j] = fsilu(v[j]); }
                        u32x4 w; w.x = cvt_pk_bf16(v[0], v[1]); w.y = cvt_pk_bf16(v[2], v[3]); w.z = cvt_pk_bf16(v[4], v[5]); w.w = cvt_pk_bf16(v[6], v[7]);
                        *(u32x4*)(O + roff + bj * HALF) = w; } } }
    }
};
struct EpiDown {
    static constexpr bool PERM = false, AFTER_DRAIN = false;
    const float* base; float* out; bf16_t* y; size_t ystride; int kl, ldc;
    __device__ __forceinline__ void operator()(const f32x4 (&acc)[2][2][4][2], const Unit& u, int wr, int wc, int fr, int fq) const {
        const int col0 = u.pc * BM + wc * 32 + 4 * fq;
        if (out) {
            const int row0 = u.pm * BM + wr * 64 + fr;
#pragma unroll
            for (int ai = 0; ai < 2; ++ai)
#pragma unroll
                for (int m = 0; m < 4; ++m) { const size_t off = (size_t)(row0 + ai * HALF + m * 16) * ldc + col0;
#pragma unroll
                    for (int bj = 0; bj < 2; ++bj)
#pragma unroll
                        for (int n = 0; n < 2; ++n) { const f32x4 b = *(const f32x4*)(base + off + bj * HALF + n * 16); *(f32x4*)(out + off + bj * HALF + n * 16) = b + acc[ai][bj][m][n]; } }
        } else {
            const int row0 = u.po * BM + wr * 64 + fr; bf16_t* Y = y + (size_t)(u.ko / kl) * ystride;
            typedef unsigned u32x2 __attribute__((ext_vector_type(2)));
#pragma unroll
            for (int ai = 0; ai < 2; ++ai)
#pragma unroll
                for (int m = 0; m < 4; ++m) { const size_t off = (size_t)(row0 + ai * HALF + m * 16) * ldc + col0;
#pragma unroll
                    for (int bj = 0; bj < 2; ++bj)
#pragma unroll
                        for (int n = 0; n < 2; ++n) { const f32x4 v = acc[ai][bj][m][n]; u32x2 w; w.x = cvt_pk_bf16(v[0], v[1]); w.y = cvt_pk_bf16(v[2], v[3]); *(u32x2*)(Y + off + bj * HALF + n * 16) = w; } }
        }
    }
};
struct EpiDownMoe {
    static constexpr bool PERM = true, AFTER_DRAIN = false;
    bf16_t* y; size_t ystride; int kl, ldc;
    __device__ __forceinline__ void operator()(const f32x4 (&acc)[2][2][4][2], const Unit& u, int wr, int wc, int fr, int fq) const {
        const int row0 = u.po * BM + wr * 64 + fr, col0 = u.pc * BM + wc * 32 + 8 * fq; bf16_t* Y = y + (size_t)(u.ko / kl) * ystride;
#pragma unroll
        for (int ai = 0; ai < 2; ++ai)
#pragma unroll
            for (int m = 0; m < 4; ++m) { bf16_t* rowp = Y + (size_t)(row0 + ai * HALF + m * 16) * ldc + col0;
#pragma unroll
                for (int bj = 0; bj < 2; ++bj) { const f32x4 v0 = acc[ai][bj][m][0], v1 = acc[ai][bj][m][1];
                    u32x4 w; w.x = cvt_pk_bf16(v0[0], v0[1]); w.y = cvt_pk_bf16(v0[2], v0[3]); w.z = cvt_pk_bf16(v1[0], v1[1]); w.w = cvt_pk_bf16(v1[2], v1[3]);
                    *(u32x4*)(rowp + bj * HALF) = w; } }
    }
};
struct MoeOrder {
    StaticOrder so; const int* tile_e; const int* list; int nN, KL, compact, rev;
    __device__ void init(int nrt, int nN_, int KS, int KL_, int G_, int c_, const int* te, const int* li, int compact_, int rev_ = 0) { compact = compact_; rev = rev_; so.nM = nrt; so.nN = nN_ * KS; so.nwg = nrt * nN_ * KS; so.G = G_; so.c = c_; tile_e = te; list = li; nN = nN_; KL = KL_; }
    __device__ bool next(int i, Unit& u) const { if (!so.next(i, u)) return false;
        if (list) u.pm = __builtin_amdgcn_readfirstlane(list[rev ? so.nM - 1 - u.pm : u.pm]);
        if (!compact) u.po = u.pm;
        const int e = __builtin_amdgcn_readfirstlane(tile_e[u.pm]); const int ks = u.pc / nN, pl = u.pc - ks * nN;
        u.pn = e * nN + pl; u.pc = pl; u.ko = ks * KL; return true; }
    __device__ __forceinline__ void a_ready(const Unit&) const {}
    __device__ __forceinline__ void done(const Unit&) const {}
};
template <class Epi, class Sched, bool ALIGN_EPI = false, bool SP2 = false, bool I8 = false>
__device__ __forceinline__ void gemm_phase(PG8_LAS unsigned char* lds, const Gemm g, const Sched& S, const Epi& E) {
    int tid_ = threadIdx.x; asm volatile("" : "+v"(tid_));
    const int tid = tid_, wid = __builtin_amdgcn_readfirstlane(tid >> 6), lane = tid & 63, wr = wid >> 2, wc = wid & 3, fr = lane & 15, fq = lane >> 4;
    const int K = g.K  , nt = g.KL / BK  ;
    const int pitA = g.pA ? g.pA : K, pitB = g.pB ? g.pB : K;
    unsigned voffA[2], voffB[2];
#pragma unroll
    for (int i = 0; i < 2; ++i) { int R, C; stage_rc(tid * 16 + i * 8192, R, C); const int Rb = Epi::PERM ? ((R & ~31) + perm32(R & 31)) : R;
        voffA[i] = (unsigned)(R * pitA + C) * 2u; voffB[i] = (unsigned)(Rb * pitB + C) * 2u; }
    const size_t kstepA = g.ksA ? (size_t)g.ksA : (size_t)(BK * 2), kstepB = g.ksB ? (size_t)g.ksB : (size_t)(BK * 2);
    const size_t hstepA = (size_t)HALF * pitA * 2, hstepB = (size_t)HALF * pitB * 2;
    const size_t tstepA = 2 * hstepA, tstepB = 2 * hstepB;
    const unsigned ldsw = (unsigned)wid * 1024u;
    const int aoff = lds_byte(wr * 64 + fr, fq * 8), boff = lds_byte(wc * 32 + fr, fq * 8);
#define PG8_SA(b, h) (((b) * 2 + (h)) * HTB)
#define PG8_SB(b, h) ((4 + (b) * 2 + (h)) * HTB)
#define PG8_STAGE(bufoff, gbase, voff) do { _Pragma("unroll") for (int _i = 0; _i < 2; ++_i) \
        __builtin_amdgcn_global_load_lds((const unsigned*)((const char*)(gbase) + (voff)[_i]), (PG8_LAS unsigned*)(lds + (bufoff) + ldsw + _i * 8192), 16, 0, 0); } while (0)
#define PG8_LDA(dst, b, h) do { _Pragma("unroll") for (int m = 0; m < 4; ++m) _Pragma("unroll") for (int k = 0; k < 2; ++k) dst[m][k] = *(const PG8_LAS bf16x8*)(lds + PG8_SA(b, h) + aoff + m * 2048 + k * 1024); } while (0)
#define PG8_LDB(dst, b, h) do { _Pragma("unroll") for (int n = 0; n < 2; ++n) _Pragma("unroll") for (int k = 0; k < 2; ++k) dst[n][k] = *(const PG8_LAS bf16x8*)(lds + PG8_SB(b, h) + boff + n * 2048 + k * 1024); } while (0)
#define PG8_MMA(ai, bj, At, Bt) do { __builtin_amdgcn_s_setprio(1); _Pragma("unroll") for (int m = 0; m < 4; ++m) _Pragma("unroll") for (int n = 0; n < 2; ++n) _Pragma("unroll") for (int k = 0; k < 2; ++k) \
        acc[ai][bj][m][n] = mma16(Bt[n][k], At[m][k], acc[ai][bj][m][n]); __builtin_amdgcn_s_setprio(0); } while (0)
#define PG8_WAIT_V(n) asm volatile("s_waitcnt vmcnt(" #n ")" ::: "memory")
#define PG8_WAIT_L(n) asm volatile("s_waitcnt lgkmcnt(" #n ")" ::: "memory")
#define PG8_BAR __builtin_amdgcn_s_barrier()
#define PG8_SCHED __builtin_amdgcn_sched_barrier(0)
    Unit cur, nxt; int ui = 0;
    if (!S.next(0, cur)) return;
    typedef typename AccSel<I8>::type acc_t;
    acc_t acc[2][2][4][2];
#pragma unroll
    for (int a = 0; a < 2; ++a)
#pragma unroll
        for (int b = 0; b < 2; ++b)
#pragma unroll
            for (int m = 0; m < 4; ++m)
#pragma unroll
                for (int n = 0; n < 2; ++n) acc[a][b][m][n] = (acc_t){0, 0, 0, 0};
    bf16x8 At[4][2], B0[2][2], B1[2][2];
    const char* cA = (const char*)g.A + (size_t)cur.pm * tstepA + (size_t)(cur.ko / BK) * kstepA; const char* cB = (const char*)g.Bt + (size_t)cur.pn * tstepB + (size_t)(cur.ko / BK) * kstepB;
    S.a_ready(cur);
    if constexpr (SP2) {
        PG8_STAGE(PG8_SB(0, 0), cB, voffB); PG8_STAGE(PG8_SB(0, 1), cB + hstepB, voffB); PG8_STAGE(PG8_SA(0, 0), cA, voffA); PG8_STAGE(PG8_SA(0, 1), cA + hstepA, voffA);
        if (wr == 1) PG8_BAR;
        PG8_WAIT_V(2); PG8_BAR;
        PG8_STAGE(PG8_SB(1, 0), cB + kstepB, voffB); PG8_STAGE(PG8_SA(1, 0), cA + kstepA, voffA); PG8_STAGE(PG8_SB(1, 1), cB + hstepB + kstepB, voffB);
        PG8_WAIT_V(6); PG8_BAR;
    } else {
        PG8_STAGE(PG8_SB(0, 0), cB, voffB); PG8_STAGE(PG8_SA(0, 0), cA, voffA); PG8_STAGE(PG8_SB(0, 1), cB + hstepB, voffB); PG8_STAGE(PG8_SA(0, 1), cA + hstepA, voffA);
        if (wr == 1) PG8_BAR;
        PG8_WAIT_V(4); PG8_BAR;
        PG8_STAGE(PG8_SB(1, 0), cB + kstepB, voffB); PG8_STAGE(PG8_SA(1, 0), cA + kstepA, voffA); PG8_STAGE(PG8_SB(1, 1), cB + hstepB + kstepB, voffB);
        PG8_WAIT_V(6); PG8_BAR;
    }
    for (;;) {
        const bool has_next = S.next(ui + 1, nxt);
        if constexpr (I8) {
            const float* sp_ = tid < 256 ? g.sA + cur.pm * BM + tid : g.sB + cur.pn * BM + (tid - 256);
            __builtin_amdgcn_global_load_lds((const unsigned*)sp_, (PG8_LAS unsigned*)(lds + STAGE_BYTES + (ui & 1) * 2048 + wid * 256), 4, 0, 0); }
        const char* nA = has_next ? (const char*)g.A + (size_t)nxt.pm * tstepA + (size_t)(nxt.ko / BK) * kstepA : cA; const char* nB = has_next ? (const char*)g.Bt + (size_t)nxt.pn * tstepB + (size_t)(nxt.ko / BK) * kstepB : cB;
        for (int t = 0; t < nt; t += 2) {
            const bool last = (t == nt - 2);
            const char* a1 = cA + (size_t)(t + 1) * kstepA;
            const char* a2 = last ? nA : cA + (size_t)(t + 2) * kstepA; const char* b2 = last ? nB : cB + (size_t)(t + 2) * kstepB;
            const char* a3 = a2 + kstepA; const char* b3 = b2 + kstepB;
            if (last && has_next) S.a_ready(nxt);
            if constexpr (SP2) {
            PG8_LDB(B0, 0, 0); PG8_LDB(B1, 0, 1); PG8_SCHED; PG8_LDA(At, 0, 0); PG8_STAGE(PG8_SA(1, 1), a1 + hstepA, voffA);
            PG8_WAIT_V(8); PG8_WAIT_L(0); PG8_BAR; PG8_MMA(0, 0, At, B0); PG8_MMA(0, 1, At, B1); PG8_BAR; PG8_SCHED;
            PG8_LDA(At, 0, 1); PG8_STAGE(PG8_SB(0, 0), b2, voffB); PG8_STAGE(PG8_SB(0, 1), b2 + hstepB, voffB); PG8_STAGE(PG8_SA(0, 0), a2, voffA);
            PG8_WAIT_V(8); PG8_WAIT_L(0); PG8_BAR; PG8_MMA(1, 0, At, B0); PG8_MMA(1, 1, At, B1); PG8_BAR; PG8_SCHED;
            PG8_LDB(B0, 1, 0); PG8_LDB(B1, 1, 1); PG8_SCHED; PG8_LDA(At, 1, 0); PG8_STAGE(PG8_SA(0, 1), a2 + hstepA, voffA);
            PG8_WAIT_V(8); PG8_WAIT_L(0); PG8_BAR; PG8_MMA(0, 0, At, B0); PG8_MMA(0, 1, At, B1); PG8_BAR; PG8_SCHED;
            PG8_LDA(At, 1, 1); PG8_STAGE(PG8_SB(1, 0), b3, voffB); PG8_STAGE(PG8_SB(1, 1), b3 + hstepB, voffB); PG8_STAGE(PG8_SA(1, 0), a3, voffA);
            PG8_WAIT_V(8); PG8_WAIT_L(0); PG8_BAR; PG8_MMA(1, 0, At, B0); PG8_MMA(1, 1, At, B1); PG8_BAR; PG8_SCHED;
            } else {
            PG8_LDB(B0, 0, 0); PG8_SCHED; PG8_LDA(At, 0, 0); PG8_STAGE(PG8_SA(1, 1), a1 + hstepA, voffA);
            PG8_WAIT_L(8); PG8_BAR; PG8_WAIT_L(0); PG8_MMA(0, 0, At, B0); PG8_BAR; PG8_SCHED;
            PG8_LDB(B1, 0, 1); PG8_STAGE(PG8_SB(0, 0), b2, voffB);
            PG8_BAR; PG8_WAIT_L(0); PG8_MMA(0, 1, At, B1); PG8_BAR;
            PG8_LDA(At, 0, 1); PG8_STAGE(PG8_SA(0, 0), a2, voffA);
            PG8_BAR; PG8_WAIT_L(0); PG8_MMA(1, 0, At, B0); PG8_BAR; PG8_SCHED;
            PG8_STAGE(PG8_SB(0, 1), b2 + hstepB, voffB);
            PG8_WAIT_V(6); PG8_BAR; PG8_MMA(1, 1, At, B1); PG8_BAR;
            PG8_LDB(B0, 1, 0); PG8_SCHED; PG8_LDA(At, 1, 0); PG8_STAGE(PG8_SA(0, 1), a2 + hstepA, voffA);
            PG8_WAIT_L(8); PG8_BAR; PG8_WAIT_L(0); PG8_MMA(0, 0, At, B0); PG8_BAR; PG8_SCHED;
            PG8_LDB(B1, 1, 1); PG8_STAGE(PG8_SB(1, 0), b3, voffB);
            PG8_BAR; PG8_WAIT_L(0); PG8_MMA(0, 1, At, B1); PG8_BAR;
            PG8_LDA(At, 1, 1); PG8_STAGE(PG8_SA(1, 0), a3, voffA);
            PG8_BAR; PG8_WAIT_L(0); PG8_MMA(1, 0, At, B0); PG8_BAR; PG8_SCHED;
            PG8_STAGE(PG8_SB(1, 1), b3 + hstepB, voffB);
            PG8_WAIT_V(6); PG8_BAR; PG8_MMA(1, 1, At, B1); PG8_BAR;
            }
        }
        if constexpr (ALIGN_EPI) { if (wr == 0) PG8_BAR; }
        if constexpr (!Epi::AFTER_DRAIN) { if constexpr (I8) { _Pragma("nounroll") for (int er_ = 0; er_ < REP_EPI8; ++er_) { f32x4 facc[2][2][4][2]; dequant<Epi::PERM>(acc, facc, (const PG8_LAS float*)(lds + STAGE_BYTES + (ui & 1) * 2048), wr, wc, fr, fq); E(facc, cur, wr, wc, fr, fq); } } else { E(acc, cur, wr, wc, fr, fq); } S.done(cur); }
        if (!has_next) break;
#pragma unroll
        for (int a = 0; a < 2; ++a)
#pragma unroll
            for (int b = 0; b < 2; ++b)
#pragma unroll
                for (int m = 0; m < 4; ++m)
#pragma unroll
                    for (int n = 0; n < 2; ++n) acc[a][b][m][n] = (acc_t){0, 0, 0, 0};
        cur = nxt; cA = nA; cB = nB; ++ui;
        if constexpr (ALIGN_EPI) { if (wr == 1) PG8_BAR; }
    }
    PG8_WAIT_V(0);
    if constexpr (!ALIGN_EPI) { if (wr == 0) PG8_BAR; }
    PG8_BAR;
    if constexpr (Epi::AFTER_DRAIN) { E.fused(acc, cur, wr, wc, fr, fq, lds, wid, lane); S.done(cur); }
#undef PG8_SA
#undef PG8_SB
#undef PG8_STAGE
#undef PG8_LDA
#undef PG8_LDB
#undef PG8_MMA
#undef PG8_WAIT_V
#undef PG8_WAIT_L
#undef PG8_BAR
#undef PG8_SCHED
}
}
#define GAS __attribute__((address_space(1)))
#define LAS __attribute__((address_space(3)))
typedef unsigned short bf16;
typedef unsigned v4u __attribute__((ext_vector_type(4)));
typedef float f32x4 __attribute__((ext_vector_type(4)));
typedef short bf16x8 __attribute__((ext_vector_type(8)));
typedef GAS unsigned gu32;
typedef GAS unsigned long long gu64;
#define RLX_AGENT __ATOMIC_RELAXED, __HIP_MEMORY_SCOPE_AGENT
#define LDS_WAIT() asm volatile("s_waitcnt lgkmcnt(0)" ::: "memory")
#define VM_WAIT() asm volatile("s_waitcnt vmcnt(0)" ::: "memory")
__device__ __forceinline__ unsigned long long rt() { return __builtin_amdgcn_s_memrealtime(); }
__device__ __forceinline__ unsigned f2bf(float f) { unsigned u = __builtin_bit_cast(unsigned, f); return (u + 0x7fffu + ((u >> 16) & 1u)) >> 16; }
__device__ __forceinline__ unsigned pk2(float lo, float hi) { return f2bf(lo) | (f2bf(hi) << 16); }

#define XB_TMO      128
#define XB_XCNT(j)  (256  + 64 * (j))
#define XB_XSUB(j)  (1280 + 64 * (j))
#define XB_XGEN(j)  (2304 + 64 * (j))
#define XB_TOP      3328
#define XB_TOPGEN   3392
#define XCD_BAR_WORDS 3456
#define XB_SPIN_CAP (1u << 22)

__device__ __forceinline__ unsigned xb_ld(unsigned* p)              { return __hip_atomic_load(p, __ATOMIC_RELAXED, __HIP_MEMORY_SCOPE_AGENT); }
__device__ __forceinline__ unsigned xb_add(unsigned* p, unsigned v) { return __hip_atomic_fetch_add(p, v, __ATOMIC_RELAXED, __HIP_MEMORY_SCOPE_AGENT); }
__device__ __forceinline__ unsigned xb_xcc_id() { return (unsigned)__builtin_amdgcn_s_getreg((3 << 11) | 20) & 0xFu; }
#define XB_SPIN(cond, bar) do { unsigned _sp = 0; while (cond) { __builtin_amdgcn_s_sleep(1); \
    if ((++_sp & 255u) == 0u) { if (xb_ld(&(bar)[XB_TMO])) break; if (_sp > XB_SPIN_CAP) { atomicAdd(&(bar)[XB_TMO], 1u); break; } } } } while (0)

struct XcdBarrier {
    unsigned* bar; unsigned x;
    volatile LAS unsigned* st;
};

__device__ __forceinline__ XcdBarrier xcd_barrier_post(unsigned* bar, volatile LAS unsigned* st) {
    XcdBarrier b; b.bar = bar; b.x = xb_xcc_id(); b.st = st;
    if (threadIdx.x == 0) (void)xb_add(&bar[XB_XCNT(b.x)], 1u);
    return b;
}
__device__ __forceinline__ void xcd_barrier_complete(unsigned* bar, unsigned x, unsigned& nloc, unsigned& nx) {
    const unsigned G = gridDim.x * gridDim.y * gridDim.z;
    unsigned sum, cnt, mine, sp = 0u;
    for (;;) {
        sum = 0u; cnt = 0u; mine = 0u;
#pragma unroll
        for (unsigned j = 0; j < 16; ++j) { const unsigned c = xb_ld(&bar[XB_XCNT(j)]); sum += c; cnt += (c > 0u) ? 1u : 0u; mine = (j == x) ? c : mine; }
        if (sum == G) break;
        __builtin_amdgcn_s_sleep(1);
        if ((++sp & 255u) == 0u) { if (xb_ld(&bar[XB_TMO])) break; if (sp > XB_SPIN_CAP) { atomicAdd(&bar[XB_TMO], 1u); break; } }
    }
    nloc = mine > 0u ? mine : 1u; nx = cnt > 0u ? cnt : 1u;
}

__device__ __forceinline__ void xcd_barrier(const XcdBarrier& b) {
    asm volatile("s_waitcnt vmcnt(0)" ::: "memory");
    __syncthreads();
    if (threadIdx.x == 0) {
        unsigned* bar = b.bar;
        __builtin_amdgcn_s_waitcnt(0);
        unsigned nloc = b.st[0], nx = b.st[1];
        if (nloc == 0u) { xcd_barrier_complete(bar, b.x, nloc, nx); b.st[0] = nloc; b.st[1] = nx; }
        const unsigned old = xb_add(&bar[XB_XSUB(b.x)], 1u);
        const unsigned gen = old / nloc;
        if (old + 1u == (gen + 1u) * nloc) {
            __builtin_amdgcn_fence(__ATOMIC_RELEASE, "agent");
            asm volatile("s_waitcnt vmcnt(0)" ::: "memory");
            const unsigned og = xb_add(&bar[XB_TOP], 1u);
            const unsigned tg = og / nx;
            if (og + 1u == (tg + 1u) * nx) xb_add(&bar[XB_TOPGEN], 1u);
            else XB_SPIN(xb_ld(&bar[XB_TOPGEN]) == tg, bar);
            __builtin_amdgcn_fence(__ATOMIC_ACQUIRE, "agent");
            xb_add(&bar[XB_XGEN(b.x)], 1u);
            asm volatile("s_waitcnt vmcnt(0)" ::: "memory");
        } else {
            XB_SPIN(xb_ld(&bar[XB_XGEN(b.x)]) == gen, bar);
            __builtin_amdgcn_fence(__ATOMIC_ACQUIRE, "agent");
            asm volatile("s_waitcnt vmcnt(0)" ::: "memory");
        }
    }
    __syncthreads();
}

constexpr int NWAVES = 8;
constexpr int GRID = 256;
constexpr int BATCH = 2, T = 8192, D = 1024, M = BATCH * T;
constexpr int HG_H = 8;
constexpr int SB_H = 16, SB_D = 64;
constexpr int FFD = 2816, FFE = 3584, NE = 8;
constexpr int MROWS = 2 * M + NE * 256, MRT = MROWS / 256;
constexpr float EPS = 1e-6f;
constexpr float QSCALE = 0.125f * 1.44269504089f;

constexpr size_t MiB = 1u << 20;
constexpr size_t WS_CTL = 0, CTL_ZERO_BYTES = 1 * MiB;
constexpr size_t WS_TAB = 1 * MiB;
constexpr size_t TAB_LB = WS_TAB, TAB_HIST = WS_TAB + 16384, TAB_TILE = WS_TAB + 32768, TAB_TOKE = WS_TAB + 65536, TAB_TOKG = WS_TAB + 262144, TAB_TOKP = WS_TAB + 524288;
constexpr size_t WS_WIN = 8 * MiB, WS_WOUT = 24 * MiB, WS_WQ = 28 * MiB, WS_WK = 32 * MiB, WS_WV = 34 * MiB, WS_WO = 36 * MiB, WS_WGU = 40 * MiB, WS_WDN = 62 * MiB;
constexpr size_t WS_WMGU = 80 * MiB, WS_WMDN = 192 * MiB, WS_WMDN2 = 80 * MiB;
constexpr size_t WS_WMGU_UNUSED_ = 0;
constexpr size_t WS_XN = 248 * MiB;
constexpr size_t WS_K = 280 * MiB, WS_VT = 312 * MiB;
constexpr size_t WS_S = 344 * MiB;
constexpr size_t WS_QS = WS_S, WS_KK = WS_S + 32 * MiB, WS_VV = WS_S + 64 * MiB, WS_GG = WS_S + 96 * MiB, WS_LF = WS_S + 128 * MiB, WS_OR = WS_S + 192 * MiB, WS_OG = WS_S + 256 * MiB;
constexpr size_t WS_HB = WS_S;
constexpr size_t WS_XP = WS_S, WS_HM = WS_S + 68 * MiB, WS_Y = WS_S + 306 * MiB;
constexpr int MOE_RKS = 2, MOE_RKL = FFE / MOE_RKS;
constexpr size_t WS_Y0 = WS_XP;
constexpr size_t WS_YR = WS_Y, YR_STRIDE = (size_t)NE * 256 * D;
constexpr size_t WS_Q = WS_S, WS_AO = WS_S + 32 * MiB;
constexpr size_t WS_END0 = WS_S + 442 * MiB;
constexpr size_t WS_XQ = WS_XN, WS_SA = WS_XN + 16 * MiB, WS_SAP = WS_XN + 17 * MiB, WS_SB = WS_XN + 18 * MiB, WS_SBM = WS_XN + 19 * MiB;
constexpr size_t WS_XPQ = WS_XP;
constexpr size_t WS_WM8 = WS_END0, WS_W8 = WS_END0 + 56 * MiB;
constexpr int W8_ROWS = (int)((WS_WDN - WS_WIN) / 2048), WM8_ROWS = NE * 2 * FFE;
constexpr size_t WS_END = WS_W8 + 27 * MiB;
static_assert(WS_HM + (size_t)MROWS * FFE * 2 <= WS_Y && WS_YR + (size_t)MOE_RKS * YR_STRIDE * 2 <= WS_END0 && (size_t)W8_ROWS * D <= 27 * MiB && WS_END <= 896 * MiB && WS_XP + (size_t)MROWS * D * 2 <= WS_HM, "MoE scratch map");
static_assert(WS_WDN + (size_t)2 * D * FFD * 2 <= WS_WMGU && WS_WMGU + (size_t)NE * 2 * FFE * D * 2 <= WS_WMDN && WS_WMDN + (size_t)NE * D * FFE * 2 <= WS_XN, "weight map");
constexpr int CW_BAR = 4096;
constexpr int CW_ZTAB = 16384;

constexpr int RING_OFF = 0, RING_BYTES = 131072;
constexpr int LDSCTL_OFF = 135168, MISC_OFF = LDSCTL_OFF + 320;
constexpr int LDS_BYTES = 147456;

struct Args { const float* in[18]; float* out; unsigned char* ws; int ph_lo, ph_hi; };
typedef const __attribute__((address_space(4))) Args* CArgsP;
__device__ __forceinline__ CArgsP kargs() { CArgsP p = (CArgsP)__builtin_amdgcn_kernarg_segment_ptr(); asm volatile("" : "+s"(p)); return p; }
__device__ __forceinline__ int lg(int v) { asm volatile("" : "+s"(v)); return v; }
__device__ __forceinline__ unsigned char* wsbase() { return kargs()->ws; }
typedef float f32x2 __attribute__((ext_vector_type(2)));
struct Frame;
#define PHASE_LOCALS const int blk = lg((int)blockIdx.x); Frame F = F_; { int t_ = F_.tid; asm volatile("" : "+v"(t_)); F.tid = t_; F.lane = t_ & 63; F.wave = lg(F_.wave); F.vcu = lg(F_.vcu); F.G = lg(F_.G); } (void)blk;
struct Frame {
    LAS unsigned char* lds;
    volatile LAS unsigned* MISC;
    int tid, lane, wave;
    int vcu, G;
};

__device__ __forceinline__ float wave_sum(float v) {
#pragma unroll
    for (int o = 1; o < 64; o <<= 1) v += __shfl_xor(v, o);
    return v;
}
__device__ __forceinline__ float bf_lo(unsigned u) { return __uint_as_float(u << 16); }
__device__ __forceinline__ float bf_hi(unsigned u) { return __uint_as_float(u & 0xffff0000u); }
__device__ __forceinline__ float bf2f(bf16 b) { return __uint_as_float((unsigned)b << 16); }
typedef __bf16 bf16x2_t __attribute__((ext_vector_type(2)));
__device__ __forceinline__ unsigned cvtpk(float lo, float hi) { f32x2 v = {lo, hi}; bf16x2_t b = __builtin_convertvector(v, bf16x2_t); return __builtin_bit_cast(unsigned, b); }
__device__ __forceinline__ unsigned q8x4(float a, float b, float c, float d) {
    const float MG = 12582912.0f;
    const unsigned ua = __float_as_uint(a + MG), ub = __float_as_uint(b + MG), uc = __float_as_uint(c + MG), ud = __float_as_uint(d + MG);
    const unsigned lo = __builtin_amdgcn_perm(ub, ua, 0x0c0c0400u), hi = __builtin_amdgcn_perm(ud, uc, 0x0c0c0400u);
    return __builtin_amdgcn_perm(hi, lo, 0x05040100u);
}

struct CItem { const float* W; const float* gain; bf16* WT; int pitch, ldk, k0, drow0, ktm; float scale; };
__device__ __forceinline__ CItem cmat(int r, const float* W, int pitch, int c0, int nc, const float* gain, float scale, bf16* WT, int ldk, int il, int ktm = 0) {
    const int nb = nc / 64, kb = r / nb, n0 = (r % nb) * 64;
    CItem c; c.W = W + c0 + n0; c.gain = gain; c.WT = WT; c.pitch = pitch; c.ldk = ldk; c.k0 = kb * 64; c.scale = scale; c.ktm = ktm;
    c.drow0 = il == 0 ? n0 : (n0 >> 7) * 256 + (il - 1) * 128 + (n0 & 127);
    return c;
}
constexpr int CONV_DENSE_ITEMS = 2 * (256 + 256 + 704), CONV_MOE_PER = 896, CONV_MOE_ITEMS = 8 * CONV_MOE_PER;
__device__ __forceinline__ CItem conv_decode(int it, bool dense, int ml, unsigned char* ws_) {
#define in (kargs()->in)
    int r = it;
    if (dense) {
        if (r < CONV_DENSE_ITEMS) {
#pragma unroll
            for (int l = 0; l < 2; ++l) {
                if (r < 256) return cmat(r, in[6] + (size_t)l * D * D, D, 0, D, nullptr, 1.0f, (bf16*)(ws_ + WS_WOUT) + (size_t)l * D * D, D, 0); r -= 256;
                if (r < 256) return cmat(r, in[10] + (size_t)l * D * D, D, 0, D, nullptr, 1.0f, (bf16*)(ws_ + WS_WO) + (size_t)l * D * D, D, 0); r -= 256;
                if (l == 0) { if (r < 704) return cmat(r, in[12], D, 0, D, nullptr, 1.0f, (bf16*)(ws_ + WS_WDN), FFD, 0, D); r -= 704; }
            }
            return cmat(r, in[12] + (size_t)FFD * D, D, 0, D, nullptr, 1.0f, (bf16*)(ws_ + WS_WDN) + (size_t)D * FFD, FFD, 0, D);
        }
        r -= CONV_DENSE_ITEMS;
    }
    const int e = r / CONV_MOE_PER, loc = r % CONV_MOE_PER; const size_t eo = (size_t)(ml * NE + e) * D * FFE;
    { CItem c = cmat(loc, in[16] + eo, D, 0, D, nullptr, 1.0f, (bf16*)(ws_ + (ml == 0 ? WS_WMDN : WS_WMDN2)), FFE, 0, NE * D); c.drow0 += e * D; return c; }
#undef in
}
__device__ __forceinline__ void conv_load(const CItem& c, int lane, f32x4 (&v)[16]) {
    const float* p = c.W + (size_t)(c.k0 + (lane >> 4)) * c.pitch + 4 * (lane & 15);
#pragma unroll
    for (int i = 0; i < 16; ++i) v[i] = __builtin_nontemporal_load((const GAS f32x4*)(p + (size_t)(4 * i) * c.pitch));
}
__device__ __forceinline__ void conv_store(const CItem& c, int lane, const f32x4 (&v)[16], LAS float* scr) {
    const int kr = lane >> 4, nc4 = 4 * (lane & 15);
#pragma unroll
    for (int i = 0; i < 16; ++i) { const float g = c.gain ? c.gain[c.k0 + 4 * i + kr] * c.scale : c.scale; LAS float* p = scr + (4 * i + kr) * 65 + nc4;
        p[0] = v[i].x * g; p[1] = v[i].y * g; p[2] = v[i].z * g; p[3] = v[i].w * g; }
    LDS_WAIT(); asm volatile("" ::: "memory");
    const int ch = lane & 7;
#pragma unroll
    for (int j = 0; j < 8; ++j) { const int n = (lane >> 3) + 8 * j; const LAS float* s = scr + (8 * ch) * 65 + n;
        v4u o; o.x = cvtpk(s[0 * 65], s[1 * 65]); o.y = cvtpk(s[2 * 65], s[3 * 65]); o.z = cvtpk(s[4 * 65], s[5 * 65]); o.w = cvtpk(s[6 * 65], s[7 * 65]);
        bf16* dp = c.ktm ? c.WT + ((size_t)(c.k0 >> 6) * c.ktm + (c.drow0 + n)) * 64 + 8 * ch : c.WT + (size_t)(c.drow0 + n) * c.ldk + c.k0 + 8 * ch;
        *(GAS v4u*)dp = o; }
    LDS_WAIT(); asm volatile("" ::: "memory");
}
__device__ __forceinline__ void conv_all(Frame& F_, bool dense, int ml) {
    PHASE_LOCALS
    unsigned char* const ws_ = kargs()->ws;
    LAS float* scr = (LAS float*)(F.lds + RING_OFF + F.wave * 16640);
    const int gw = F.vcu * NWAVES + F.wave, NGW = F.G * NWAVES, n = (dense ? CONV_DENSE_ITEMS : 0) + CONV_MOE_ITEMS;
    int it = gw;
    if (it >= n) return;
    CItem cur = conv_decode(it, dense, ml, ws_); f32x4 v[16]; conv_load(cur, F.lane, v);
    for (;;) {
        const int itn = it + NGW; const bool more = itn < n;
        CItem nxt = cur; f32x4 vn[16];
        if (more) { nxt = conv_decode(itn, dense, ml, ws_); conv_load(nxt, F.lane, vn); }
        conv_store(cur, F.lane, v, scr);
        if (!more) break;
        cur = nxt; it = itn;
#pragma unroll
        for (int i = 0; i < 16; ++i) v[i] = vn[i];
    }
}

__device__ __forceinline__ void conv_one_moe_down(int item, int ml, unsigned char* ws_, LAS unsigned char* ldsb, int wave, int lane) {
    const CItem c = conv_decode(item, false, ml, ws_); f32x4 v[16]; conv_load(c, lane, v);
    conv_store(c, lane, v, (LAS float*)(ldsb + wave * 16640));
}
__device__ __forceinline__ void store_xn(bf16* XN, int m, int lane, const f32x4 (&v)[4], float rstd) {
    GAS unsigned long long* o8 = (GAS unsigned long long*)(XN + (size_t)m * D) + lane;
#pragma unroll
    for (int j = 0; j < 4; ++j) o8[64 * j] = (unsigned long long)pk2(v[j].x * rstd, v[j].y * rstd) | ((unsigned long long)pk2(v[j].z * rstd, v[j].w * rstd) << 32);
}
__device__ __forceinline__ void store_xq(unsigned char* ws_, int m, int lane, const f32x4 (&v)[4], float rstd) {
    float am = 0.f;
#pragma unroll
    for (int j = 0; j < 4; ++j) am = fmaxf(fmaxf(am, fmaxf(fabsf(v[j].x), fabsf(v[j].y))), fmaxf(fabsf(v[j].z), fabsf(v[j].w)));
#pragma unroll
    for (int o = 1; o < 64; o <<= 1) am = fmaxf(am, __shfl_xor(am, o));
    am *= rstd;
    const float inv = am > 0.f ? 127.0f / am : 0.f, k = rstd * inv;
    GAS unsigned* o4 = (GAS unsigned*)(ws_ + WS_XQ + (size_t)m * D) + lane;
#pragma unroll
    for (int j = 0; j < 4; ++j) o4[64 * j] = q8x4(v[j].x * k, v[j].y * k, v[j].z * k, v[j].w * k);
    if (lane == 0) ((GAS float*)(ws_ + WS_SA))[m] = am * (1.0f / 127.0f);
}
struct C8Item { const float* W; const float* gain; unsigned char* D8; float* SBp; int pitch; float scale; };
__device__ __forceinline__ C8Item c8mat(int r, const float* W, int pitch, int c0, const float* gain, float scale, unsigned char* W8base, float* SBbase, int row0, int il) {
    const int n0 = r * 64, drow = row0 + (il == 0 ? n0 : (n0 >> 7) * 256 + (il - 1) * 128 + (n0 & 127));
    C8Item c; c.W = W + c0 + n0; c.gain = gain; c.pitch = pitch; c.scale = scale; c.D8 = W8base + (size_t)drow * D; c.SBp = SBbase + drow; return c;
}
constexpr int C8_DENSE_ITEMS = 2 * (64 + 16 + 44 + 44) + 16 + 16, C8_MOE_ITEMS = 16 * 56;
constexpr int R_WIN = 0, R_WQ = (int)((WS_WQ - WS_WIN) / 2048), R_WK = (int)((WS_WK - WS_WIN) / 2048), R_WV = (int)((WS_WV - WS_WIN) / 2048), R_WGU = (int)((WS_WGU - WS_WIN) / 2048);
__device__ __forceinline__ C8Item conv8_decode(int it, bool dense, int ml, unsigned char* ws_) {
#define in (kargs()->in)
    int r = it; unsigned char* W8 = ws_ + WS_W8; float* SBd = (float*)(ws_ + WS_SB);
    if (dense) {
        if (r < C8_DENSE_ITEMS) {
#pragma unroll
            for (int l = 0; l < 2; ++l) {
                if (r < 64) return c8mat(r, in[3] + (size_t)l * D * 4 * D, 4 * D, 0, in[1] + l * D, 1.0f, W8, SBd, R_WIN + l * 4 * D, 0); r -= 64;
                if (r < 16) return c8mat(r, in[9] + (size_t)l * D * D, D, 0, in[1] + (2 + l) * D, QSCALE, W8, SBd, R_WQ + l * D, 0); r -= 16;
                if (r < 44) return c8mat(r, in[11] + (size_t)l * D * 2 * FFD, 2 * FFD, 0, in[2] + (2 * l) * D, 1.0f, W8, SBd, R_WGU + l * 2 * FFD, 1); r -= 44;
                if (r < 44) return c8mat(r, in[11] + (size_t)l * D * 2 * FFD, 2 * FFD, FFD, in[2] + (2 * l) * D, 1.0f, W8, SBd, R_WGU + l * 2 * FFD, 2); r -= 44;
            }
            if (r < 16) return c8mat(r, in[8], 2 * D, 0, in[7], 1.0f, W8, SBd, R_WK, 0); r -= 16;
            return c8mat(r, in[8], 2 * D, D, in[7], 1.0f, W8, SBd, R_WV, 0);
        }
        r -= C8_DENSE_ITEMS;
    }
    const int q = r / 56, loc = r % 56, ty = q >> 3, e = q & 7;
    return c8mat(loc, in[14 + ty] + (size_t)(ml * NE + e) * D * FFE, FFE, 0, in[2] + (2 * ml + 1) * D, 1.0f, ws_ + WS_WM8, (float*)(ws_ + WS_SBM), e * 2 * FFE, 1 + ty);
#undef in
}
__device__ __forceinline__ void conv8_all(Frame& F_, bool dense, int ml) {
    PHASE_LOCALS
    unsigned char* const ws_ = kargs()->ws;
    LAS bf16* TT = (LAS bf16*)(F.lds + RING_OFF);
    LAS float* CM = (LAS float*)(F.lds + RING_OFF + 132096);
    LAS float* CMX = CM + 512;
    const int n8 = (dense ? C8_DENSE_ITEMS : 0) + C8_MOE_ITEMS, lane = F.lane, kr = lane >> 4, nc4 = 4 * (lane & 15), kb = 128 * F.wave;
    for (int it = F.vcu; it < n8; it += F.G) {
        const C8Item c = conv8_decode(it, dense, ml, ws_);
        float cm0 = 0.f, cm1 = 0.f, cm2 = 0.f, cm3 = 0.f;
#pragma nounroll
        for (int hf = 0; hf < 2; ++hf) {
            f32x4 v[16];
            { const float* p0 = c.W + (size_t)(kb + 64 * hf + kr) * c.pitch + nc4; const size_t st = (size_t)4 * c.pitch;
#pragma unroll
            for (int i = 0; i < 16; ++i) v[i] = __builtin_nontemporal_load((const GAS f32x4*)(p0 + i * st)); }
#pragma unroll
            for (int i = 0; i < 16; ++i) { const int k = kb + 64 * hf + 4 * i + kr; const float g = c.gain ? c.gain[k] * c.scale : c.scale;
                const unsigned p01 = cvtpk(v[i].x * g, v[i].y * g), p23 = cvtpk(v[i].z * g, v[i].w * g);
                cm0 = fmaxf(cm0, fabsf(__uint_as_float(p01 << 16))); cm1 = fmaxf(cm1, fabsf(__uint_as_float(p01 & 0xffff0000u))); cm2 = fmaxf(cm2, fabsf(__uint_as_float(p23 << 16))); cm3 = fmaxf(cm3, fabsf(__uint_as_float(p23 & 0xffff0000u)));
                TT[(nc4 + 0) * 1032 + k] = (bf16)(p01 & 0xffffu); TT[(nc4 + 1) * 1032 + k] = (bf16)(p01 >> 16); TT[(nc4 + 2) * 1032 + k] = (bf16)(p23 & 0xffffu); TT[(nc4 + 3) * 1032 + k] = (bf16)(p23 >> 16); }
        }
        cm0 = fmaxf(cm0, __shfl_xor(cm0, 16)); cm0 = fmaxf(cm0, __shfl_xor(cm0, 32)); cm1 = fmaxf(cm1, __shfl_xor(cm1, 16)); cm1 = fmaxf(cm1, __shfl_xor(cm1, 32));
        cm2 = fmaxf(cm2, __shfl_xor(cm2, 16)); cm2 = fmaxf(cm2, __shfl_xor(cm2, 32)); cm3 = fmaxf(cm3, __shfl_xor(cm3, 16)); cm3 = fmaxf(cm3, __shfl_xor(cm3, 32));
        if (lane < 16) { LAS float* p = CM + F.wave * 64 + nc4; p[0] = cm0; p[1] = cm1; p[2] = cm2; p[3] = cm3; }
        __syncthreads();
        if (F.tid < 64) { float m = 0.f;
#pragma unroll
            for (int w = 0; w < 8; ++w) m = fmaxf(m, CM[w * 64 + F.tid]);
            CMX[F.tid] = m; c.SBp[F.tid] = m * (1.0f / 127.0f); }
        __syncthreads();
#pragma unroll 2
        for (int j = 0; j < 8; ++j) { const int idx = j * 512 + F.tid, n = idx >> 6, ch = idx & 63; const float m = CMX[n], inv = m > 0.f ? 127.0f / m : 0.f;
            const v4u a = *(const LAS v4u*)(TT + n * 1032 + 16 * ch), b = *(const LAS v4u*)(TT + n * 1032 + 16 * ch + 8);
            const unsigned wv[8] = {a.x, a.y, a.z, a.w, b.x, b.y, b.z, b.w}; unsigned q[4];
#pragma unroll
            for (int t = 0; t < 4; ++t) q[t] = q8x4(bf_lo(wv[2 * t]) * inv, bf_hi(wv[2 * t]) * inv, bf_lo(wv[2 * t + 1]) * inv, bf_hi(wv[2 * t + 1]) * inv);
            *(GAS v4u*)(c.D8 + (size_t)n * D + 16 * ch) = (v4u){q[0], q[1], q[2], q[3]}; }
        __syncthreads();
    }
}
__device__ __forceinline__ float row_rstd(const f32x4 (&v)[4]) {
    float s = 0.f;
#pragma unroll
    for (int j = 0; j < 4; ++j) s += (v[j].x * v[j].x + v[j].y * v[j].y) + (v[j].z * v[j].z + v[j].w * v[j].w);
    return 1.0f / sqrtf(wave_sum(s) * (1.0f / D) + EPS);
}
__device__ __forceinline__ void norm_phase(Frame& F_, const float* X, bool route, const float* router  , const float* rgain  ) {
    PHASE_LOCALS
    unsigned char* const ws_ = kargs()->ws;
    LAS float* RGT = (LAS float*)(F.lds + RING_OFF);
    LAS int* hist = (LAS int*)(F.lds + RING_OFF + 32768);
    if (route) {
        for (int i = F.tid; i < D * NE; i += NWAVES * 64) { const int k = i >> 3, e = i & 7; RGT[e * D + k] = router[i] * rgain[k]; }
        if (F.tid < NE) hist[F.tid] = 0;
        __syncthreads();
    }
#pragma nounroll
    for (int i4 = 0; i4 < 8; i4 += 4) {
        f32x4 vv[4][4];
#pragma unroll
        for (int t = 0; t < 4; ++t) { const GAS f32x4* xr = (const GAS f32x4*)(X + (size_t)(blk * 64 + F.wave * 8 + i4 + t) * D) + F.lane;
#pragma unroll
            for (int j = 0; j < 4; ++j) vv[t][j] = xr[64 * j]; }
        __builtin_amdgcn_sched_barrier(0);
#pragma unroll
        for (int t = 0; t < 4; ++t) {
        const int m = blk * 64 + F.wave * 8 + i4 + t;
        f32x4 (&v)[4] = vv[t];
        const float rstd = row_rstd(v);
        store_xq(ws_, m, F.lane, v, rstd);
        if (route) {
            float lg[NE];
#pragma unroll
            for (int e = 0; e < NE; ++e) { float s = 0.f;
#pragma unroll
                for (int j = 0; j < 4; ++j) { const f32x4 r = *(const LAS f32x4*)(RGT + e * D + 4 * F.lane + 256 * j); s += (v[j].x * r.x + v[j].y * r.y) + (v[j].z * r.z + v[j].w * r.w); }
                lg[e] = wave_sum(s) * rstd; }
            float b0 = -3.0e38f, b1 = -3.0e38f; int i0 = 0, i1 = 0;
#pragma unroll
            for (int e = 0; e < NE; ++e) { if (lg[e] > b0) { b1 = b0; i1 = i0; b0 = lg[e]; i0 = e; } else if (lg[e] > b1) { b1 = lg[e]; i1 = e; } }
            if (F.lane == 0) { const float ex = __expf(b1 - b0), g0 = 1.0f / (1.0f + ex);
                ((GAS int*)(ws_ + TAB_TOKE))[2 * m] = i0; ((GAS int*)(ws_ + TAB_TOKE))[2 * m + 1] = i1;
                ((GAS float*)(ws_ + TAB_TOKG))[2 * m] = g0; ((GAS float*)(ws_ + TAB_TOKG))[2 * m + 1] = ex * g0;
                atomicAdd((int*)(hist + i0), 1); atomicAdd((int*)(hist + i1), 1); }
        }
        }
    }
    if (route) { __syncthreads(); if (F.tid < NE) ((GAS int*)(ws_ + TAB_HIST))[blk * NE + F.tid] = hist[F.tid]; }
}
__device__ __forceinline__ void scatter_phase(Frame& F_) {
    PHASE_LOCALS
    unsigned char* const ws_ = kargs()->ws;
    LAS int* h = (LAS int*)(F.lds + RING_OFF);
    LAS int* pre = h + 2048; LAS int* tot = pre + 8; LAS int* pst = tot + 8; LAS int* pos = pst + 16;
    const GAS int* HIST = (const GAS int*)(ws_ + TAB_HIST);
    for (int i = F.tid; i < GRID * NE; i += NWAVES * 64) h[i] = HIST[i];
    __syncthreads();
    if (F.tid < NE) { int p = 0, t = 0; for (int b = 0; b < GRID; ++b) { const int v = h[b * NE + F.tid]; p += (b < blk) ? v : 0; t += v; } pre[F.tid] = p; tot[F.tid] = t; }
    __syncthreads();
    if (F.tid == 0) { int s = 0; for (int e = 0; e < NE; ++e) { pst[e] = s; s += (tot[e] + 255) & ~255; } pst[NE] = s; }
    __syncthreads();
    if (F.wave == 0) {
        const int m = blk * 64 + F.lane;
        const int e0 = ((const GAS int*)(ws_ + TAB_TOKE))[2 * m], e1 = ((const GAS int*)(ws_ + TAB_TOKE))[2 * m + 1];
        int p0 = 0, p1 = 0; const unsigned long long lt = (1ull << F.lane) - 1ull;
#pragma unroll
        for (int e = 0; e < NE; ++e) { const unsigned long long mk = __ballot(e0 == e || e1 == e); const int rk = __popcll(mk & lt) + pst[e] + pre[e];
            if (e0 == e) p0 = rk; if (e1 == e) p1 = rk; }
        ((GAS int*)(ws_ + TAB_TOKP))[2 * m] = p0; ((GAS int*)(ws_ + TAB_TOKP))[2 * m + 1] = p1;
        pos[2 * F.lane] = p0; pos[2 * F.lane + 1] = p1;
    }
    if (blk == 0) { GAS int* TE = (GAS int*)(ws_ + TAB_TILE);
        LAS unsigned long long* wm = (LAS unsigned long long*)(pos + 128);
        const int nrt = pst[NE] >> 8, rt = F.tid;
        int e = NE - 1; bool full = false;
        if (rt < nrt) {
#pragma unroll
            for (int q = NE - 1; q >= 0; --q) if (rt * 256 < pst[q + 1]) e = q;
            TE[rt] = e; full = (rt + 1) * 256 <= pst[e] + tot[e]; }
        const unsigned long long bm = __ballot(full);
        if (F.lane == 0 && F.wave < 3) wm[F.wave] = bm;
        __syncthreads();
        if (rt < nrt) { int nfb = __popcll(bm & ((1ull << F.lane) - 1ull)); if (F.wave > 0) nfb += __popcll(wm[0]); if (F.wave > 1) nfb += __popcll(wm[1]);
            if (full) { TE[176 + nfb] = rt; TE[384 + rt] = -1; } else { TE[352 + rt - nfb] = rt; TE[384 + rt] = rt - nfb; }
            if (rt == nrt - 1) { const int nf = nfb + (full ? 1 : 0); TE[160] = nrt; TE[336] = nf; TE[368] = nrt - nf; } }
    }
    __syncthreads();
    const unsigned char* XQ = ws_ + WS_XQ; unsigned char* XPQ = ws_ + WS_XPQ;
    for (int i = 0; i < 8; ++i) { const int tl = F.wave * 8 + i, m = blk * 64 + tl, d0 = pos[2 * tl], d1 = pos[2 * tl + 1];
        const v4u a = *((const GAS v4u*)(XQ + (size_t)m * D) + F.lane);
        *((GAS v4u*)(XPQ + (size_t)d0 * D) + F.lane) = a; *((GAS v4u*)(XPQ + (size_t)d1 * D) + F.lane) = a;
        if (F.lane == 0) { const float sc = ((const GAS float*)(ws_ + WS_SA))[m]; ((GAS float*)(ws_ + WS_SAP))[d0] = sc; ((GAS float*)(ws_ + WS_SAP))[d1] = sc; } }
}
__device__ __forceinline__ void add_y(f32x4 (&a)[4], const unsigned char* ws_, int p, int j, int lane) {
    if (j < 0) { const GAS unsigned long long* y = (const GAS unsigned long long*)((const bf16*)(ws_ + WS_Y0) + (size_t)p * D) + lane;
#pragma unroll
        for (int c = 0; c < 4; ++c) { const unsigned long long w = y[64 * c]; a[c] = (f32x4){bf_lo((unsigned)w), bf_hi((unsigned)w), bf_lo((unsigned)(w >> 32)), bf_hi((unsigned)(w >> 32))}; } }
    else {
#pragma unroll
        for (int c = 0; c < 4; ++c) a[c] = (f32x4){0.f, 0.f, 0.f, 0.f};
#pragma unroll
        for (int k = 0; k < MOE_RKS; ++k) { const GAS unsigned long long* y = (const GAS unsigned long long*)((const bf16*)(ws_ + WS_YR) + (size_t)k * YR_STRIDE + (size_t)(j * 256 + (p & 255)) * D) + lane;
#pragma unroll
            for (int c = 0; c < 4; ++c) { const unsigned long long w = y[64 * c]; a[c] += (f32x4){bf_lo((unsigned)w), bf_hi((unsigned)w), bf_lo((unsigned)(w >> 32)), bf_hi((unsigned)(w >> 32))}; } } }
}
__device__ __forceinline__ void combine_phase(Frame& F_, float* X, bool last, const float* fgain) {
    PHASE_LOCALS
    unsigned char* const ws_ = kargs()->ws;
    int pp0 = 0, pp1 = 0, jj0 = -1, jj1 = -1; float gg0 = 0.f, gg1 = 0.f;
    if (F.lane < 8) { const int ml = blk * 64 + F.wave * 8 + F.lane;
        pp0 = ((const GAS int*)(ws_ + TAB_TOKP))[2 * ml]; pp1 = ((const GAS int*)(ws_ + TAB_TOKP))[2 * ml + 1];
        gg0 = ((const GAS float*)(ws_ + TAB_TOKG))[2 * ml]; gg1 = ((const GAS float*)(ws_ + TAB_TOKG))[2 * ml + 1];
        jj0 = ((const GAS int*)(ws_ + TAB_TILE))[384 + (pp0 >> 8)]; jj1 = ((const GAS int*)(ws_ + TAB_TILE))[384 + (pp1 >> 8)]; }
    for (int i = 0; i < 8; ++i) {
        const int m = blk * 64 + F.wave * 8 + i;
        const int p0 = __shfl(pp0, i), p1 = __shfl(pp1, i), j0 = __shfl(jj0, i), j1 = __shfl(jj1, i);
        const float g0 = __shfl(gg0, i), g1 = __shfl(gg1, i);
        GAS f32x4* xr = (GAS f32x4*)(X + (size_t)m * D) + F.lane;
        f32x4 v[4], a0[4], a1[4];
#pragma unroll
        for (int j = 0; j < 4; ++j) v[j] = xr[64 * j];
        add_y(a0, ws_, __builtin_amdgcn_readfirstlane(p0), __builtin_amdgcn_readfirstlane(j0), F.lane); add_y(a1, ws_, __builtin_amdgcn_readfirstlane(p1), __builtin_amdgcn_readfirstlane(j1), F.lane);
#pragma unroll
        for (int j = 0; j < 4; ++j) v[j] = v[j] + g0 * a0[j] + g1 * a1[j];
        const float rstd = row_rstd(v);
        if (last) {
#pragma unroll
            for (int j = 0; j < 4; ++j) { const f32x4 g = *((const GAS f32x4*)fgain + F.lane + 64 * j); xr[64 * j] = v[j] * rstd * g; }
        } else {
#pragma unroll
            for (int j = 0; j < 4; ++j) xr[64 * j] = v[j];
            store_xq(ws_, m, F.lane, v, rstd);
        }
    }
}

#define MFMA16(a, b, c) __builtin_amdgcn_mfma_f32_16x16x32_bf16((a), (b), (c), 0, 0, 0)
constexpr int HL_QH = 0, HL_KH = 17408, HL_KHT = 34816, HL_VT = 53248, HL_AS = 71680, HL_SPT = 80896, HL_QT = 115712, HL_EGM = 117760, HL_EGL = 118272, HL_PART = 118784;
constexpr size_t WS_LS = WS_OR, WS_SI = WS_OR + 16 * MiB, WS_GS = WS_OR + 32 * MiB;
template <int MODE> __device__ __forceinline__ void hgrn_chunks(Frame& F_, const float* gnorm) {
    PHASE_LOCALS
    unsigned char* const ws_ = kargs()->ws;
    const bf16* QS = (const bf16*)(ws_ + WS_QS); const bf16* VV = (const bf16*)(ws_ + WS_VV); const bf16* GG = (const bf16*)(ws_ + WS_GG);
    const _Float16* LF = (const _Float16*)(ws_ + WS_LF); bf16* OG = (bf16*)(ws_ + WS_OG);
    const int u = blk, bh = u >> 4, sc = u & 15, b = bh >> 3, h = bh & 7;
    const int tid = F.tid, lane = F.lane, w = F.wave, l15 = lane & 15, q = lane >> 4, d = tid & 127, tq = tid >> 7;
    LAS unsigned char* lds = F.lds + RING_OFF;
    LAS bf16* QH = (LAS bf16*)(lds + HL_QH); LAS bf16* KH = (LAS bf16*)(lds + HL_KH); LAS bf16* KHT = (LAS bf16*)(lds + HL_KHT); LAS bf16* VT = (LAS bf16*)(lds + HL_VT);
    LAS bf16* AS = (LAS bf16*)(lds + HL_AS); LAS bf16* SPT = (LAS bf16*)(lds + HL_SPT);
    LAS float* QT = (LAS float*)(lds + HL_QT); LAS float* EGM = (LAS float*)(lds + HL_EGM); LAS float* EGL = (LAS float*)(lds + HL_EGL); LAS float* PART = (LAS float*)(lds + HL_PART);
    if (MODE == 1) { for (int i = tid; i < 9216 / 4; i += NWAVES * 64) ((LAS unsigned*)AS)[i] = 0u; }
    f32x4 U[8];
    if (MODE == 1) { const float* si = (const float*)(ws_ + WS_SI) + (size_t)u * 16384 + 16 * w + l15;
#pragma unroll
        for (int dt = 0; dt < 8; ++dt)
#pragma unroll
            for (int rg = 0; rg < 4; ++rg) U[dt][rg] = si[(16 * dt + 4 * q + rg) * 128]; }
    else {
#pragma unroll
        for (int dt = 0; dt < 8; ++dt) U[dt] = (f32x4){0.f, 0.f, 0.f, 0.f}; }
    float gsum = 0.f;
    const float gn = (MODE == 1) ? gnorm[16 * w + l15] : 0.f;
    const size_t row0 = (size_t)b * T + (size_t)sc * 512;
    bf16 rq[16], rv[16]; _Float16 rl[16];
    { const size_t base = (row0 + 16 * tq) * D + h * 128 + d;
#pragma unroll
        for (int i = 0; i < 16; ++i) { const size_t off = base + (size_t)i * D; rq[i] = (MODE == 1) ? QS[off] : (bf16)0; rv[i] = VV[off]; rl[i] = LF[off]; } }
#pragma nounroll
    for (int c = 0; c < 8; ++c) {
        float qv[16], kv[16], vv[16], g[16];
#pragma unroll
        for (int i = 0; i < 16; ++i) { qv[i] = (MODE == 1) ? bf2f(rq[i]) : 0.f; vv[i] = bf2f(rv[i]); g[i] = (float)rl[i]; kv[i] = 1.0f - __expf(g[i]); }
        { const int cn = c < 7 ? c + 1 : 7; const size_t base = (row0 + cn * 64 + 16 * tq) * D + h * 128 + d;
#pragma unroll
            for (int i = 0; i < 16; ++i) { const size_t off = base + (size_t)i * D; if (MODE == 1) rq[i] = QS[off]; rv[i] = VV[off]; rl[i] = LF[off]; } }
        bf16 rg_[16];
        if (MODE == 1) {
#pragma unroll
            for (int ti = 0; ti < 4; ++ti)
#pragma unroll
                for (int rg = 0; rg < 4; ++rg) rg_[4 * ti + rg] = GG[(row0 + c * 64 + 16 * ti + 4 * q + rg) * D + h * 128 + 16 * w + l15]; }
        __builtin_amdgcn_sched_barrier(0);
#pragma unroll
        for (int i = 1; i < 16; ++i) g[i] += g[i - 1];
        QT[tq * 128 + d] = g[15];
        __syncthreads();
        { const float t0 = QT[d], t1 = QT[128 + d], t2 = QT[256 + d], t3 = QT[384 + d];
            const float basev = tq == 0 ? 0.f : (tq == 1 ? t0 : (tq == 2 ? t0 + t1 : t0 + t1 + t2));
            const float Gm = t0 + t1, Gl = (t0 + t1) + (t2 + t3), ref = (MODE == 1) ? Gm : Gl;
            unsigned kp[8], vp[8];
#pragma unroll
            for (int i = 0; i < 16; i += 2) {
                const float G0 = basev + g[i], G1 = basev + g[i + 1];
                const float kh0 = kv[i] * __expf(fminf(ref - G0, 80.f)), kh1 = kv[i + 1] * __expf(fminf(ref - G1, 80.f));
                kp[i >> 1] = cvtpk(kh0, kh1); vp[i >> 1] = cvtpk(vv[i], vv[i + 1]);
                if (MODE == 1) { const float qh0 = qv[i] * __expf(fminf(G0 - ref, 80.f)), qh1 = qv[i + 1] * __expf(fminf(G1 - ref, 80.f));
                    const unsigned qp = cvtpk(qh0, qh1); QH[(16 * tq + i) * 136 + d] = (bf16)(qp & 0xffffu); QH[(16 * tq + i + 1) * 136 + d] = (bf16)(qp >> 16);
                    KH[(16 * tq + i) * 136 + d] = (bf16)(kp[i >> 1] & 0xffffu); KH[(16 * tq + i + 1) * 136 + d] = (bf16)(kp[i >> 1] >> 16); } }
            *(LAS v4u*)(KHT + d * 72 + 16 * tq) = (v4u){kp[0], kp[1], kp[2], kp[3]}; *(LAS v4u*)(KHT + d * 72 + 16 * tq + 8) = (v4u){kp[4], kp[5], kp[6], kp[7]};
            *(LAS v4u*)(VT + d * 72 + 16 * tq) = (v4u){vp[0], vp[1], vp[2], vp[3]}; *(LAS v4u*)(VT + d * 72 + 16 * tq + 8) = (v4u){vp[4], vp[5], vp[6], vp[7]};
            if (tq == 0) { if (MODE == 1) { EGM[d] = __expf(Gm); EGL[d] = __expf(Gl - Gm); } else { EGL[d] = __expf(Gl); gsum += Gl; } } }
        __syncthreads();
        if (MODE == 1) for (int rb_ = 0; rb_ < REP_HCB; ++rb_) {
            for (int tix = w; tix < 10; tix += 8) { const int ti = tix >= 6 ? 3 : (tix >= 3 ? 2 : (tix >= 1 ? 1 : 0)), si = tix - ti * (ti + 1) / 2;
                f32x4 a = (f32x4){0.f, 0.f, 0.f, 0.f};
#pragma unroll
                for (int ks = 0; ks < 4; ++ks) a = MFMA16(*(const LAS bf16x8*)(QH + (16 * ti + l15) * 136 + 32 * ks + 8 * q), *(const LAS bf16x8*)(KH + (16 * si + l15) * 136 + 32 * ks + 8 * q), a);
#pragma unroll
                for (int rg = 0; rg < 4; ++rg) { const int t = 16 * ti + 4 * q + rg, sI = 16 * si + l15; AS[t * 72 + sI] = (bf16)(cvtpk(sI <= t ? a[rg] : 0.f, 0.f) & 0xffffu); } }
#pragma unroll
            for (int dt = 0; dt < 8; ++dt) { const f32x4 eg = *(const LAS f32x4*)(EGM + 16 * dt + 4 * q); if (rb_ == 0) U[dt] = U[dt] * eg;
                *(LAS unsigned long long*)(SPT + (16 * w + l15) * 136 + 16 * dt + 4 * q) = (unsigned long long)cvtpk(U[dt][0], U[dt][1]) | ((unsigned long long)cvtpk(U[dt][2], U[dt][3]) << 32); }
            __syncthreads();
        }
        bf16x8 Vf[2];
#pragma unroll
        for (int kk = 0; kk < 2; ++kk) Vf[kk] = *(const LAS bf16x8*)(VT + (16 * w + l15) * 72 + 32 * kk + 8 * q);
        if (MODE == 1) for (int rc_ = 0; rc_ < REP_HCC; ++rc_) { if (rc_) __syncthreads();
            bf16x8 Sf[4];
#pragma unroll
            for (int ks = 0; ks < 4; ++ks) Sf[ks] = *(const LAS bf16x8*)(SPT + (16 * w + l15) * 136 + 32 * ks + 8 * q);
            f32x4 o[4];
#pragma unroll
            for (int ti = 0; ti < 4; ++ti) { f32x4 a = (f32x4){0.f, 0.f, 0.f, 0.f};
#pragma unroll
                for (int kk = 0; kk < 2; ++kk) if (kk <= (ti >> 1)) a = MFMA16(*(const LAS bf16x8*)(AS + (16 * ti + l15) * 72 + 32 * kk + 8 * q), Vf[kk], a);
#pragma unroll
                for (int ks = 0; ks < 4; ++ks) a = MFMA16(*(const LAS bf16x8*)(QH + (16 * ti + l15) * 136 + 32 * ks + 8 * q), Sf[ks], a);
                o[ti] = a; }
#pragma unroll
            for (int ti = 0; ti < 4; ++ti)
#pragma unroll
                for (int rg = 0; rg < 4; ++rg) { float p = o[ti][rg] * o[ti][rg]; p += __shfl_xor(p, 1); p += __shfl_xor(p, 2); p += __shfl_xor(p, 4); p += __shfl_xor(p, 8);
                    if (l15 == 0) PART[w * 64 + 16 * ti + 4 * q + rg] = p; }
            __syncthreads();
#pragma unroll
            for (int ti = 0; ti < 4; ++ti)
#pragma unroll
                for (int rg = 0; rg < 4; ++rg) { const int t = 16 * ti + 4 * q + rg; float ss = 0.f;
#pragma unroll
                    for (int ww = 0; ww < 8; ++ww) ss += PART[ww * 64 + t];
                    const float rs = __builtin_amdgcn_rsqf(ss * (1.0f / 128.0f) + EPS);
                    const size_t off = (row0 + c * 64 + t) * D + h * 128 + 16 * w + l15;
                    OG[off] = (bf16)(cvtpk(o[ti][rg] * rs * gn * bf2f(rg_[4 * ti + rg]), 0.f) & 0xffffu); }
        }
        if (MODE == 0) {
#pragma unroll
            for (int dt = 0; dt < 8; ++dt) U[dt] = U[dt] * *(const LAS f32x4*)(EGL + 16 * dt + 4 * q); }
#pragma unroll
        for (int dt = 0; dt < 8; ++dt)
#pragma unroll
            for (int kk = 0; kk < 2; ++kk) U[dt] = MFMA16(*(const LAS bf16x8*)(KHT + (16 * dt + l15) * 72 + 32 * kk + 8 * q), Vf[kk], U[dt]);
        if (MODE == 1) {
#pragma unroll
            for (int dt = 0; dt < 8; ++dt) U[dt] = U[dt] * *(const LAS f32x4*)(EGL + 16 * dt + 4 * q); }
    }
    if (MODE == 0) { float* ls = (float*)(ws_ + WS_LS) + (size_t)u * 16384 + 16 * w + l15;
#pragma unroll
        for (int dt = 0; dt < 8; ++dt)
#pragma unroll
            for (int rg = 0; rg < 4; ++rg) ls[(16 * dt + 4 * q + rg) * 128] = U[dt][rg];
        if (tq == 0) ((float*)(ws_ + WS_GS))[u * 128 + d] = gsum; }
    __syncthreads();
}
__device__ __forceinline__ void hgrn_scan(Frame& F_) {
    PHASE_LOCALS
    unsigned char* const ws_ = kargs()->ws;
    const float* LS = (const float*)(ws_ + WS_LS); const float* GS = (const float*)(ws_ + WS_GS); float* SI = (float*)(ws_ + WS_SI);
    const int x = (blk * NWAVES * 64 + F.tid) * 2, bh = x >> 14, de = x & 16383, dd = de >> 7;
    f32x2 S = (f32x2){0.f, 0.f};
#pragma unroll
    for (int sc = 0; sc < 16; ++sc) { const int u = bh * 16 + sc;
        *(GAS f32x2*)(SI + (size_t)u * 16384 + de) = S;
        const float dec = __expf(GS[u * 128 + dd]); const f32x2 ls = *(const GAS f32x2*)(LS + (size_t)u * 16384 + de);
        S = dec * S + ls; }
}
typedef float f32x16 __attribute__((ext_vector_type(16)));
#define MFMA32(a, b, c) __builtin_amdgcn_mfma_f32_32x32x16_bf16((a), (b), (c), 0, 0, 0)
#define PACK8(x, s) __builtin_bit_cast(bf16x8, (v4u){cvtpk((x)[8 * (s)], (x)[8 * (s) + 1]), cvtpk((x)[8 * (s) + 2], (x)[8 * (s) + 3]), cvtpk((x)[8 * (s) + 4], (x)[8 * (s) + 5]), cvtpk((x)[8 * (s) + 6], (x)[8 * (s) + 7])})
__device__ __forceinline__ int swap23(int x) { return (x & ~12) | ((x & 4) << 1) | ((x & 8) >> 1); }
__device__ __forceinline__ void attn_mfma(Frame& F_, int cv_first, int cv_count) {
    PHASE_LOCALS
    unsigned char* const ws_ = kargs()->ws;
    const bf16* Q = (const bf16*)(ws_ + WS_Q); const bf16* K = (const bf16*)(ws_ + WS_K); const bf16* VT = (const bf16*)(ws_ + WS_VT); bf16* AO = (bf16*)(ws_ + WS_AO);
    const int lane = F.lane, r = lane & 31, hh = lane >> 5;
    bf16x8 Tf[2];
    { const int kout = swap23(r);
#pragma unroll
        for (int s = 0; s < 2; ++s)
#pragma unroll
            for (int j = 0; j < 8; ++j) Tf[s][j] = (16 * s + 8 * hh + j >= kout) ? (short)0xBF80 : (short)0; }
    const int gw = blk * NWAVES + F.wave, bh = gw >> 6, qa = gw & 63, b = bh >> 4, h = bh & 15;
    const bf16* Kb = K + (size_t)bh * 256 * 2048 + lane * 8;
    const bf16* Vb = VT + (size_t)bh * 256 * 2048 + lane * 8;
    bf16x8 Qp[4], Kp[4], Vp[4];
    { const int qt0 = qa; const bf16* qp = Q + (size_t)(b * T + qt0 * 32 + r) * D + h * 64 + 8 * hh; const bf16* kp = Kb + (size_t)qt0 * 2048; const bf16* vp = Vb + (size_t)qt0 * 2048;
#pragma unroll
        for (int x = 0; x < 4; ++x) { Qp[x] = *(const GAS bf16x8*)(qp + 16 * x); Kp[x] = *(const GAS bf16x8*)(kp + 512 * x); Vp[x] = *(const GAS bf16x8*)(vp + 512 * x); } }
#pragma nounroll
    for (int it = 0; it < 4; ++it) {
        const int qt = (it == 0) ? qa : (it == 1) ? 127 - qa : (it == 2) ? 128 + qa : 255 - qa, q0 = qt * 32;
        bf16x8 Qf[4], Kf[4], Vf[4], Kn[4], Vn[4];
#pragma unroll
        for (int x = 0; x < 4; ++x) { Qf[x] = Qp[x]; Kf[x] = Kp[x]; Vf[x] = Vp[x]; }
        { const int qn = (it == 0) ? 127 - qa : (it == 1) ? 128 + qa : 255 - qa;
            const bf16* qp = Q + (size_t)(b * T + qn * 32 + r) * D + h * 64 + 8 * hh; const bf16* kp = Kb + (size_t)qn * 2048; const bf16* vp = Vb + (size_t)qn * 2048;
#pragma unroll
            for (int x = 0; x < 4; ++x) { Qp[x] = *(const GAS bf16x8*)(qp + 16 * x); Kp[x] = *(const GAS bf16x8*)(kp + 512 * x); Vp[x] = *(const GAS bf16x8*)(vp + 512 * x); } }
        __builtin_amdgcn_sched_barrier(0);
        f32x16 O0, O1;
#pragma unroll
        for (int i = 0; i < 16; ++i) { O0[i] = 0.f; O1[i] = 0.f; }
        float R = 0.f;
        for (int kb = qt; kb >= 0; --kb) {
            { const int kn = kb > 0 ? kb - 1 : 0; const bf16* kp = Kb + (size_t)kn * 2048; const bf16* vp = Vb + (size_t)kn * 2048;
#pragma unroll
                for (int x = 0; x < 4; ++x) { Kn[x] = *(const GAS bf16x8*)(kp + 512 * x); Vn[x] = *(const GAS bf16x8*)(vp + 512 * x); } }
            __builtin_amdgcn_sched_barrier(0);
            f32x16 S;
#pragma unroll
            for (int i = 0; i < 16; ++i) S[i] = 0.f;
#pragma unroll
            for (int ks = 0; ks < 4; ++ks) S = MFMA32(Kf[ks], Qf[ks], S);
            f32x16 L;
            const bool diag = (kb == qt);
#pragma unroll
            for (int i = 0; i < 16; ++i) { const float z = fminf(S[i], 126.0f); S[i] = z; L[i] = __builtin_amdgcn_logf(1.0f + __builtin_amdgcn_exp2f(z)); }
            if (diag) {
#pragma unroll
                for (int i = 0; i < 16; ++i) { const int kl = (i & 3) + 4 * ((i >> 2) & 1) + 16 * (i >> 3) + 8 * hh; if (kl >= r) L[i] = 0.f; }
            }
            const bf16x8 L0 = PACK8(L, 0), L1 = PACK8(L, 1);
            const float z0 = S[0];
            S = MFMA32(Tf[0], L0, S); S = MFMA32(Tf[1], L1, S);
            const float tot = __shfl(z0 - S[0], r);
#pragma unroll
            for (int i = 0; i < 16; ++i) S[i] = __builtin_amdgcn_exp2f(S[i] + R);
            if (diag) {
#pragma unroll
                for (int i = 0; i < 16; ++i) { const int kl = (i & 3) + 4 * ((i >> 2) & 1) + 16 * (i >> 3) + 8 * hh; if (kl >= r) S[i] = 0.f; }
            }
            R -= tot;
            const bf16x8 P0 = PACK8(S, 0), P1 = PACK8(S, 1);
            O0 = MFMA32(Vf[0], P0, O0); O0 = MFMA32(Vf[1], P1, O0);
            O1 = MFMA32(Vf[2], P0, O1); O1 = MFMA32(Vf[3], P1, O1);
            if (__builtin_amdgcn_ballot_w64(R >= -150.0f) == 0ull) break;
#pragma unroll
            for (int x = 0; x < 4; ++x) { Kf[x] = Kn[x]; Vf[x] = Vn[x]; }
        }
        bf16* op = AO + (size_t)(b * T + q0 + r) * D + h * 64 + 4 * hh;
#pragma unroll
        for (int g = 0; g < 4; ++g) {
            *(GAS unsigned long long*)(op + 8 * g) = (unsigned long long)cvtpk(O0[4 * g], O0[4 * g + 1]) | ((unsigned long long)cvtpk(O0[4 * g + 2], O0[4 * g + 3]) << 32);
            *(GAS unsigned long long*)(op + 32 + 8 * g) = (unsigned long long)cvtpk(O1[4 * g], O1[4 * g + 1]) | ((unsigned long long)cvtpk(O1[4 * g + 2], O1[4 * g + 3]) << 32); }
        if ((it & 1) == 0) { const int ci = gw + (it >> 1) * (F.G * NWAVES); if (ci < cv_count) conv_one_moe_down(cv_first + ci, 1, ws_, F.lds + RING_OFF, F.wave, lane); }
    }
}

__device__ __forceinline__ void prologue(Frame& F_) {
    PHASE_LOCALS
    unsigned char* const ws_ = kargs()->ws;
#define in (kargs()->in)
    if (blk == 0) { GAS float* LB = (GAS float*)(ws_ + TAB_LB); const float* raw = in[4];
        for (int c = F.tid; c < D; c += NWAVES * 64) { const float a = raw[c], b = raw[D + c], mx = fmaxf(a, b), ea = __expf(a - mx), eb = __expf(b - mx); LB[c] = 0.f; LB[D + c] = eb / (ea + eb); } }
    conv8_all(F, true, 0);
    conv_all(F, true, 0);
    __syncthreads();
    norm_phase(F, in[0], false, nullptr, nullptr);
#undef in
}

#ifndef REP_PRO
#define REP_PRO 1
#endif
#ifndef REP_HGRN
#define REP_HGRN 1
#endif
#ifndef REP_HG0
#define REP_HG0 1
#endif
#ifndef REP_HG1
#define REP_HG1 1
#endif
#ifndef REP_ATTN
#define REP_ATTN 1
#endif
#ifndef REP_NORM
#define REP_NORM 1
#endif
#ifndef REP_CONV
#define REP_CONV 1
#endif
#ifndef REP_MDOWN
#define REP_MDOWN 1
#endif
#ifndef REP_MGU
#define REP_MGU 1
#endif
#ifndef REP_OUTP
#define REP_OUTP 1
#endif
#ifndef REP_DDOWN
#define REP_DDOWN 1
#endif
#ifndef REP_BAR
#define REP_BAR 1
#endif
#ifndef REP_SCAT
#define REP_SCAT 1
#endif
#ifndef REP_WIN
#define REP_WIN 1
#endif
#ifndef REP_DGU
#define REP_DGU 1
#endif
#ifndef REP_QKV
#define REP_QKV 1
#endif
#define REPEAT(n) _Pragma("nounroll") for (int rep_ = 0; rep_ < (n); ++rep_)

constexpr int NPH = 1 + (5 + 1 + 3) + (5 + 1 + 4) + (3 + 1 + 3) + (3 + 1 + 4);
__global__ void __launch_bounds__(NWAVES * 64, 2) yoco_fwd(Args) {
    extern __shared__ __attribute__((aligned(16))) unsigned char lds[];
    Frame F;
    F.lds = (LAS unsigned char*)lds;
    F.MISC = (volatile LAS unsigned*)(F.lds + MISC_OFF);
    F.tid = threadIdx.x; F.lane = F.tid & 63; F.wave = __builtin_amdgcn_readfirstlane(F.tid >> 6);
    F.G = gridDim.x; { const int bx = blockIdx.x; F.vcu = (F.G % 8 == 0) ? (bx % 8) * (F.G / 8) + bx / 8 : bx; }
    for (int u = F.tid; u < (LDS_BYTES - LDSCTL_OFF) / 4; u += NWAVES * 64) ((LAS unsigned*)(F.lds + LDSCTL_OFF))[u] = 0u;
    __syncthreads();
    const int lo = kargs()->ph_lo, hi = kargs()->ph_hi;
    XcdBarrier bar; bar.bar = (unsigned*)(kargs()->ws + WS_CTL) + CW_BAR; bar.x = 0; bar.st = nullptr;
    if (hi - lo > 1) bar = xcd_barrier_post((unsigned*)(kargs()->ws + WS_CTL) + CW_BAR, F.MISC + 8);
    int ph = 0;
#define PH_ON (ph >= lo && ph < hi)
#define PH_END do { if (ph >= lo && ph + 1 < hi) { XcdBarrier b2_; b2_.bar = (unsigned*)(wsbase() + WS_CTL) + CW_BAR; b2_.st = bar.st; b2_.x = lg((int)__builtin_amdgcn_readfirstlane(bar.x)); xcd_barrier(b2_); } ++ph; } while (0)
#define in (kargs()->in)
#define X (kargs()->out)
#define XQB ((const bf16*)(wsbase() + WS_XQ))
#define W8P(off) ((const bf16*)(wsbase() + WS_W8 + ((off) - WS_WIN) / 2))
#define SBP(off) ((const float*)(wsbase() + WS_SB) + ((off) - WS_WIN) / 2048)
#define SAPTR ((const float*)(wsbase() + WS_SA))
#define ws (wsbase())

    if (PH_ON) REPEAT(REP_PRO) { prologue(F); __syncthreads(); }
    PH_END;
#pragma nounroll
    for (int layer = 0; layer < 4; ++layer) {
        const bool hg = layer < 2, moe = (layer & 1) != 0;
        const int fi = layer >> 1;
        if (hg) {
            if (PH_ON) {
                const size_t wo = WS_WIN + (size_t)layer * 4 * D * D * 2;
                pg8::Gemm g{XQB, W8P(wo), M, 4 * D, D / 2, D / 2, 0, 0, 0, 0, SAPTR, SBP(wo)}; pg8::StaticOrder S; S.init(M, 4 * D, lg(F.G), lg((int)blockIdx.x));
                pg8::EpiHgrnIn E{(bf16*)(ws + WS_QS), (_Float16*)(ws + WS_LF), (const float*)(ws + TAB_LB) + layer * D};
                static_assert(WS_VV == WS_QS + 2 * 2 * pg8::EpiHgrnIn::SEGSTRIDE && WS_GG == WS_QS + 3 * 2 * pg8::EpiHgrnIn::SEGSTRIDE, "segment buffers are 32 MiB apart");
                REPEAT(REP_WIN) { pg8::gemm_phase<pg8::EpiHgrnIn, pg8::StaticOrder, true, true, true>(F.lds + RING_OFF, g, S, E); __syncthreads(); }
            }
            PH_END;
            if (PH_ON) REPEAT(REP_HGRN * REP_HG0) hgrn_chunks<0>(F, nullptr);
            PH_END;
            if (PH_ON) REPEAT(REP_HGRN) hgrn_scan(F);
            PH_END;
            if (PH_ON) REPEAT(REP_HGRN * REP_HG1) hgrn_chunks<1>(F, in[5] + layer * 128);
            PH_END;
        } else {
            if (PH_ON) {
                const int nw = (layer == 2) ? 3 : 1;
#pragma nounroll
                for (int w = 0; w < nw * REP_QKV; ++w) {
                    pg8::Gemm g; pg8::EpiBf16P E; pg8::StaticOrder S;
                    if (w % nw == 0) { const size_t wo = WS_WQ + (size_t)(layer - 2) * D * D * 2; g = pg8::Gemm{XQB, W8P(wo), M, D, D / 2, D / 2, 0, 0, 0, 0, SAPTR, SBP(wo)}; E = pg8::EpiBf16P{(bf16*)(ws + WS_Q), D, 0}; }
                    else if (w % nw == 1) { g = pg8::Gemm{XQB, W8P(WS_WK), M, D, D / 2, D / 2, 0, 0, 0, 0, SAPTR, SBP(WS_WK)}; E = pg8::EpiBf16P{(bf16*)(ws + WS_K), D, 1}; }
                    else { g = pg8::Gemm{W8P(WS_WV), XQB, D, M, D / 2, D / 2, 0, 0, 0, 0, SBP(WS_WV), SAPTR}; E = pg8::EpiBf16P{(bf16*)(ws + WS_VT), M, 2}; }
                    S.init(g.M, g.N, lg(F.G), lg((int)blockIdx.x));
                    pg8::gemm_phase<pg8::EpiBf16P, pg8::StaticOrder, true, true, true>(F.lds + RING_OFF, g, S, E);
                    __syncthreads();
                }
            }
            PH_END;
            if (PH_ON) REPEAT(REP_ATTN) attn_mfma(F, (layer - 2) * (CONV_MOE_ITEMS / 2), CONV_MOE_ITEMS / 2);
            PH_END;
        }
        if (PH_ON) {
            const float* xin = (layer == 0) ? in[0] : X;
            pg8::Gemm g{hg ? (const bf16*)(ws + WS_OG) : (const bf16*)(ws + WS_AO), hg ? (const bf16*)(ws + WS_WOUT) + (size_t)layer * D * D : (const bf16*)(ws + WS_WO) + (size_t)(layer - 2) * D * D, M, D, D, D};
            pg8::StaticOrder S; S.init(M, D, lg(F.G), lg((int)blockIdx.x));
            REPEAT(REP_OUTP) { pg8::EpiResid E{xin, rep_ == 0 ? X : (float*)(ws + WS_OR), D};
                pg8::gemm_phase<pg8::EpiResid, pg8::StaticOrder, true, true>(F.lds + RING_OFF, g, S, E); __syncthreads(); }
        }
        PH_END;
        if (PH_ON) REPEAT(REP_NORM) { norm_phase(F, X, moe, in[13] + (size_t)fi * D * NE, in[2] + layer * D); __syncthreads(); }
        PH_END;
        if (moe) { if (PH_ON) REPEAT(REP_SCAT) { scatter_phase(F); __syncthreads(); } PH_END; }
        if (PH_ON) {
            const int nrt = moe ? __builtin_amdgcn_readfirstlane(((const GAS int*)(ws + TAB_TILE))[160]) : M / 256;
            const size_t wo = WS_WGU + (size_t)fi * 2 * FFD * D * 2;
            pg8::Gemm g{moe ? (const bf16*)(ws + WS_XPQ) : XQB, moe ? (const bf16*)(ws + WS_WM8) : W8P(wo), nrt * 256, moe ? 2 * FFE : 2 * FFD, D / 2, D / 2, 0, 0, 0, 0,
                        moe ? (const float*)(ws + WS_SAP) : SAPTR, moe ? (const float*)(ws + WS_SBM) : SBP(wo)};
            pg8::MoeOrder S; S.init(nrt, (moe ? 2 * FFE : 2 * FFD) / 256, 1, D / 2, lg(F.G), lg((int)blockIdx.x), moe ? (const int*)(ws + TAB_TILE) : (const int*)(ws + WS_CTL) + CW_ZTAB, nullptr, 0);
            pg8::EpiSwiglu E{moe ? (bf16*)(ws + WS_HM) : (bf16*)(ws + WS_HB), moe ? MROWS : M};
            REPEAT(moe ? REP_MGU : REP_DGU) { pg8::gemm_phase<pg8::EpiSwiglu, pg8::MoeOrder, true, true, true>(F.lds + RING_OFF, g, S, E); __syncthreads(); }
        }
        PH_END;
        if (PH_ON) {
            const int* TE = (const int*)(ws + TAB_TILE);
#pragma nounroll
            for (int w = 0; w < (moe ? 2 : 1); ++w) {
                const int nrt = moe ? __builtin_amdgcn_readfirstlane(((const GAS int*)TE)[w == 0 ? 336 : 368]) : M / 256;
                const int ksn = (moe && w == 1) ? MOE_RKS : 1, kl = moe ? (w == 1 ? MOE_RKL : FFE) : FFD;
                pg8::Gemm g{moe ? (const bf16*)(ws + WS_HM) : (const bf16*)(ws + WS_HB), moe ? (const bf16*)(ws + (layer == 1 ? WS_WMDN : WS_WMDN2)) : (const bf16*)(ws + WS_WDN) + (size_t)fi * D * FFD, nrt * 256, D, moe ? FFE : FFD, kl,
                            64, 64, (long)(moe ? MROWS : M) * 128, (long)(moe ? NE * D : D) * 128};
                pg8::MoeOrder S; S.init(nrt, D / 256, ksn, kl, lg(F.G), lg((int)blockIdx.x), moe ? TE : (const int*)(ws + WS_CTL) + CW_ZTAB, moe ? TE + (w == 0 ? 176 : 352) : nullptr, w);
                if (moe) { REPEAT(REP_MDOWN) { pg8::EpiDownMoe E{(bf16*)(ws + (w == 0 ? WS_Y0 : WS_YR)), YR_STRIDE, kl, D};
                    pg8::gemm_phase<pg8::EpiDownMoe, pg8::MoeOrder, true, true>(F.lds + RING_OFF, g, S, E); __syncthreads(); } }
                else { REPEAT(REP_DDOWN) { pg8::EpiDown E{X, rep_ == 0 ? X : (float*)(ws + WS_OR), nullptr, 0, kl, D};
                    pg8::gemm_phase<pg8::EpiDown, pg8::MoeOrder, true, true>(F.lds + RING_OFF, g, S, E); __syncthreads(); } }
            }
        }
        PH_END;
        if (PH_ON) {
            if (moe) { combine_phase(F, X, layer == 3, in[17]); if (layer == 1) REPEAT(REP_CONV) { __syncthreads(); conv8_all(F, false, 1); } }
            else norm_phase(F, X, false, nullptr, nullptr);
        }
        PH_END;
    }
#undef PH_ON
#undef PH_END
#undef in
#undef X
#undef ws
#undef XQB
#undef W8P
#undef SBP
#undef SAPTR
}

#ifndef MK_PER_PHASE
#define MK_PER_PHASE 0
#endif
extern "C" void kernel_launch(void* const* d_in, const int* in_sizes, int n_in, void* d_out, int out_size, void* d_ws, size_t ws_size, hipStream_t stream) {
    static int ok = 0;
    if (ok == 0) {
        if (n_in != 18 || in_sizes[0] != M * D || out_size != M * D || ws_size < WS_END) { fprintf(stderr, "kernel_launch: unexpected shapes / workspace (n_in %d, ws %zu, need %zu); nothing launched\n", n_in, ws_size, (size_t)WS_END); ok = -1; return; }
        if (hipFuncSetAttribute((const void*)yoco_fwd, hipFuncAttributeMaxDynamicSharedMemorySize, LDS_BYTES) != hipSuccess) { fprintf(stderr, "kernel_launch: hipFuncSetAttribute failed\n"); ok = -1; return; }
        int per_cu = 0;
        if (hipOccupancyMaxActiveBlocksPerMultiprocessor(&per_cu, (const void*)yoco_fwd, NWAVES * 64, LDS_BYTES) != hipSuccess || per_cu < 1) fprintf(stderr, "kernel_launch: note: occupancy query reports %d workgroups per CU\n", per_cu);
        (void)hipGetLastError();
        ok = 1;
    }
    if (ok < 0) return;
    (void)hipMemsetAsync((char*)d_ws + WS_CTL, 0, CTL_ZERO_BYTES, stream);
    Args a{};
    for (int i = 0; i < 18; ++i) a.in[i] = (const float*)d_in[i];
    a.out = (float*)d_out; a.ws = (unsigned char*)d_ws;
#if MK_PER_PHASE
    for (int p = 0; p < NPH; ++p) { a.ph_lo = p; a.ph_hi = p + 1; hipLaunchKernelGGL(yoco_fwd, dim3(GRID), dim3(NWAVES * 64), LDS_BYTES, stream, a); }
#else
    a.ph_lo = 0; a.ph_hi = NPH; hipLaunchKernelGGL(yoco_fwd, dim3(GRID), dim3(NWAVES * 64), LDS_BYTES, stream, a);
#endif
}
```

```cpp
#include <hip/hip_runtime.h>
#include <cstdio>
#include <cstdint>
#ifndef REP_EPI8
#define REP_EPI8 1
#endif
#ifndef REP_HCC
#define REP_HCC 1
#endif
#ifndef REP_HCB
#define REP_HCB 1
#endif
namespace pg8 {
#define PG8_LAS __attribute__((address_space(3)))
typedef unsigned short bf16_t;
typedef short bf16x8 __attribute__((ext_vector_type(8)));
typedef float f32x4 __attribute__((ext_vector_type(4)));
typedef unsigned u32x4 __attribute__((ext_vector_type(4)));
constexpr int BM = 256, BK = 64, HALF = 128, HTB = HALF * BK * 2  , STAGE_BYTES = 8 * HTB, NXCD = 8, WGM = 4;

__host__ __device__ __forceinline__ int lds_byte(int r, int c) { const int st = (r >> 4) * 2 + (c >> 5), rr = r & 15, cc = c & 31, ob = rr * 64 + cc * 2; return st * 1024 + (ob ^ (((ob >> 9) & 1) << 5)); }
__host__ __device__ __forceinline__ void stage_rc(int b, int& R, int& C) { const int st = b / 1024, sb = b % 1024, swz = sb ^ (((sb >> 9) & 1) << 5); R = (st >> 1) * 16 + swz / 64; C = (st & 1) * 32 + (swz % 64) / 2; }
__host__ __device__ __forceinline__ int perm32(int rho) { const int n = rho >> 4, i = rho & 15; return 8 * (i >> 2) + 4 * n + (i & 3); }

struct Unit { int pm, pn, pc, ko, po; };
struct Gemm { const bf16_t* A; const bf16_t* Bt; int M, N, K, KL; int pA = 0, pB = 0; long ksA = 0, ksB = 0; const float* sA = nullptr; const float* sB = nullptr; };

struct StaticOrder {
    int nM, nN, nwg, G, c;
    __host__ __device__ void init(int M, int N, int G_, int c_) { nM = M / BM; nN = N / BM; nwg = nM * nN; G = G_; c = c_; }
    __host__ __device__ bool next(int i, Unit& u) const {
        const long L = (long)i * G + c; if (L >= nwg) return false;
        int wgid = (int)L; { const int q = nwg / NXCD, r = nwg % NXCD, xcd = wgid % NXCD, off = wgid / NXCD; wgid = (xcd < r ? xcd * (q + 1) : r * (q + 1) + (xcd - r) * q) + off; }
        const int nig = WGM * nN, gid = wgid / nig, fm = gid * WGM, gsz = (nM - fm) < WGM ? (nM - fm) : WGM;
        u.pm = fm + ((wgid % nig) % gsz); u.pn = (wgid % nig) / gsz; u.pc = u.pn; u.ko = 0; u.po = u.pm; return true;
    }
    __device__ __forceinline__ void a_ready(const Unit&) const {}
    __device__ __forceinline__ void done(const Unit&) const {}
};

__device__ __forceinline__ unsigned cvt_pk_bf16(float lo, float hi) { unsigned r; asm volatile("v_cvt_pk_bf16_f32 %0, %1, %2" : "=v"(r) : "v"(lo), "v"(hi)); return r; }
typedef float f32x2 __attribute__((ext_vector_type(2)));

typedef int i32x4 __attribute__((ext_vector_type(4)));
template <class E, class = void> struct AccInit { static constexpr bool value = false; };
template <class E> struct AccInit<E, decltype((void)E::INIT)> { static constexpr bool value = E::INIT; };
template <bool I8> struct AccSel { typedef f32x4 type; };
template <> struct AccSel<true> { typedef i32x4 type; };
__device__ __forceinline__ f32x4 mma16(bf16x8 a, bf16x8 b, f32x4 c) { return __builtin_amdgcn_mfma_f32_16x16x32_bf16(a, b, c, 0, 0, 0); }
__device__ __forceinline__ i32x4 mma16(bf16x8 a, bf16x8 b, i32x4 c) { return __builtin_amdgcn_mfma_i32_16x16x64_i8(__builtin_bit_cast(i32x4, a), __builtin_bit_cast(i32x4, b), c, 0, 0, 0); }
template <bool PERM> __device__ __forceinline__ void dequant(const f32x4 (&)[2][2][4][2], f32x4 (&)[2][2][4][2], const PG8_LAS float*, int, int, int, int) {}
template <bool PERM> __device__ __forceinline__ void dequant(const i32x4 (&acc)[2][2][4][2], f32x4 (&f)[2][2][4][2], const PG8_LAS float* SL, int wr, int wc, int fr, int fq) {
    const PG8_LAS float* sa = SL + wr * 64 + fr; const PG8_LAS float* sb = SL + 256 + wc * 32 + (PERM ? 8 * fq : 4 * fq);
    f32x4 cs[2][2];
#pragma unroll
    for (int bj = 0; bj < 2; ++bj)
#pragma unroll
        for (int n = 0; n < 2; ++n) cs[bj][n] = *(const PG8_LAS f32x4*)(sb + bj * HALF + (PERM ? 4 * n : 16 * n));
#pragma unroll
    for (int ai = 0; ai < 2; ++ai)
#pragma unroll
        for (int m = 0; m < 4; ++m) { const float rs = sa[ai * HALF + m * 16];
#pragma unroll
            for (int bj = 0; bj < 2; ++bj)
#pragma unroll
                for (int n = 0; n < 2; ++n) { const i32x4 a = acc[ai][bj][m][n]; f[ai][bj][m][n] = (f32x4){(float)a[0], (float)a[1], (float)a[2], (float)a[3]} * (cs[bj][n] * rs); } }
}
__device__ __forceinline__ float fsigmoid(float x) { return __builtin_amdgcn_rcpf(1.0f + __builtin_amdgcn_exp2f(-1.44269504089f * x)); }
__device__ __forceinline__ float fsilu(float x) { return x * fsigmoid(x); }

struct EpiResid {
    static constexpr bool PERM = false, AFTER_DRAIN = false, INIT = true;
    const float* base; float* out; int ldc;
    __device__ __forceinline__ void init(f32x4 (&acc)[2][2][4][2], const Unit& u, int wr, int wc, int fr, int fq) const {
        const int row0 = u.pm * BM + wr * 64 + fr, col0 = u.pc * BM + wc * 32 + 4 * fq;
#pragma unroll
        for (int ai = 0; ai < 2; ++ai)
#pragma unroll
            for (int m = 0; m < 4; ++m) { const size_t off = (size_t)(row0 + ai * HALF + m * 16) * ldc + col0;
#pragma unroll
                for (int bj = 0; bj < 2; ++bj)
#pragma unroll
                    for (int n = 0; n < 2; ++n) acc[ai][bj][m][n] = *(const f32x4*)(base + off + bj * HALF + n * 16); }
    }
    __device__ __forceinline__ void operator()(const f32x4 (&acc)[2][2][4][2], const Unit& u, int wr, int wc, int fr, int fq) const {
        const int row0 = u.pm * BM + wr * 64 + fr, col0 = u.pc * BM + wc * 32 + 4 * fq;
#pragma unroll
        for (int ai = 0; ai < 2; ++ai)
#pragma unroll
            for (int m = 0; m < 4; ++m) { const size_t off = (size_t)(row0 + ai * HALF + m * 16) * ldc + col0;
#pragma unroll
                for (int bj = 0; bj < 2; ++bj)
#pragma unroll
                    for (int n = 0; n < 2; ++n) *(f32x4*)(out + off + bj * HALF + n * 16) = acc[ai][bj][m][n]; }
    }
};
struct EpiF32 {
    static constexpr bool PERM = false, AFTER_DRAIN = false;
    float* out; int ldc;
    __device__ __forceinline__ void operator()(const f32x4 (&acc)[2][2][4][2], const Unit& u, int wr, int wc, int fr, int fq) const {
        const int row0 = u.pm * BM + wr * 64 + fr, col0 = u.pc * BM + wc * 32 + 4 * fq;
#pragma unroll
        for (int ai = 0; ai < 2; ++ai)
#pragma unroll
            for (int m = 0; m < 4; ++m) { const size_t off = (size_t)(row0 + ai * HALF + m * 16) * ldc + col0;
#pragma unroll
                for (int bj = 0; bj < 2; ++bj)
#pragma unroll
                    for (int n = 0; n < 2; ++n) *(f32x4*)(out + off + bj * HALF + n * 16) = acc[ai][bj][m][n]; }
    }
};
struct EpiBf16P {
    static constexpr bool PERM = true, AFTER_DRAIN = false;
    bf16_t* O; int ldc, mode;
    __device__ __forceinline__ void operator()(const f32x4 (&acc)[2][2][4][2], const Unit& u, int wr, int wc, int fr, int fq) const {
        const int row0 = u.pm * BM + wr * 64 + fr, col0 = u.pc * BM + wc * 32 + 8 * fq;
#pragma unroll
        for (int ai = 0; ai < 2; ++ai)
#pragma unroll
            for (int m = 0; m < 4; ++m) { const int row = row0 + ai * HALF + m * 16;
#pragma unroll
                for (int bj = 0; bj < 2; ++bj) { const f32x4 v0 = acc[ai][bj][m][0], v1 = acc[ai][bj][m][1]; const int col = col0 + bj * HALF;
                    u32x4 w; w.x = cvt_pk_bf16(v0[0], v0[1]); w.y = cvt_pk_bf16(v0[2], v0[3]); w.z = cvt_pk_bf16(v1[0], v1[1]); w.w = cvt_pk_bf16(v1[2], v1[3]);
                    size_t off;
                    if (mode == 0) off = (size_t)row * ldc + col;
                    else if (mode == 1) { const int b = row >> 13, key = row & 8191, kk = key & 31, rr = (kk & ~12) | ((kk & 4) << 1) | ((kk & 8) >> 1), h = col >> 6;
                        off = ((size_t)((((b * 16 + h) * 256 + (key >> 5)) * 4 + ((col & 63) >> 4)) * 64 + ((col & 15) >> 3) * 32 + rr)) * 8; }
                    else { const int h = row >> 6, d = row & 63, b = col >> 13, key = col & 8191;
                        off = ((size_t)((((b * 16 + h) * 256 + (key >> 5)) * 4 + (d >> 5) * 2 + ((key & 31) >> 4)) * 64 + ((key & 15) >> 3) * 32 + (d & 31))) * 8; }
                    *(u32x4*)(O + off) = w; } }
    }
};
struct EpiSwiglu {
    static constexpr bool PERM = true, AFTER_DRAIN = false;
    bf16_t* H; int rows;
    __device__ __forceinline__ void operator()(const f32x4 (&acc)[2][2][4][2], const Unit& u, int wr, int wc, int fr, int fq) const {
        const int row0 = u.pm * BM + wr * 64 + fr, kt = u.pc * 2 + (wc >> 1), c64 = (wc & 1) * 32 + 8 * fq;
#pragma unroll
        for (int ai = 0; ai < 2; ++ai)
#pragma unroll
            for (int m = 0; m < 4; ++m) { bf16_t* rowp = H + ((size_t)kt * rows + (row0 + ai * HALF + m * 16)) * 64 + c64;
                float h[8];
#pragma unroll
                for (int n = 0; n < 2; ++n)
#pragma unroll
                    for (int j = 0; j < 4; ++j) h[4 * n + j] = fsilu(acc[ai][0][m][n][j]) * acc[ai][1][m][n][j];
                u32x4 w; w.x = cvt_pk_bf16(h[0], h[1]); w.y = cvt_pk_bf16(h[2], h[3]); w.z = cvt_pk_bf16(h[4], h[5]); w.w = cvt_pk_bf16(h[6], h[7]);
                *(u32x4*)rowp = w; }
    }
};
struct EpiHgrnIn {
    static constexpr bool PERM = true, AFTER_DRAIN = false;
    bf16_t* QS; _Float16* LF; const float* lb;
    static constexpr size_t SEGSTRIDE = (size_t)16 << 20;
    __device__ __forceinline__ void operator()(const f32x4 (&acc)[2][2][4][2], const Unit& u, int wr, int wc, int fr, int fq) const {
        const int seg = u.pc >> 2;
        const int row0 = u.pm * BM + wr * 64 + fr, col0 = (u.pc & 3) * BM + wc * 32 + 8 * fq;
        bf16_t* O = QS + (size_t)seg * SEGSTRIDE;
        float lbv[2][8];
        if (seg == 1) {
#pragma unroll
            for (int bj = 0; bj < 2; ++bj) { const f32x4 a = *(const f32x4*)(lb + col0 + bj * HALF), b = *(const f32x4*)(lb + col0 + bj * HALF + 4);
#pragma unroll
                for (int j = 0; j < 4; ++j) { lbv[bj][j] = a[j]; lbv[bj][4 + j] = b[j]; } }
        }
#pragma unroll
        for (int ai = 0; ai < 2; ++ai)
#pragma unroll
            for (int m = 0; m < 4; ++m) { const size_t roff = (size_t)(row0 + ai * HALF + m * 16) * 1024 + col0;
#pragma unroll
                for (int bj = 0; bj < 2; ++bj) {
                    float v[8];
#pragma unroll
                    for (int n = 0; n < 2; ++n)
#pragma unroll
                        for (int j = 0; j < 4; ++j) v[4 * n + j] = acc[ai][bj][m][n][j];
                    if (seg == 1) {
                        typedef _Float16 f16x2 __attribute__((ext_vector_type(2)));
                        float lf[8];
#pragma unroll
                        for (int j = 0; j < 8; ++j) { const float sg = fsigmoid(v[j]); const float f = lbv[bj][j] + (1.0f - lbv[bj][j]) * sg; lf[j] = 0.69314718056f * __builtin_amdgcn_logf(fmaxf(f, 1e-30f)); }
                        u32x4 hw;
                        hw.x = __builtin_bit_cast(unsigned, (f16x2){(_Float16)lf[0], (_Float16)lf[1]}); hw.y = __builtin_bit_cast(unsigned, (f16x2){(_Float16)lf[2], (_Float16)lf[3]});
                        hw.z = __builtin_bit_cast(unsigned, (f16x2){(_Float16)lf[4], (_Float16)lf[5]}); hw.w = __builtin_bit_cast(unsigned, (f16x2){(_Float16)lf[6], (_Float16)lf[7]});
                        *(u32x4*)(LF + roff + bj * HALF) = hw;
                    } else {
                        if (seg != 2) {
#pragma unroll
                            for (int j = 0; j < 8; ++j) v[j] = fsilu(v[j]); }
                        u32x4 w; w.x = cvt_pk_bf16(v[0], v[1]); w.y = cvt_pk_bf16(v[2], v[3]); w.z = cvt_pk_bf16(v[4], v[5]); w.w = cvt_pk_bf16(v[6], v[7]);
                        *(u32x4*)(O + roff + bj * HALF) = w; } } }
    }
};
struct EpiDown {
    static constexpr bool PERM = false, AFTER_DRAIN = false, INIT = true;
    const float* base; float* out; bf16_t* y; size_t ystride; int kl, ldc;
    __device__ __forceinline__ void init(f32x4 (&acc)[2][2][4][2], const Unit& u, int wr, int wc, int fr, int fq) const {
        const int row0 = u.pm * BM + wr * 64 + fr, col0 = u.pc * BM + wc * 32 + 4 * fq;
#pragma unroll
        for (int ai = 0; ai < 2; ++ai)
#pragma unroll
            for (int m = 0; m < 4; ++m) { const size_t off = (size_t)(row0 + ai * HALF + m * 16) * ldc + col0;
#pragma unroll
                for (int bj = 0; bj < 2; ++bj)
#pragma unroll
                    for (int n = 0; n < 2; ++n) acc[ai][bj][m][n] = *(const f32x4*)(base + off + bj * HALF + n * 16); }
    }
    __device__ __forceinline__ void operator()(const f32x4 (&acc)[2][2][4][2], const Unit& u, int wr, int wc, int fr, int fq) const {
        const int row0 = u.pm * BM + wr * 64 + fr, col0 = u.pc * BM + wc * 32 + 4 * fq;
#pragma unroll
        for (int ai = 0; ai < 2; ++ai)
#pragma unroll
            for (int m = 0; m < 4; ++m) { const size_t off = (size_t)(row0 + ai * HALF + m * 16) * ldc + col0;
#pragma unroll
                for (int bj = 0; bj < 2; ++bj)
#pragma unroll
                    for (int n = 0; n < 2; ++n) *(f32x4*)(out + off + bj * HALF + n * 16) = acc[ai][bj][m][n]; }
    }
};
struct EpiDownMoe {
    static constexpr bool PERM = true, AFTER_DRAIN = false;
    bf16_t* y; size_t ystride; int kl, ldc;
    __device__ __forceinline__ void operator()(const f32x4 (&acc)[2][2][4][2], const Unit& u, int wr, int wc, int fr, int fq) const {
        const int row0 = u.po * BM + wr * 64 + fr, col0 = u.pc * BM + wc * 32 + 8 * fq; bf16_t* Y = y + (size_t)(u.ko / kl) * ystride;
#pragma unroll
        for (int ai = 0; ai < 2; ++ai)
#pragma unroll
            for (int m = 0; m < 4; ++m) { bf16_t* rowp = Y + (size_t)(row0 + ai * HALF + m * 16) * ldc + col0;
#pragma unroll
                for (int bj = 0; bj < 2; ++bj) { const f32x4 v0 = acc[ai][bj][m][0], v1 = acc[ai][bj][m][1];
                    u32x4 w; w.x = cvt_pk_bf16(v0[0], v0[1]); w.y = cvt_pk_bf16(v0[2], v0[3]); w.z = cvt_pk_bf16(v1[0], v1[1]); w.w = cvt_pk_bf16(v1[2], v1[3]);
                    *(u32x4*)(rowp + bj * HALF) = w; } }
    }
};
struct MoeOrder {
    StaticOrder so; const int* tile_e; const int* list; int nN, KL, compact, rev;
    __device__ void init(int nrt, int nN_, int KS, int KL_, int G_, int c_, const int* te, const int* li, int compact_, int rev_ = 0) { compact = compact_; rev = rev_; so.nM = nrt; so.nN = nN_ * KS; so.nwg = nrt * nN_ * KS; so.G = G_; so.c = c_; tile_e = te; list = li; nN = nN_; KL = KL_; }
    __device__ bool next(int i, Unit& u) const { if (!so.next(i, u)) return false;
        if (list) u.pm = __builtin_amdgcn_readfirstlane(list[rev ? so.nM - 1 - u.pm : u.pm]);
        if (!compact) u.po = u.pm;
        const int e = __builtin_amdgcn_readfirstlane(tile_e[u.pm]); const int ks = u.pc / nN, pl = u.pc - ks * nN;
        u.pn = e * nN + pl; u.pc = pl; u.ko = ks * KL; return true; }
    __device__ __forceinline__ void a_ready(const Unit&) const {}
    __device__ __forceinline__ void done(const Unit&) const {}
};
template <class Epi, class Sched, bool ALIGN_EPI = false, bool SP2 = false, bool I8 = false>
__device__ __forceinline__ void gemm_phase(PG8_LAS unsigned char* lds, const Gemm g, const Sched& S, const Epi& E) {
    int tid_ = threadIdx.x; asm volatile("" : "+v"(tid_));
    const int tid = tid_, wid = __builtin_amdgcn_readfirstlane(tid >> 6), lane = tid & 63, wr = wid >> 2, wc = wid & 3, fr = lane & 15, fq = lane >> 4;
    const int K = g.K  , nt = g.KL / BK  ;
    const int pitA = g.pA ? g.pA : K, pitB = g.pB ? g.pB : K;
    unsigned voffA[2], voffB[2];
#pragma unroll
    for (int i = 0; i < 2; ++i) { int R, C; stage_rc(tid * 16 + i * 8192, R, C); const int Rb = Epi::PERM ? ((R & ~31) + perm32(R & 31)) : R;
        voffA[i] = (unsigned)(R * pitA + C) * 2u; voffB[i] = (unsigned)(Rb * pitB + C) * 2u; }
    const size_t kstepA = g.ksA ? (size_t)g.ksA : (size_t)(BK * 2), kstepB = g.ksB ? (size_t)g.ksB : (size_t)(BK * 2);
    const size_t hstepA = (size_t)HALF * pitA * 2, hstepB = (size_t)HALF * pitB * 2;
    const size_t tstepA = 2 * hstepA, tstepB = 2 * hstepB;
    const unsigned ldsw = (unsigned)wid * 1024u;
    const int aoff = lds_byte(wr * 64 + fr, fq * 8), boff = lds_byte(wc * 32 + fr, fq * 8);
#define PG8_SA(b, h) (((b) * 2 + (h)) * HTB)
#define PG8_SB(b, h) ((4 + (b) * 2 + (h)) * HTB)
#define PG8_STAGE(bufoff, gbase, voff) do { _Pragma("unroll") for (int _i = 0; _i < 2; ++_i) \
        __builtin_amdgcn_global_load_lds((const unsigned*)((const char*)(gbase) + (voff)[_i]), (PG8_LAS unsigned*)(lds + (bufoff) + ldsw + _i * 8192), 16, 0, 0); } while (0)
#define PG8_LDA(dst, b, h) do { _Pragma("unroll") for (int m = 0; m < 4; ++m) _Pragma("unroll") for (int k = 0; k < 2; ++k) dst[m][k] = *(const PG8_LAS bf16x8*)(lds + PG8_SA(b, h) + aoff + m * 2048 + k * 1024); } while (0)
#define PG8_LDB(dst, b, h) do { _Pragma("unroll") for (int n = 0; n < 2; ++n) _Pragma("unroll") for (int k = 0; k < 2; ++k) dst[n][k] = *(const PG8_LAS bf16x8*)(lds + PG8_SB(b, h) + boff + n * 2048 + k * 1024); } while (0)
#define PG8_MMA(ai, bj, At, Bt) do { __builtin_amdgcn_s_setprio(1); _Pragma("unroll") for (int m = 0; m < 4; ++m) _Pragma("unroll") for (int n = 0; n < 2; ++n) _Pragma("unroll") for (int k = 0; k < 2; ++k) \
        acc[ai][bj][m][n] = mma16(Bt[n][k], At[m][k], acc[ai][bj][m][n]); __builtin_amdgcn_s_setprio(0); } while (0)
#define PG8_WAIT_V(n) asm volatile("s_waitcnt vmcnt(" #n ")" ::: "memory")
#define PG8_WAIT_L(n) asm volatile("s_waitcnt lgkmcnt(" #n ")" ::: "memory")
#define PG8_BAR __builtin_amdgcn_s_barrier()
#define PG8_SCHED __builtin_amdgcn_sched_barrier(0)
    Unit cur, nxt; int ui = 0;
    if (!S.next(0, cur)) return;
    typedef typename AccSel<I8>::type acc_t;
    acc_t acc[2][2][4][2];
#pragma unroll
    for (int a = 0; a < 2; ++a)
#pragma unroll
        for (int b = 0; b < 2; ++b)
#pragma unroll
            for (int m = 0; m < 4; ++m)
#pragma unroll
                for (int n = 0; n < 2; ++n) acc[a][b][m][n] = (acc_t){0, 0, 0, 0};
    if constexpr (AccInit<Epi>::value) E.init(acc, cur, wr, wc, fr, fq);
    bf16x8 At[4][2], B0[2][2], B1[2][2];
    const char* cA = (const char*)g.A + (size_t)cur.pm * tstepA + (size_t)(cur.ko / BK) * kstepA; const char* cB = (const char*)g.Bt + (size_t)cur.pn * tstepB + (size_t)(cur.ko / BK) * kstepB;
    S.a_ready(cur);
    if constexpr (SP2) {
        PG8_STAGE(PG8_SB(0, 0), cB, voffB); PG8_STAGE(PG8_SB(0, 1), cB + hstepB, voffB); PG8_STAGE(PG8_SA(0, 0), cA, voffA); PG8_STAGE(PG8_SA(0, 1), cA + hstepA, voffA);
        if (wr == 1) PG8_BAR;
        PG8_WAIT_V(2); PG8_BAR;
        PG8_STAGE(PG8_SB(1, 0), cB + kstepB, voffB); PG8_STAGE(PG8_SA(1, 0), cA + kstepA, voffA); PG8_STAGE(PG8_SB(1, 1), cB + hstepB + kstepB, voffB);
        PG8_WAIT_V(6); PG8_BAR;
    } else {
        PG8_STAGE(PG8_SB(0, 0), cB, voffB); PG8_STAGE(PG8_SA(0, 0), cA, voffA); PG8_STAGE(PG8_SB(0, 1), cB + hstepB, voffB); PG8_STAGE(PG8_SA(0, 1), cA + hstepA, voffA);
        if (wr == 1) PG8_BAR;
        PG8_WAIT_V(4); PG8_BAR;
        PG8_STAGE(PG8_SB(1, 0), cB + kstepB, voffB); PG8_STAGE(PG8_SA(1, 0), cA + kstepA, voffA); PG8_STAGE(PG8_SB(1, 1), cB + hstepB + kstepB, voffB);
        PG8_WAIT_V(6); PG8_BAR;
    }
    for (;;) {
        const bool has_next = S.next(ui + 1, nxt);
        if constexpr (I8) {
            const float* sp_ = tid < 256 ? g.sA + cur.pm * BM + tid : g.sB + cur.pn * BM + (tid - 256);
            __builtin_amdgcn_global_load_lds((const unsigned*)sp_, (PG8_LAS unsigned*)(lds + STAGE_BYTES + (ui & 1) * 2048 + wid * 256), 4, 0, 0); }
        const char* nA = has_next ? (const char*)g.A + (size_t)nxt.pm * tstepA + (size_t)(nxt.ko / BK) * kstepA : cA; const char* nB = has_next ? (const char*)g.Bt + (size_t)nxt.pn * tstepB + (size_t)(nxt.ko / BK) * kstepB : cB;
        for (int t = 0; t < nt; t += 2) {
            const bool last = (t == nt - 2);
            const char* a1 = cA + (size_t)(t + 1) * kstepA;
            const char* a2 = last ? nA : cA + (size_t)(t + 2) * kstepA; const char* b2 = last ? nB : cB + (size_t)(t + 2) * kstepB;
            const char* a3 = a2 + kstepA; const char* b3 = b2 + kstepB;
            if (last && has_next) S.a_ready(nxt);
            if constexpr (SP2) {
            PG8_LDB(B0, 0, 0); PG8_LDB(B1, 0, 1); PG8_SCHED; PG8_LDA(At, 0, 0); PG8_STAGE(PG8_SA(1, 1), a1 + hstepA, voffA);
            PG8_WAIT_V(8); PG8_WAIT_L(0); PG8_BAR; PG8_MMA(0, 0, At, B0); PG8_MMA(0, 1, At, B1); PG8_BAR; PG8_SCHED;
            PG8_LDA(At, 0, 1); PG8_STAGE(PG8_SB(0, 0), b2, voffB); PG8_STAGE(PG8_SB(0, 1), b2 + hstepB, voffB); PG8_STAGE(PG8_SA(0, 0), a2, voffA);
            PG8_WAIT_V(8); PG8_WAIT_L(0); PG8_BAR; PG8_MMA(1, 0, At, B0); PG8_MMA(1, 1, At, B1); PG8_BAR; PG8_SCHED;
            PG8_LDB(B0, 1, 0); PG8_LDB(B1, 1, 1); PG8_SCHED; PG8_LDA(At, 1, 0); PG8_STAGE(PG8_SA(0, 1), a2 + hstepA, voffA);
            PG8_WAIT_V(8); PG8_WAIT_L(0); PG8_BAR; PG8_MMA(0, 0, At, B0); PG8_MMA(0, 1, At, B1); PG8_BAR; PG8_SCHED;
            PG8_LDA(At, 1, 1); PG8_STAGE(PG8_SB(1, 0), b3, voffB); PG8_STAGE(PG8_SB(1, 1), b3 + hstepB, voffB); PG8_STAGE(PG8_SA(1, 0), a3, voffA);
            PG8_WAIT_V(8); PG8_WAIT_L(0); PG8_BAR; PG8_MMA(1, 0, At, B0); PG8_MMA(1, 1, At, B1); PG8_BAR; PG8_SCHED;
            } else {
            PG8_LDB(B0, 0, 0); PG8_SCHED; PG8_LDA(At, 0, 0); PG8_STAGE(PG8_SA(1, 1), a1 + hstepA, voffA);
            PG8_WAIT_L(8); PG8_BAR; PG8_WAIT_L(0); PG8_MMA(0, 0, At, B0); PG8_BAR; PG8_SCHED;
            PG8_LDB(B1, 0, 1); PG8_STAGE(PG8_SB(0, 0), b2, voffB);
            PG8_BAR; PG8_WAIT_L(0); PG8_MMA(0, 1, At, B1); PG8_BAR;
            PG8_LDA(At, 0, 1); PG8_STAGE(PG8_SA(0, 0), a2, voffA);
            PG8_BAR; PG8_WAIT_L(0); PG8_MMA(1, 0, At, B0); PG8_BAR; PG8_SCHED;
            PG8_STAGE(PG8_SB(0, 1), b2 + hstepB, voffB);
            PG8_WAIT_V(6); PG8_BAR; PG8_MMA(1, 1, At, B1); PG8_BAR;
            PG8_LDB(B0, 1, 0); PG8_SCHED; PG8_LDA(At, 1, 0); PG8_STAGE(PG8_SA(0, 1), a2 + hstepA, voffA);
            PG8_WAIT_L(8); PG8_BAR; PG8_WAIT_L(0); PG8_MMA(0, 0, At, B0); PG8_BAR; PG8_SCHED;
            PG8_LDB(B1, 1, 1); PG8_STAGE(PG8_SB(1, 0), b3, voffB);
            PG8_BAR; PG8_WAIT_L(0); PG8_MMA(0, 1, At, B1); PG8_BAR;
            PG8_LDA(At, 1, 1); PG8_STAGE(PG8_SA(1, 0), a3, voffA);
            PG8_BAR; PG8_WAIT_L(0); PG8_MMA(1, 0, At, B0); PG8_BAR; PG8_SCHED;
            PG8_STAGE(PG8_SB(1, 1), b3 + hstepB, voffB);
            PG8_WAIT_V(6); PG8_BAR; PG8_MMA(1, 1, At, B1); PG8_BAR;
            }
        }
        if constexpr (ALIGN_EPI) { if (wr == 0) PG8_BAR; }
        if constexpr (!Epi::AFTER_DRAIN) { if constexpr (I8) { _Pragma("nounroll") for (int er_ = 0; er_ < REP_EPI8; ++er_) { f32x4 facc[2][2][4][2]; dequant<Epi::PERM>(acc, facc, (const PG8_LAS float*)(lds + STAGE_BYTES + (ui & 1) * 2048), wr, wc, fr, fq); E(facc, cur, wr, wc, fr, fq); } } else { E(acc, cur, wr, wc, fr, fq); } S.done(cur); }
        if (!has_next) break;
#pragma unroll
        for (int a = 0; a < 2; ++a)
#pragma unroll
            for (int b = 0; b < 2; ++b)
#pragma unroll
                for (int m = 0; m < 4; ++m)
#pragma unroll
                    for (int n = 0; n < 2; ++n) acc[a][b][m][n] = (acc_t){0, 0, 0, 0};
        if constexpr (AccInit<Epi>::value) E.init(acc, nxt, wr, wc, fr, fq);
        cur = nxt; cA = nA; cB = nB; ++ui;
        if constexpr (ALIGN_EPI) { if (wr == 1) PG8_BAR; }
    }
    PG8_WAIT_V(0);
    if constexpr (!ALIGN_EPI) { if (wr == 0) PG8_BAR; }
    PG8_BAR;
    if constexpr (Epi::AFTER_DRAIN) { E.fused(acc, cur, wr, wc, fr, fq, lds, wid, lane); S.done(cur); }
#undef PG8_SA
#undef PG8_SB
#undef PG8_STAGE
#undef PG8_LDA
#undef PG8_LDB
#undef PG8_MMA
#undef PG8_WAIT_V
#undef PG8_WAIT_L
#undef PG8_BAR
#undef PG8_SCHED
}
}
#define GAS __attribute__((address_space(1)))
#define LAS __attribute__((address_space(3)))
typedef unsigned short bf16;
typedef unsigned v4u __attribute__((ext_vector_type(4)));
typedef float f32x4 __attribute__((ext_vector_type(4)));
typedef short bf16x8 __attribute__((ext_vector_type(8)));
typedef GAS unsigned gu32;
typedef GAS unsigned long long gu64;
#define RLX_AGENT __ATOMIC_RELAXED, __HIP_MEMORY_SCOPE_AGENT
#define LDS_WAIT() asm volatile("s_waitcnt lgkmcnt(0)" ::: "memory")
#define VM_WAIT() asm volatile("s_waitcnt vmcnt(0)" ::: "memory")
__device__ __forceinline__ unsigned long long rt() { return __builtin_amdgcn_s_memrealtime(); }
__device__ __forceinline__ unsigned f2bf(float f) { unsigned u = __builtin_bit_cast(unsigned, f); return (u + 0x7fffu + ((u >> 16) & 1u)) >> 16; }
__device__ __forceinline__ unsigned pk2(float lo, float hi) { return f2bf(lo) | (f2bf(hi) << 16); }

#define XB_TMO      128
#define XB_XCNT(j)  (256  + 64 * (j))
#define XB_XSUB(j)  (1280 + 64 * (j))
#define XB_XGEN(j)  (2304 + 64 * (j))
#define XB_TOP      3328
#define XB_TOPGEN   3392
#define XCD_BAR_WORDS 3456
#define XB_SPIN_CAP (1u << 22)

__device__ __forceinline__ unsigned xb_ld(unsigned* p)              { return __hip_atomic_load(p, __ATOMIC_RELAXED, __HIP_MEMORY_SCOPE_AGENT); }
__device__ __forceinline__ unsigned xb_add(unsigned* p, unsigned v) { return __hip_atomic_fetch_add(p, v, __ATOMIC_RELAXED, __HIP_MEMORY_SCOPE_AGENT); }
__device__ __forceinline__ unsigned xb_xcc_id() { return (unsigned)__builtin_amdgcn_s_getreg((3 << 11) | 20) & 0xFu; }
#define XB_SPIN(cond, bar) do { unsigned _sp = 0; while (cond) { __builtin_amdgcn_s_sleep(1); \
    if ((++_sp & 255u) == 0u) { if (xb_ld(&(bar)[XB_TMO])) break; if (_sp > XB_SPIN_CAP) { atomicAdd(&(bar)[XB_TMO], 1u); break; } } } } while (0)

struct XcdBarrier {
    unsigned* bar; unsigned x;
    volatile LAS unsigned* st;
};

__device__ __forceinline__ XcdBarrier xcd_barrier_post(unsigned* bar, volatile LAS unsigned* st) {
    XcdBarrier b; b.bar = bar; b.x = xb_xcc_id(); b.st = st;
    if (threadIdx.x == 0) (void)xb_add(&bar[XB_XCNT(b.x)], 1u);
    return b;
}
__device__ __forceinline__ void xcd_barrier_complete(unsigned* bar, unsigned x, unsigned& nloc, unsigned& nx) {
    const unsigned G = gridDim.x * gridDim.y * gridDim.z;
    unsigned sum, cnt, mine, sp = 0u;
    for (;;) {
        sum = 0u; cnt = 0u; mine = 0u;
#pragma unroll
        for (unsigned j = 0; j < 16; ++j) { const unsigned c = xb_ld(&bar[XB_XCNT(j)]); sum += c; cnt += (c > 0u) ? 1u : 0u; mine = (j == x) ? c : mine; }
        if (sum == G) break;
        __builtin_amdgcn_s_sleep(1);
        if ((++sp & 255u) == 0u) { if (xb_ld(&bar[XB_TMO])) break; if (sp > XB_SPIN_CAP) { atomicAdd(&bar[XB_TMO], 1u); break; } }
    }
    nloc = mine > 0u ? mine : 1u; nx = cnt > 0u ? cnt : 1u;
}

__device__ __forceinline__ void xcd_barrier(const XcdBarrier& b) {
    asm volatile("s_waitcnt vmcnt(0)" ::: "memory");
    __syncthreads();
    if (threadIdx.x == 0) {
        unsigned* bar = b.bar;
        __builtin_amdgcn_s_waitcnt(0);
        unsigned nloc = b.st[0], nx = b.st[1];
        if (nloc == 0u) { xcd_barrier_complete(bar, b.x, nloc, nx); b.st[0] = nloc; b.st[1] = nx; }
        const unsigned old = xb_add(&bar[XB_XSUB(b.x)], 1u);
        const unsigned gen = old / nloc;
        if (old + 1u == (gen + 1u) * nloc) {
            __builtin_amdgcn_fence(__ATOMIC_RELEASE, "agent");
            asm volatile("s_waitcnt vmcnt(0)" ::: "memory");
            const unsigned og = xb_add(&bar[XB_TOP], 1u);
            const unsigned tg = og / nx;
            if (og + 1u == (tg + 1u) * nx) xb_add(&bar[XB_TOPGEN], 1u);
            else XB_SPIN(xb_ld(&bar[XB_TOPGEN]) == tg, bar);
            __builtin_amdgcn_fence(__ATOMIC_ACQUIRE, "agent");
            xb_add(&bar[XB_XGEN(b.x)], 1u);
            asm volatile("s_waitcnt vmcnt(0)" ::: "memory");
        } else {
            XB_SPIN(xb_ld(&bar[XB_XGEN(b.x)]) == gen, bar);
            __builtin_amdgcn_fence(__ATOMIC_ACQUIRE, "agent");
            asm volatile("s_waitcnt vmcnt(0)" ::: "memory");
        }
    }
    __syncthreads();
}

constexpr int NWAVES = 8;
constexpr int GRID = 256;
constexpr int BATCH = 2, T = 8192, D = 1024, M = BATCH * T;
constexpr int HG_H = 8;
constexpr int SB_H = 16, SB_D = 64;
constexpr int FFD = 2816, FFE = 3584, NE = 8;
constexpr int MROWS = 2 * M + NE * 256, MRT = MROWS / 256;
constexpr float EPS = 1e-6f;
constexpr float QSCALE = 0.125f * 1.44269504089f;

constexpr size_t MiB = 1u << 20;
constexpr size_t WS_CTL = 0, CTL_ZERO_BYTES = 1 * MiB;
constexpr size_t WS_TAB = 1 * MiB;
constexpr size_t TAB_LB = WS_TAB, TAB_HIST = WS_TAB + 16384, TAB_TILE = WS_TAB + 32768, TAB_TOKE = WS_TAB + 65536, TAB_TOKG = WS_TAB + 262144, TAB_TOKP = WS_TAB + 524288;
constexpr size_t WS_WIN = 8 * MiB, WS_WOUT = 24 * MiB, WS_WQ = 28 * MiB, WS_WK = 32 * MiB, WS_WV = 34 * MiB, WS_WO = 36 * MiB, WS_WGU = 40 * MiB, WS_WDN = 62 * MiB;
constexpr size_t WS_WMGU = 80 * MiB, WS_WMDN = 192 * MiB, WS_WMDN2 = 80 * MiB;
constexpr size_t WS_WMGU_UNUSED_ = 0;
constexpr size_t WS_XN = 248 * MiB;
constexpr size_t WS_K = 280 * MiB, WS_VT = 312 * MiB;
constexpr size_t WS_S = 344 * MiB;
constexpr size_t WS_QS = WS_S, WS_KK = WS_S + 32 * MiB, WS_VV = WS_S + 64 * MiB, WS_GG = WS_S + 96 * MiB, WS_LF = WS_S + 128 * MiB, WS_OR = WS_S + 192 * MiB, WS_OG = WS_S + 256 * MiB;
constexpr size_t WS_HB = WS_S;
constexpr size_t WS_XP = WS_S, WS_HM = WS_S + 68 * MiB, WS_Y = WS_S + 306 * MiB;
constexpr int MOE_RKS = 2, MOE_RKL = FFE / MOE_RKS;
constexpr size_t WS_Y0 = WS_XP;
constexpr size_t WS_YR = WS_Y, YR_STRIDE = (size_t)NE * 256 * D;
constexpr size_t WS_Q = WS_S, WS_AO = WS_S + 32 * MiB;
constexpr size_t WS_END0 = WS_S + 442 * MiB;
constexpr size_t WS_XQ = WS_XN, WS_SA = WS_XN + 16 * MiB, WS_SAP = WS_XN + 17 * MiB, WS_SB = WS_XN + 18 * MiB, WS_SBM = WS_XN + 19 * MiB;
constexpr size_t WS_XPQ = WS_XP;
constexpr size_t WS_WM8 = WS_END0, WS_W8 = WS_END0 + 56 * MiB;
constexpr int W8_ROWS = (int)((WS_WDN - WS_WIN) / 2048), WM8_ROWS = NE * 2 * FFE;
constexpr size_t WS_END = WS_W8 + 27 * MiB;
static_assert(WS_HM + (size_t)MROWS * FFE * 2 <= WS_Y && WS_YR + (size_t)MOE_RKS * YR_STRIDE * 2 <= WS_END0 && (size_t)W8_ROWS * D <= 27 * MiB && WS_END <= 896 * MiB && WS_XP + (size_t)MROWS * D * 2 <= WS_HM, "MoE scratch map");
static_assert(WS_WDN + (size_t)2 * D * FFD * 2 <= WS_WMGU && WS_WMGU + (size_t)NE * 2 * FFE * D * 2 <= WS_WMDN && WS_WMDN + (size_t)NE * D * FFE * 2 <= WS_XN, "weight map");
constexpr int CW_BAR = 4096;
constexpr int CW_ZTAB = 16384;

constexpr int RING_OFF = 0, RING_BYTES = 131072;
constexpr int LDSCTL_OFF = 135168, MISC_OFF = LDSCTL_OFF + 320;
constexpr int LDS_BYTES = 147456;

struct Args { const float* in[18]; float* out; unsigned char* ws; int ph_lo, ph_hi; };
typedef const __attribute__((address_space(4))) Args* CArgsP;
__device__ __forceinline__ CArgsP kargs() { CArgsP p = (CArgsP)__builtin_amdgcn_kernarg_segment_ptr(); asm volatile("" : "+s"(p)); return p; }
__device__ __forceinline__ int lg(int v) { asm volatile("" : "+s"(v)); return v; }
__device__ __forceinline__ unsigned char* wsbase() { return kargs()->ws; }
typedef float f32x2 __attribute__((ext_vector_type(2)));
struct Frame;
#define PHASE_LOCALS const int blk = lg((int)blockIdx.x); Frame F = F_; { int t_ = F_.tid; asm volatile("" : "+v"(t_)); F.tid = t_; F.lane = t_ & 63; F.wave = lg(F_.wave); F.vcu = lg(F_.vcu); F.G = lg(F_.G); } (void)blk;
struct Frame {
    LAS unsigned char* lds;
    volatile LAS unsigned* MISC;
    int tid, lane, wave;
    int vcu, G;
};

__device__ __forceinline__ float wave_sum(float v) {
#pragma unroll
    for (int o = 1; o < 64; o <<= 1) v += __shfl_xor(v, o);
    return v;
}
__device__ __forceinline__ float bf_lo(unsigned u) { return __uint_as_float(u << 16); }
__device__ __forceinline__ float bf_hi(unsigned u) { return __uint_as_float(u & 0xffff0000u); }
__device__ __forceinline__ float bf2f(bf16 b) { return __uint_as_float((unsigned)b << 16); }
typedef __bf16 bf16x2_t __attribute__((ext_vector_type(2)));
__device__ __forceinline__ unsigned cvtpk(float lo, float hi) { f32x2 v = {lo, hi}; bf16x2_t b = __builtin_convertvector(v, bf16x2_t); return __builtin_bit_cast(unsigned, b); }

struct CItem { const float* W; const float* gain; bf16* WT; int pitch, ldk, k0, drow0, ktm; float scale; };
__device__ __forceinline__ CItem cmat(int r, const float* W, int pitch, int c0, int nc, const float* gain, float scale, bf16* WT, int ldk, int il, int ktm = 0) {
    const int nb = nc / 64, kb = r / nb, n0 = (r % nb) * 64;
    CItem c; c.W = W + c0 + n0; c.gain = gain; c.WT = WT; c.pitch = pitch; c.ldk = ldk; c.k0 = kb * 64; c.scale = scale; c.ktm = ktm;
    c.drow0 = il == 0 ? n0 : (n0 >> 7) * 256 + (il - 1) * 128 + (n0 & 127);
    return c;
}
constexpr int CONV_DENSE_ITEMS = 2 * (256 + 256 + 704), CONV_MOE_PER = 896, CONV_MOE_ITEMS = 8 * CONV_MOE_PER;
__device__ __forceinline__ CItem conv_decode(int it, bool dense, int ml, unsigned char* ws_) {
#define in (kargs()->in)
    int r = it;
    if (dense) {
        if (r < CONV_DENSE_ITEMS) {
#pragma unroll
            for (int l = 0; l < 2; ++l) {
                if (r < 256) return cmat(r, in[6] + (size_t)l * D * D, D, 0, D, nullptr, 1.0f, (bf16*)(ws_ + WS_WOUT) + (size_t)l * D * D, D, 0); r -= 256;
                if (r < 256) return cmat(r, in[10] + (size_t)l * D * D, D, 0, D, nullptr, 1.0f, (bf16*)(ws_ + WS_WO) + (size_t)l * D * D, D, 0); r -= 256;
                if (l == 0) { if (r < 704) return cmat(r, in[12], D, 0, D, nullptr, 1.0f, (bf16*)(ws_ + WS_WDN), FFD, 0, D); r -= 704; }
            }
            return cmat(r, in[12] + (size_t)FFD * D, D, 0, D, nullptr, 1.0f, (bf16*)(ws_ + WS_WDN) + (size_t)D * FFD, FFD, 0, D);
        }
        r -= CONV_DENSE_ITEMS;
    }
    const int e = r / CONV_MOE_PER, loc = r % CONV_MOE_PER; const size_t eo = (size_t)(ml * NE + e) * D * FFE;
    { CItem c = cmat(loc, in[16] + eo, D, 0, D, nullptr, 1.0f, (bf16*)(ws_ + (ml == 0 ? WS_WMDN : WS_WMDN2)), FFE, 0, NE * D); c.drow0 += e * D; return c; }
#undef in
}
__device__ __forceinline__ void conv_load(const CItem& c, int lane, f32x4 (&v)[16]) {
    const float* p = c.W + (size_t)(c.k0 + (lane >> 4)) * c.pitch + 4 * (lane & 15);
#pragma unroll
    for (int i = 0; i < 16; ++i) v[i] = __builtin_nontemporal_load((const GAS f32x4*)(p + (size_t)(4 * i) * c.pitch));
}
__device__ __forceinline__ void conv_store(const CItem& c, int lane, const f32x4 (&v)[16], LAS float* scr) {
    const int kr = lane >> 4, nc4 = 4 * (lane & 15);
#pragma unroll
    for (int i = 0; i < 16; ++i) { const float g = c.gain ? c.gain[c.k0 + 4 * i + kr] * c.scale : c.scale; LAS float* p = scr + (4 * i + kr) * 65 + nc4;
        p[0] = v[i].x * g; p[1] = v[i].y * g; p[2] = v[i].z * g; p[3] = v[i].w * g; }
    LDS_WAIT(); asm volatile("" ::: "memory");
    const int ch = lane & 7;
#pragma unroll
    for (int j = 0; j < 8; ++j) { const int n = (lane >> 3) + 8 * j; const LAS float* s = scr + (8 * ch) * 65 + n;
        v4u o; o.x = pk2(s[0 * 65], s[1 * 65]); o.y = pk2(s[2 * 65], s[3 * 65]); o.z = pk2(s[4 * 65], s[5 * 65]); o.w = pk2(s[6 * 65], s[7 * 65]);
        bf16* dp = c.ktm ? c.WT + ((size_t)(c.k0 >> 6) * c.ktm + (c.drow0 + n)) * 64 + 8 * ch : c.WT + (size_t)(c.drow0 + n) * c.ldk + c.k0 + 8 * ch;
        *(GAS v4u*)dp = o; }
    LDS_WAIT(); asm volatile("" ::: "memory");
}
__device__ __forceinline__ void conv_all(Frame& F_, bool dense, int ml) {
    PHASE_LOCALS
    unsigned char* const ws_ = kargs()->ws;
    LAS float* scr = (LAS float*)(F.lds + RING_OFF + F.wave * 16640);
    const int gw = F.vcu * NWAVES + F.wave, NGW = F.G * NWAVES, n = (dense ? CONV_DENSE_ITEMS : 0) + CONV_MOE_ITEMS;
    int it = gw;
    if (it >= n) return;
    CItem cur = conv_decode(it, dense, ml, ws_); f32x4 v[16]; conv_load(cur, F.lane, v);
    for (;;) {
        const int itn = it + NGW; const bool more = itn < n;
        CItem nxt = cur; f32x4 vn[16];
        if (more) { nxt = conv_decode(itn, dense, ml, ws_); conv_load(nxt, F.lane, vn); }
        conv_store(cur, F.lane, v, scr);
        if (!more) break;
        cur = nxt; it = itn;
#pragma unroll
        for (int i = 0; i < 16; ++i) v[i] = vn[i];
    }
}

__device__ __forceinline__ void conv_one_moe_down(int item, int ml, unsigned char* ws_, LAS unsigned char* ldsb, int wave, int lane) {
    const CItem c = conv_decode(item, false, ml, ws_); f32x4 v[16]; conv_load(c, lane, v);
    conv_store(c, lane, v, (LAS float*)(ldsb + wave * 16640));
}
__device__ __forceinline__ void store_xn(bf16* XN, int m, int lane, const f32x4 (&v)[4], float rstd) {
    GAS unsigned long long* o8 = (GAS unsigned long long*)(XN + (size_t)m * D) + lane;
#pragma unroll
    for (int j = 0; j < 4; ++j) o8[64 * j] = (unsigned long long)pk2(v[j].x * rstd, v[j].y * rstd) | ((unsigned long long)pk2(v[j].z * rstd, v[j].w * rstd) << 32);
}
__device__ __forceinline__ void store_xq(unsigned char* ws_, int m, int lane, const f32x4 (&v)[4], float rstd) {
    float am = 0.f;
#pragma unroll
    for (int j = 0; j < 4; ++j) am = fmaxf(fmaxf(am, fmaxf(fabsf(v[j].x), fabsf(v[j].y))), fmaxf(fabsf(v[j].z), fabsf(v[j].w)));
#pragma unroll
    for (int o = 1; o < 64; o <<= 1) am = fmaxf(am, __shfl_xor(am, o));
    am *= rstd;
    const float inv = am > 0.f ? 127.0f / am : 0.f, k = rstd * inv;
    GAS unsigned* o4 = (GAS unsigned*)(ws_ + WS_XQ + (size_t)m * D) + lane;
#pragma unroll
    for (int j = 0; j < 4; ++j) { const int a = (int)rintf(v[j].x * k), b = (int)rintf(v[j].y * k), c = (int)rintf(v[j].z * k), d = (int)rintf(v[j].w * k);
        o4[64 * j] = (unsigned)(a & 255) | ((unsigned)(b & 255) << 8) | ((unsigned)(c & 255) << 16) | ((unsigned)(d & 255) << 24); }
    if (lane == 0) ((GAS float*)(ws_ + WS_SA))[m] = am * (1.0f / 127.0f);
}
struct C8Item { const float* W; const float* gain; unsigned char* D8; float* SBp; int pitch; float scale; };
__device__ __forceinline__ C8Item c8mat(int r, const float* W, int pitch, int c0, const float* gain, float scale, unsigned char* W8base, float* SBbase, int row0, int il) {
    const int n0 = r * 64, drow = row0 + (il == 0 ? n0 : (n0 >> 7) * 256 + (il - 1) * 128 + (n0 & 127));
    C8Item c; c.W = W + c0 + n0; c.gain = gain; c.pitch = pitch; c.scale = scale; c.D8 = W8base + (size_t)drow * D; c.SBp = SBbase + drow; return c;
}
constexpr int C8_DENSE_ITEMS = 2 * (64 + 16 + 44 + 44) + 16 + 16, C8_MOE_ITEMS = 16 * 56;
constexpr int R_WIN = 0, R_WQ = (int)((WS_WQ - WS_WIN) / 2048), R_WK = (int)((WS_WK - WS_WIN) / 2048), R_WV = (int)((WS_WV - WS_WIN) / 2048), R_WGU = (int)((WS_WGU - WS_WIN) / 2048);
__device__ __forceinline__ C8Item conv8_decode(int it, bool dense, int ml, unsigned char* ws_) {
#define in (kargs()->in)
    int r = it; unsigned char* W8 = ws_ + WS_W8; float* SBd = (float*)(ws_ + WS_SB);
    if (dense) {
        if (r < C8_DENSE_ITEMS) {
#pragma unroll
            for (int l = 0; l < 2; ++l) {
                if (r < 64) return c8mat(r, in[3] + (size_t)l * D * 4 * D, 4 * D, 0, in[1] + l * D, 1.0f, W8, SBd, R_WIN + l * 4 * D, 0); r -= 64;
                if (r < 16) return c8mat(r, in[9] + (size_t)l * D * D, D, 0, in[1] + (2 + l) * D, QSCALE, W8, SBd, R_WQ + l * D, 0); r -= 16;
                if (r < 44) return c8mat(r, in[11] + (size_t)l * D * 2 * FFD, 2 * FFD, 0, in[2] + (2 * l) * D, 1.0f, W8, SBd, R_WGU + l * 2 * FFD, 1); r -= 44;
                if (r < 44) return c8mat(r, in[11] + (size_t)l * D * 2 * FFD, 2 * FFD, FFD, in[2] + (2 * l) * D, 1.0f, W8, SBd, R_WGU + l * 2 * FFD, 2); r -= 44;
            }
            if (r < 16) return c8mat(r, in[8], 2 * D, 0, in[7], 1.0f, W8, SBd, R_WK, 0); r -= 16;
            return c8mat(r, in[8], 2 * D, D, in[7], 1.0f, W8, SBd, R_WV, 0);
        }
        r -= C8_DENSE_ITEMS;
    }
    const int q = r / 56, loc = r % 56, ty = q >> 3, e = q & 7;
    return c8mat(loc, in[14 + ty] + (size_t)(ml * NE + e) * D * FFE, FFE, 0, in[2] + (2 * ml + 1) * D, 1.0f, ws_ + WS_WM8, (float*)(ws_ + WS_SBM), e * 2 * FFE, 1 + ty);
#undef in
}
__device__ __forceinline__ void conv8_all(Frame& F_, bool dense, int ml) {
    PHASE_LOCALS
    unsigned char* const ws_ = kargs()->ws;
    LAS bf16* TT = (LAS bf16*)(F.lds + RING_OFF);
    LAS float* CM = (LAS float*)(F.lds + RING_OFF + 132096);
    LAS float* CMX = CM + 512;
    const int n8 = (dense ? C8_DENSE_ITEMS : 0) + C8_MOE_ITEMS, lane = F.lane, kr = lane >> 4, nc4 = 4 * (lane & 15), kb = 128 * F.wave;
    for (int it = F.vcu; it < n8; it += F.G) {
        const C8Item c = conv8_decode(it, dense, ml, ws_);
        float cm0 = 0.f, cm1 = 0.f, cm2 = 0.f, cm3 = 0.f;
#pragma nounroll
        for (int hf = 0; hf < 2; ++hf) {
            f32x4 v[16];
            { const float* p0 = c.W + (size_t)(kb + 64 * hf + kr) * c.pitch + nc4; const size_t st = (size_t)4 * c.pitch;
#pragma unroll
            for (int i = 0; i < 16; ++i) v[i] = __builtin_nontemporal_load((const GAS f32x4*)(p0 + i * st)); }
#pragma unroll
            for (int i = 0; i < 16; ++i) { const int k = kb + 64 * hf + 4 * i + kr; const float g = c.gain ? c.gain[k] * c.scale : c.scale;
                const unsigned b0 = f2bf(v[i].x * g), b1 = f2bf(v[i].y * g), b2 = f2bf(v[i].z * g), b3 = f2bf(v[i].w * g);
                cm0 = fmaxf(cm0, fabsf(__uint_as_float(b0 << 16))); cm1 = fmaxf(cm1, fabsf(__uint_as_float(b1 << 16))); cm2 = fmaxf(cm2, fabsf(__uint_as_float(b2 << 16))); cm3 = fmaxf(cm3, fabsf(__uint_as_float(b3 << 16)));
                TT[(nc4 + 0) * 1032 + k] = (bf16)b0; TT[(nc4 + 1) * 1032 + k] = (bf16)b1; TT[(nc4 + 2) * 1032 + k] = (bf16)b2; TT[(nc4 + 3) * 1032 + k] = (bf16)b3; }
        }
        cm0 = fmaxf(cm0, __shfl_xor(cm0, 16)); cm0 = fmaxf(cm0, __shfl_xor(cm0, 32)); cm1 = fmaxf(cm1, __shfl_xor(cm1, 16)); cm1 = fmaxf(cm1, __shfl_xor(cm1, 32));
        cm2 = fmaxf(cm2, __shfl_xor(cm2, 16)); cm2 = fmaxf(cm2, __shfl_xor(cm2, 32)); cm3 = fmaxf(cm3, __shfl_xor(cm3, 16)); cm3 = fmaxf(cm3, __shfl_xor(cm3, 32));
        if (lane < 16) { LAS float* p = CM + F.wave * 64 + nc4; p[0] = cm0; p[1] = cm1; p[2] = cm2; p[3] = cm3; }
        __syncthreads();
        if (F.tid < 64) { float m = 0.f;
#pragma unroll
            for (int w = 0; w < 8; ++w) m = fmaxf(m, CM[w * 64 + F.tid]);
            CMX[F.tid] = m; c.SBp[F.tid] = m * (1.0f / 127.0f); }
        __syncthreads();
#pragma unroll 2
        for (int j = 0; j < 8; ++j) { const int idx = j * 512 + F.tid, n = idx >> 6, ch = idx & 63; const float m = CMX[n], inv = m > 0.f ? 127.0f / m : 0.f;
            const v4u a = *(const LAS v4u*)(TT + n * 1032 + 16 * ch), b = *(const LAS v4u*)(TT + n * 1032 + 16 * ch + 8);
            const unsigned wv[8] = {a.x, a.y, a.z, a.w, b.x, b.y, b.z, b.w}; unsigned q[4];
#pragma unroll
            for (int t = 0; t < 4; ++t) { const int q0 = (int)rintf(bf_lo(wv[2 * t]) * inv), q1 = (int)rintf(bf_hi(wv[2 * t]) * inv), q2 = (int)rintf(bf_lo(wv[2 * t + 1]) * inv), q3 = (int)rintf(bf_hi(wv[2 * t + 1]) * inv);
                q[t] = (unsigned)(q0 & 255) | ((unsigned)(q1 & 255) << 8) | ((unsigned)(q2 & 255) << 16) | ((unsigned)(q3 & 255) << 24); }
            *(GAS v4u*)(c.D8 + (size_t)n * D + 16 * ch) = (v4u){q[0], q[1], q[2], q[3]}; }
        __syncthreads();
    }
}
__device__ __forceinline__ float row_rstd(const f32x4 (&v)[4]) {
    float s = 0.f;
#pragma unroll
    for (int j = 0; j < 4; ++j) s += (v[j].x * v[j].x + v[j].y * v[j].y) + (v[j].z * v[j].z + v[j].w * v[j].w);
    return 1.0f / sqrtf(wave_sum(s) * (1.0f / D) + EPS);
}
__device__ __forceinline__ void norm_phase(Frame& F_, const float* X, bool route, const float* router  , const float* rgain  ) {
    PHASE_LOCALS
    unsigned char* const ws_ = kargs()->ws;
    LAS float* RGT = (LAS float*)(F.lds + RING_OFF);
    LAS int* hist = (LAS int*)(F.lds + RING_OFF + 32768);
    if (route) {
        for (int i = F.tid; i < D * NE; i += NWAVES * 64) { const int k = i >> 3, e = i & 7; RGT[e * D + k] = router[i] * rgain[k]; }
        if (F.tid < NE) hist[F.tid] = 0;
        __syncthreads();
    }
#pragma nounroll
    for (int i4 = 0; i4 < 8; i4 += 4) {
        f32x4 vv[4][4];
#pragma unroll
        for (int t = 0; t < 4; ++t) { const GAS f32x4* xr = (const GAS f32x4*)(X + (size_t)(blk * 64 + F.wave * 8 + i4 + t) * D) + F.lane;
#pragma unroll
            for (int j = 0; j < 4; ++j) vv[t][j] = xr[64 * j]; }
        __builtin_amdgcn_sched_barrier(0);
#pragma unroll
        for (int t = 0; t < 4; ++t) {
        const int m = blk * 64 + F.wave * 8 + i4 + t;
        f32x4 (&v)[4] = vv[t];
        const float rstd = row_rstd(v);
        store_xq(ws_, m, F.lane, v, rstd);
        if (route) {
            float lg[NE];
#pragma unroll
            for (int e = 0; e < NE; ++e) { float s = 0.f;
#pragma unroll
                for (int j = 0; j < 4; ++j) { const f32x4 r = *(const LAS f32x4*)(RGT + e * D + 4 * F.lane + 256 * j); s += (v[j].x * r.x + v[j].y * r.y) + (v[j].z * r.z + v[j].w * r.w); }
                lg[e] = wave_sum(s) * rstd; }
            float b0 = -3.0e38f, b1 = -3.0e38f; int i0 = 0, i1 = 0;
#pragma unroll
            for (int e = 0; e < NE; ++e) { if (lg[e] > b0) { b1 = b0; i1 = i0; b0 = lg[e]; i0 = e; } else if (lg[e] > b1) { b1 = lg[e]; i1 = e; } }
            if (F.lane == 0) { const float ex = __expf(b1 - b0), g0 = 1.0f / (1.0f + ex);
                ((GAS int*)(ws_ + TAB_TOKE))[2 * m] = i0; ((GAS int*)(ws_ + TAB_TOKE))[2 * m + 1] = i1;
                ((GAS float*)(ws_ + TAB_TOKG))[2 * m] = g0; ((GAS float*)(ws_ + TAB_TOKG))[2 * m + 1] = ex * g0;
                atomicAdd((int*)(hist + i0), 1); atomicAdd((int*)(hist + i1), 1); }
        }
        }
    }
    if (route) { __syncthreads(); if (F.tid < NE) ((GAS int*)(ws_ + TAB_HIST))[blk * NE + F.tid] = hist[F.tid]; }
}
__device__ __forceinline__ void scatter_phase(Frame& F_) {
    PHASE_LOCALS
    unsigned char* const ws_ = kargs()->ws;
    LAS int* h = (LAS int*)(F.lds + RING_OFF);
    LAS int* pre = h + 2048; LAS int* tot = pre + 8; LAS int* pst = tot + 8; LAS int* pos = pst + 16;
    const GAS int* HIST = (const GAS int*)(ws_ + TAB_HIST);
    for (int i = F.tid; i < GRID * NE; i += NWAVES * 64) h[i] = HIST[i];
    __syncthreads();
    if (F.tid < NE) { int p = 0, t = 0; for (int b = 0; b < GRID; ++b) { const int v = h[b * NE + F.tid]; p += (b < blk) ? v : 0; t += v; } pre[F.tid] = p; tot[F.tid] = t; }
    __syncthreads();
    if (F.tid == 0) { int s = 0; for (int e = 0; e < NE; ++e) { pst[e] = s; s += (tot[e] + 255) & ~255; } pst[NE] = s; }
    __syncthreads();
    if (F.wave == 0) {
        const int m = blk * 64 + F.lane;
        const int e0 = ((const GAS int*)(ws_ + TAB_TOKE))[2 * m], e1 = ((const GAS int*)(ws_ + TAB_TOKE))[2 * m + 1];
        int p0 = 0, p1 = 0; const unsigned long long lt = (1ull << F.lane) - 1ull;
#pragma unroll
        for (int e = 0; e < NE; ++e) { const unsigned long long mk = __ballot(e0 == e || e1 == e); const int rk = __popcll(mk & lt) + pst[e] + pre[e];
            if (e0 == e) p0 = rk; if (e1 == e) p1 = rk; }
        ((GAS int*)(ws_ + TAB_TOKP))[2 * m] = p0; ((GAS int*)(ws_ + TAB_TOKP))[2 * m + 1] = p1;
        pos[2 * F.lane] = p0; pos[2 * F.lane + 1] = p1;
    }
    if (blk == 0) { GAS int* TE = (GAS int*)(ws_ + TAB_TILE);
        LAS unsigned long long* wm = (LAS unsigned long long*)(pos + 128);
        const int nrt = pst[NE] >> 8, rt = F.tid;
        int e = NE - 1; bool full = false;
        if (rt < nrt) {
#pragma unroll
            for (int q = NE - 1; q >= 0; --q) if (rt * 256 < pst[q + 1]) e = q;
            TE[rt] = e; full = (rt + 1) * 256 <= pst[e] + tot[e]; }
        const unsigned long long bm = __ballot(full);
        if (F.lane == 0 && F.wave < 3) wm[F.wave] = bm;
        __syncthreads();
        if (rt < nrt) { int nfb = __popcll(bm & ((1ull << F.lane) - 1ull)); if (F.wave > 0) nfb += __popcll(wm[0]); if (F.wave > 1) nfb += __popcll(wm[1]);
            if (full) { TE[176 + nfb] = rt; TE[384 + rt] = -1; } else { TE[352 + rt - nfb] = rt; TE[384 + rt] = rt - nfb; }
            if (rt == nrt - 1) { const int nf = nfb + (full ? 1 : 0); TE[160] = nrt; TE[336] = nf; TE[368] = nrt - nf; } }
    }
    __syncthreads();
    const unsigned char* XQ = ws_ + WS_XQ; unsigned char* XPQ = ws_ + WS_XPQ;
    for (int i = 0; i < 8; ++i) { const int tl = F.wave * 8 + i, m = blk * 64 + tl, d0 = pos[2 * tl], d1 = pos[2 * tl + 1];
        const v4u a = *((const GAS v4u*)(XQ + (size_t)m * D) + F.lane);
        *((GAS v4u*)(XPQ + (size_t)d0 * D) + F.lane) = a; *((GAS v4u*)(XPQ + (size_t)d1 * D) + F.lane) = a;
        if (F.lane == 0) { const float sc = ((const GAS float*)(ws_ + WS_SA))[m]; ((GAS float*)(ws_ + WS_SAP))[d0] = sc; ((GAS float*)(ws_ + WS_SAP))[d1] = sc; } }
}
__device__ __forceinline__ void add_y(f32x4 (&a)[4], const unsigned char* ws_, int p, int j, int lane) {
    if (j < 0) { const GAS unsigned long long* y = (const GAS unsigned long long*)((const bf16*)(ws_ + WS_Y0) + (size_t)p * D) + lane;
#pragma unroll
        for (int c = 0; c < 4; ++c) { const unsigned long long w = y[64 * c]; a[c] = (f32x4){bf_lo((unsigned)w), bf_hi((unsigned)w), bf_lo((unsigned)(w >> 32)), bf_hi((unsigned)(w >> 32))}; } }
    else {
#pragma unroll
        for (int c = 0; c < 4; ++c) a[c] = (f32x4){0.f, 0.f, 0.f, 0.f};
#pragma unroll
        for (int k = 0; k < MOE_RKS; ++k) { const GAS unsigned long long* y = (const GAS unsigned long long*)((const bf16*)(ws_ + WS_YR) + (size_t)k * YR_STRIDE + (size_t)(j * 256 + (p & 255)) * D) + lane;
#pragma unroll
            for (int c = 0; c < 4; ++c) { const unsigned long long w = y[64 * c]; a[c] += (f32x4){bf_lo((unsigned)w), bf_hi((unsigned)w), bf_lo((unsigned)(w >> 32)), bf_hi((unsigned)(w >> 32))}; } } }
}
__device__ __forceinline__ void combine_phase(Frame& F_, float* X, bool last, const float* fgain) {
    PHASE_LOCALS
    unsigned char* const ws_ = kargs()->ws;
    int pp0 = 0, pp1 = 0, jj0 = -1, jj1 = -1; float gg0 = 0.f, gg1 = 0.f;
    if (F.lane < 8) { const int ml = blk * 64 + F.wave * 8 + F.lane;
        pp0 = ((const GAS int*)(ws_ + TAB_TOKP))[2 * ml]; pp1 = ((const GAS int*)(ws_ + TAB_TOKP))[2 * ml + 1];
        gg0 = ((const GAS float*)(ws_ + TAB_TOKG))[2 * ml]; gg1 = ((const GAS float*)(ws_ + TAB_TOKG))[2 * ml + 1];
        jj0 = ((const GAS int*)(ws_ + TAB_TILE))[384 + (pp0 >> 8)]; jj1 = ((const GAS int*)(ws_ + TAB_TILE))[384 + (pp1 >> 8)]; }
    for (int i = 0; i < 8; ++i) {
        const int m = blk * 64 + F.wave * 8 + i;
        const int p0 = __shfl(pp0, i), p1 = __shfl(pp1, i), j0 = __shfl(jj0, i), j1 = __shfl(jj1, i);
        const float g0 = __shfl(gg0, i), g1 = __shfl(gg1, i);
        GAS f32x4* xr = (GAS f32x4*)(X + (size_t)m * D) + F.lane;
        f32x4 v[4], a0[4], a1[4];
#pragma unroll
        for (int j = 0; j < 4; ++j) v[j] = xr[64 * j];
        add_y(a0, ws_, __builtin_amdgcn_readfirstlane(p0), __builtin_amdgcn_readfirstlane(j0), F.lane); add_y(a1, ws_, __builtin_amdgcn_readfirstlane(p1), __builtin_amdgcn_readfirstlane(j1), F.lane);
#pragma unroll
        for (int j = 0; j < 4; ++j) v[j] = v[j] + g0 * a0[j] + g1 * a1[j];
        const float rstd = row_rstd(v);
        if (last) {
#pragma unroll
            for (int j = 0; j < 4; ++j) { const f32x4 g = *((const GAS f32x4*)fgain + F.lane + 64 * j); xr[64 * j] = v[j] * rstd * g; }
        } else {
#pragma unroll
            for (int j = 0; j < 4; ++j) xr[64 * j] = v[j];
            store_xq(ws_, m, F.lane, v, rstd);
        }
    }
}

#define MFMA16(a, b, c) __builtin_amdgcn_mfma_f32_16x16x32_bf16((a), (b), (c), 0, 0, 0)
constexpr int HL_QH = 0, HL_KH = 17408, HL_KHT = 34816, HL_VT = 53248, HL_AS = 71680, HL_SPT = 80896, HL_QT = 115712, HL_EGM = 117760, HL_EGL = 118272, HL_PART = 118784;
constexpr size_t WS_LS = WS_OR, WS_SI = WS_OR + 16 * MiB, WS_GS = WS_OR + 32 * MiB;
template <int MODE> __device__ __forceinline__ void hgrn_chunks(Frame& F_, const float* gnorm) {
    PHASE_LOCALS
    unsigned char* const ws_ = kargs()->ws;
    const bf16* QS = (const bf16*)(ws_ + WS_QS); const bf16* VV = (const bf16*)(ws_ + WS_VV); const bf16* GG = (const bf16*)(ws_ + WS_GG);
    const _Float16* LF = (const _Float16*)(ws_ + WS_LF); bf16* OG = (bf16*)(ws_ + WS_OG);
    const int u = blk, bh = u >> 4, sc = u & 15, b = bh >> 3, h = bh & 7;
    const int tid = F.tid, lane = F.lane, w = F.wave, l15 = lane & 15, q = lane >> 4, d = tid & 127, tq = tid >> 7;
    LAS unsigned char* lds = F.lds + RING_OFF;
    LAS bf16* QH = (LAS bf16*)(lds + HL_QH); LAS bf16* KH = (LAS bf16*)(lds + HL_KH); LAS bf16* KHT = (LAS bf16*)(lds + HL_KHT); LAS bf16* VT = (LAS bf16*)(lds + HL_VT);
    LAS bf16* AS = (LAS bf16*)(lds + HL_AS); LAS bf16* SPT = (LAS bf16*)(lds + HL_SPT);
    LAS float* QT = (LAS float*)(lds + HL_QT); LAS float* EGM = (LAS float*)(lds + HL_EGM); LAS float* EGL = (LAS float*)(lds + HL_EGL); LAS float* PART = (LAS float*)(lds + HL_PART);
    if (MODE == 1) { for (int i = tid; i < 9216 / 4; i += NWAVES * 64) ((LAS unsigned*)AS)[i] = 0u; }
    f32x4 U[8];
    if (MODE == 1) { const float* si = (const float*)(ws_ + WS_SI) + (size_t)u * 16384 + 16 * w + l15;
#pragma unroll
        for (int dt = 0; dt < 8; ++dt)
#pragma unroll
            for (int rg = 0; rg < 4; ++rg) U[dt][rg] = si[(16 * dt + 4 * q + rg) * 128]; }
    else {
#pragma unroll
        for (int dt = 0; dt < 8; ++dt) U[dt] = (f32x4){0.f, 0.f, 0.f, 0.f}; }
    float gsum = 0.f;
    const float gn = (MODE == 1) ? gnorm[16 * w + l15] : 0.f;
    const size_t row0 = (size_t)b * T + (size_t)sc * 512;
    bf16 rq[16], rv[16]; _Float16 rl[16];
    { const size_t base = (row0 + 16 * tq) * D + h * 128 + d;
#pragma unroll
        for (int i = 0; i < 16; ++i) { const size_t off = base + (size_t)i * D; rq[i] = (MODE == 1) ? QS[off] : (bf16)0; rv[i] = VV[off]; rl[i] = LF[off]; } }
#pragma nounroll
    for (int c = 0; c < 8; ++c) {
        float qv[16], kv[16], vv[16], g[16];
#pragma unroll
        for (int i = 0; i < 16; ++i) { qv[i] = (MODE == 1) ? bf2f(rq[i]) : 0.f; vv[i] = bf2f(rv[i]); g[i] = (float)rl[i]; kv[i] = 1.0f - __expf(g[i]); }
        { const int cn = c < 7 ? c + 1 : 7; const size_t base = (row0 + cn * 64 + 16 * tq) * D + h * 128 + d;
#pragma unroll
            for (int i = 0; i < 16; ++i) { const size_t off = base + (size_t)i * D; if (MODE == 1) rq[i] = QS[off]; rv[i] = VV[off]; rl[i] = LF[off]; } }
        bf16 rg_[16];
        if (MODE == 1) {
#pragma unroll
            for (int ti = 0; ti < 4; ++ti)
#pragma unroll
                for (int rg = 0; rg < 4; ++rg) rg_[4 * ti + rg] = GG[(row0 + c * 64 + 16 * ti + 4 * q + rg) * D + h * 128 + 16 * w + l15]; }
        __builtin_amdgcn_sched_barrier(0);
#pragma unroll
        for (int i = 1; i < 16; ++i) g[i] += g[i - 1];
        QT[tq * 128 + d] = g[15];
        __syncthreads();
        { const float t0 = QT[d], t1 = QT[128 + d], t2 = QT[256 + d], t3 = QT[384 + d];
            const float basev = tq == 0 ? 0.f : (tq == 1 ? t0 : (tq == 2 ? t0 + t1 : t0 + t1 + t2));
            const float Gm = t0 + t1, Gl = (t0 + t1) + (t2 + t3), ref = (MODE == 1) ? Gm : Gl;
            unsigned kp[8], vp[8];
#pragma unroll
            for (int i = 0; i < 16; i += 2) {
                const float G0 = basev + g[i], G1 = basev + g[i + 1];
                const float kh0 = kv[i] * __expf(fminf(ref - G0, 80.f)), kh1 = kv[i + 1] * __expf(fminf(ref - G1, 80.f));
                kp[i >> 1] = cvtpk(kh0, kh1); vp[i >> 1] = cvtpk(vv[i], vv[i + 1]);
                if (MODE == 1) { const float qh0 = qv[i] * __expf(fminf(G0 - ref, 80.f)), qh1 = qv[i + 1] * __expf(fminf(G1 - ref, 80.f));
                    const unsigned qp = cvtpk(qh0, qh1); QH[(16 * tq + i) * 136 + d] = (bf16)(qp & 0xffffu); QH[(16 * tq + i + 1) * 136 + d] = (bf16)(qp >> 16);
                    KH[(16 * tq + i) * 136 + d] = (bf16)(kp[i >> 1] & 0xffffu); KH[(16 * tq + i + 1) * 136 + d] = (bf16)(kp[i >> 1] >> 16); } }
            *(LAS v4u*)(KHT + d * 72 + 16 * tq) = (v4u){kp[0], kp[1], kp[2], kp[3]}; *(LAS v4u*)(KHT + d * 72 + 16 * tq + 8) = (v4u){kp[4], kp[5], kp[6], kp[7]};
            *(LAS v4u*)(VT + d * 72 + 16 * tq) = (v4u){vp[0], vp[1], vp[2], vp[3]}; *(LAS v4u*)(VT + d * 72 + 16 * tq + 8) = (v4u){vp[4], vp[5], vp[6], vp[7]};
            if (tq == 0) { if (MODE == 1) { EGM[d] = __expf(Gm); EGL[d] = __expf(Gl - Gm); } else { EGL[d] = __expf(Gl); gsum += Gl; } } }
        __syncthreads();
        if (MODE == 1) for (int rb_ = 0; rb_ < REP_HCB; ++rb_) {
            for (int tix = w; tix < 10; tix += 8) { const int ti = tix >= 6 ? 3 : (tix >= 3 ? 2 : (tix >= 1 ? 1 : 0)), si = tix - ti * (ti + 1) / 2;
                f32x4 a = (f32x4){0.f, 0.f, 0.f, 0.f};
#pragma unroll
                for (int ks = 0; ks < 4; ++ks) a = MFMA16(*(const LAS bf16x8*)(QH + (16 * ti + l15) * 136 + 32 * ks + 8 * q), *(const LAS bf16x8*)(KH + (16 * si + l15) * 136 + 32 * ks + 8 * q), a);
#pragma unroll
                for (int rg = 0; rg < 4; ++rg) { const int t = 16 * ti + 4 * q + rg, sI = 16 * si + l15; AS[t * 72 + sI] = (bf16)(cvtpk(sI <= t ? a[rg] : 0.f, 0.f) & 0xffffu); } }
#pragma unroll
            for (int dt = 0; dt < 8; ++dt) { const f32x4 eg = *(const LAS f32x4*)(EGM + 16 * dt + 4 * q); if (rb_ == 0) U[dt] = U[dt] * eg;
                *(LAS unsigned long long*)(SPT + (16 * w + l15) * 136 + 16 * dt + 4 * q) = (unsigned long long)cvtpk(U[dt][0], U[dt][1]) | ((unsigned long long)cvtpk(U[dt][2], U[dt][3]) << 32); }
            __syncthreads();
        }
        bf16x8 Vf[2];
#pragma unroll
        for (int kk = 0; kk < 2; ++kk) Vf[kk] = *(const LAS bf16x8*)(VT + (16 * w + l15) * 72 + 32 * kk + 8 * q);
        if (MODE == 1) for (int rc_ = 0; rc_ < REP_HCC; ++rc_) { if (rc_) __syncthreads();
            bf16x8 Sf[4];
#pragma unroll
            for (int ks = 0; ks < 4; ++ks) Sf[ks] = *(const LAS bf16x8*)(SPT + (16 * w + l15) * 136 + 32 * ks + 8 * q);
            f32x4 o[4];
#pragma unroll
            for (int ti = 0; ti < 4; ++ti) { f32x4 a = (f32x4){0.f, 0.f, 0.f, 0.f};
#pragma unroll
                for (int kk = 0; kk < 2; ++kk) if (kk <= (ti >> 1)) a = MFMA16(*(const LAS bf16x8*)(AS + (16 * ti + l15) * 72 + 32 * kk + 8 * q), Vf[kk], a);
#pragma unroll
                for (int ks = 0; ks < 4; ++ks) a = MFMA16(*(const LAS bf16x8*)(QH + (16 * ti + l15) * 136 + 32 * ks + 8 * q), Sf[ks], a);
                o[ti] = a; }
#pragma unroll
            for (int ti = 0; ti < 4; ++ti)
#pragma unroll
                for (int rg = 0; rg < 4; ++rg) { float p = o[ti][rg] * o[ti][rg]; p += __shfl_xor(p, 1); p += __shfl_xor(p, 2); p += __shfl_xor(p, 4); p += __shfl_xor(p, 8);
                    if (l15 == 0) PART[w * 64 + 16 * ti + 4 * q + rg] = p; }
            __syncthreads();
#pragma unroll
            for (int ti = 0; ti < 4; ++ti)
#pragma unroll
                for (int rg = 0; rg < 4; ++rg) { const int t = 16 * ti + 4 * q + rg; float ss = 0.f;
#pragma unroll
                    for (int ww = 0; ww < 8; ++ww) ss += PART[ww * 64 + t];
                    const float rs = __builtin_amdgcn_rsqf(ss * (1.0f / 128.0f) + EPS);
                    const size_t off = (row0 + c * 64 + t) * D + h * 128 + 16 * w + l15;
                    OG[off] = (bf16)(cvtpk(o[ti][rg] * rs * gn * bf2f(rg_[4 * ti + rg]), 0.f) & 0xffffu); }
        }
        if (MODE == 0) {
#pragma unroll
            for (int dt = 0; dt < 8; ++dt) U[dt] = U[dt] * *(const LAS f32x4*)(EGL + 16 * dt + 4 * q); }
#pragma unroll
        for (int dt = 0; dt < 8; ++dt)
#pragma unroll
            for (int kk = 0; kk < 2; ++kk) U[dt] = MFMA16(*(const LAS bf16x8*)(KHT + (16 * dt + l15) * 72 + 32 * kk + 8 * q), Vf[kk], U[dt]);
        if (MODE == 1) {
#pragma unroll
            for (int dt = 0; dt < 8; ++dt) U[dt] = U[dt] * *(const LAS f32x4*)(EGL + 16 * dt + 4 * q); }
    }
    if (MODE == 0) { float* ls = (float*)(ws_ + WS_LS) + (size_t)u * 16384 + 16 * w + l15;
#pragma unroll
        for (int dt = 0; dt < 8; ++dt)
#pragma unroll
            for (int rg = 0; rg < 4; ++rg) ls[(16 * dt + 4 * q + rg) * 128] = U[dt][rg];
        if (tq == 0) ((float*)(ws_ + WS_GS))[u * 128 + d] = gsum; }
    __syncthreads();
}
__device__ __forceinline__ void hgrn_scan(Frame& F_) {
    PHASE_LOCALS
    unsigned char* const ws_ = kargs()->ws;
    const float* LS = (const float*)(ws_ + WS_LS); const float* GS = (const float*)(ws_ + WS_GS); float* SI = (float*)(ws_ + WS_SI);
    const int x = (blk * NWAVES * 64 + F.tid) * 2, bh = x >> 14, de = x & 16383, dd = de >> 7;
    f32x2 S = (f32x2){0.f, 0.f};
#pragma unroll
    for (int sc = 0; sc < 16; ++sc) { const int u = bh * 16 + sc;
        *(GAS f32x2*)(SI + (size_t)u * 16384 + de) = S;
        const float dec = __expf(GS[u * 128 + dd]); const f32x2 ls = *(const GAS f32x2*)(LS + (size_t)u * 16384 + de);
        S = dec * S + ls; }
}
typedef float f32x16 __attribute__((ext_vector_type(16)));
#define MFMA32(a, b, c) __builtin_amdgcn_mfma_f32_32x32x16_bf16((a), (b), (c), 0, 0, 0)
#define PACK8(x, s) __builtin_bit_cast(bf16x8, (v4u){cvtpk((x)[8 * (s)], (x)[8 * (s) + 1]), cvtpk((x)[8 * (s) + 2], (x)[8 * (s) + 3]), cvtpk((x)[8 * (s) + 4], (x)[8 * (s) + 5]), cvtpk((x)[8 * (s) + 6], (x)[8 * (s) + 7])})
__device__ __forceinline__ int swap23(int x) { return (x & ~12) | ((x & 4) << 1) | ((x & 8) >> 1); }
__device__ __forceinline__ void attn_mfma(Frame& F_, int cv_first, int cv_count) {
    PHASE_LOCALS
    unsigned char* const ws_ = kargs()->ws;
    const bf16* Q = (const bf16*)(ws_ + WS_Q); const bf16* K = (const bf16*)(ws_ + WS_K); const bf16* VT = (const bf16*)(ws_ + WS_VT); bf16* AO = (bf16*)(ws_ + WS_AO);
    const int lane = F.lane, r = lane & 31, hh = lane >> 5;
    bf16x8 Tf[2];
    { const int kout = swap23(r);
#pragma unroll
        for (int s = 0; s < 2; ++s)
#pragma unroll
            for (int j = 0; j < 8; ++j) Tf[s][j] = (16 * s + 8 * hh + j >= kout) ? (short)0xBF80 : (short)0; }
    const int gw = blk * NWAVES + F.wave, bh = gw >> 6, qa = gw & 63, b = bh >> 4, h = bh & 15;
    const bf16* Kb = K + (size_t)bh * 256 * 2048 + lane * 8;
    const bf16* Vb = VT + (size_t)bh * 256 * 2048 + lane * 8;
    bf16x8 Qp[4], Kp[4], Vp[4];
    { const int qt0 = qa; const bf16* qp = Q + (size_t)(b * T + qt0 * 32 + r) * D + h * 64 + 8 * hh; const bf16* kp = Kb + (size_t)qt0 * 2048; const bf16* vp = Vb + (size_t)qt0 * 2048;
#pragma unroll
        for (int x = 0; x < 4; ++x) { Qp[x] = *(const GAS bf16x8*)(qp + 16 * x); Kp[x] = *(const GAS bf16x8*)(kp + 512 * x); Vp[x] = *(const GAS bf16x8*)(vp + 512 * x); } }
#pragma nounroll
    for (int it = 0; it < 4; ++it) {
        const int qt = (it == 0) ? qa : (it == 1) ? 127 - qa : (it == 2) ? 128 + qa : 255 - qa, q0 = qt * 32;
        bf16x8 Qf[4], Kf[4], Vf[4], Kn[4], Vn[4];
#pragma unroll
        for (int x = 0; x < 4; ++x) { Qf[x] = Qp[x]; Kf[x] = Kp[x]; Vf[x] = Vp[x]; }
        { const int qn = (it == 0) ? 127 - qa : (it == 1) ? 128 + qa : 255 - qa;
            const bf16* qp = Q + (size_t)(b * T + qn * 32 + r) * D + h * 64 + 8 * hh; const bf16* kp = Kb + (size_t)qn * 2048; const bf16* vp = Vb + (size_t)qn * 2048;
#pragma unroll
            for (int x = 0; x < 4; ++x) { Qp[x] = *(const GAS bf16x8*)(qp + 16 * x); Kp[x] = *(const GAS bf16x8*)(kp + 512 * x); Vp[x] = *(const GAS bf16x8*)(vp + 512 * x); } }
        __builtin_amdgcn_sched_barrier(0);
        f32x16 O0, O1;
#pragma unroll
        for (int i = 0; i < 16; ++i) { O0[i] = 0.f; O1[i] = 0.f; }
        float R = 0.f;
        for (int kb = qt; kb >= 0; --kb) {
            { const int kn = kb > 0 ? kb - 1 : 0; const bf16* kp = Kb + (size_t)kn * 2048; const bf16* vp = Vb + (size_t)kn * 2048;
#pragma unroll
                for (int x = 0; x < 4; ++x) { Kn[x] = *(const GAS bf16x8*)(kp + 512 * x); Vn[x] = *(const GAS bf16x8*)(vp + 512 * x); } }
            __builtin_amdgcn_sched_barrier(0);
            f32x16 S;
#pragma unroll
            for (int i = 0; i < 16; ++i) S[i] = 0.f;
#pragma unroll
            for (int ks = 0; ks < 4; ++ks) S = MFMA32(Kf[ks], Qf[ks], S);
            f32x16 L;
            const bool diag = (kb == qt);
#pragma unroll
            for (int i = 0; i < 16; ++i) { const float z = fminf(S[i], 126.0f); S[i] = z; L[i] = __builtin_amdgcn_logf(1.0f + __builtin_amdgcn_exp2f(z)); }
            if (diag) {
#pragma unroll
                for (int i = 0; i < 16; ++i) { const int kl = (i & 3) + 4 * ((i >> 2) & 1) + 16 * (i >> 3) + 8 * hh; if (kl >= r) L[i] = 0.f; }
            }
            const bf16x8 L0 = PACK8(L, 0), L1 = PACK8(L, 1);
            const float z0 = S[0];
            S = MFMA32(Tf[0], L0, S); S = MFMA32(Tf[1], L1, S);
            const float tot = __shfl(z0 - S[0], r);
#pragma unroll
            for (int i = 0; i < 16; ++i) S[i] = __builtin_amdgcn_exp2f(S[i] + R);
            if (diag) {
#pragma unroll
                for (int i = 0; i < 16; ++i) { const int kl = (i & 3) + 4 * ((i >> 2) & 1) + 16 * (i >> 3) + 8 * hh; if (kl >= r) S[i] = 0.f; }
            }
            R -= tot;
            const bf16x8 P0 = PACK8(S, 0), P1 = PACK8(S, 1);
            O0 = MFMA32(Vf[0], P0, O0); O0 = MFMA32(Vf[1], P1, O0);
            O1 = MFMA32(Vf[2], P0, O1); O1 = MFMA32(Vf[3], P1, O1);
            if (__builtin_amdgcn_ballot_w64(R >= -150.0f) == 0ull) break;
#pragma unroll
            for (int x = 0; x < 4; ++x) { Kf[x] = Kn[x]; Vf[x] = Vn[x]; }
        }
        bf16* op = AO + (size_t)(b * T + q0 + r) * D + h * 64 + 4 * hh;
#pragma unroll
        for (int g = 0; g < 4; ++g) {
            *(GAS unsigned long long*)(op + 8 * g) = (unsigned long long)cvtpk(O0[4 * g], O0[4 * g + 1]) | ((unsigned long long)cvtpk(O0[4 * g + 2], O0[4 * g + 3]) << 32);
            *(GAS unsigned long long*)(op + 32 + 8 * g) = (unsigned long long)cvtpk(O1[4 * g], O1[4 * g + 1]) | ((unsigned long long)cvtpk(O1[4 * g + 2], O1[4 * g + 3]) << 32); }
        if ((it & 1) == 0) { const int ci = gw + (it >> 1) * (F.G * NWAVES); if (ci < cv_count) conv_one_moe_down(cv_first + ci, 1, ws_, F.lds + RING_OFF, F.wave, lane); }
    }
}

__device__ __forceinline__ void prologue(Frame& F_) {
    PHASE_LOCALS
    unsigned char* const ws_ = kargs()->ws;
#define in (kargs()->in)
    if (blk == 0) { GAS float* LB = (GAS float*)(ws_ + TAB_LB); const float* raw = in[4];
        for (int c = F.tid; c < D; c += NWAVES * 64) { const float a = raw[c], b = raw[D + c], mx = fmaxf(a, b), ea = __expf(a - mx), eb = __expf(b - mx); LB[c] = 0.f; LB[D + c] = eb / (ea + eb); } }
    conv8_all(F, true, 0);
    conv_all(F, true, 0);
    __syncthreads();
    norm_phase(F, in[0], false, nullptr, nullptr);
#undef in
}

#ifndef REP_PRO
#define REP_PRO 1
#endif
#ifndef REP_HGRN
#define REP_HGRN 1
#endif
#ifndef REP_HG0
#define REP_HG0 1
#endif
#ifndef REP_HG1
#define REP_HG1 1
#endif
#ifndef REP_ATTN
#define REP_ATTN 1
#endif
#ifndef REP_NORM
#define REP_NORM 1
#endif
#ifndef REP_CONV
#define REP_CONV 1
#endif
#ifndef REP_MDOWN
#define REP_MDOWN 1
#endif
#ifndef REP_MGU
#define REP_MGU 1
#endif
#ifndef REP_OUTP
#define REP_OUTP 1
#endif
#ifndef REP_DDOWN
#define REP_DDOWN 1
#endif
#ifndef REP_BAR
#define REP_BAR 1
#endif
#ifndef REP_SCAT
#define REP_SCAT 1
#endif
#ifndef REP_WIN
#define REP_WIN 1
#endif
#ifndef REP_DGU
#define REP_DGU 1
#endif
#ifndef REP_QKV
#define REP_QKV 1
#endif
#define REPEAT(n) _Pragma("nounroll") for (int rep_ = 0; rep_ < (n); ++rep_)

constexpr int NPH = 1 + (5 + 1 + 3) + (5 + 1 + 4) + (3 + 1 + 3) + (3 + 1 + 4);
__global__ void __launch_bounds__(NWAVES * 64, 2) yoco_fwd(Args) {
    extern __shared__ __attribute__((aligned(16))) unsigned char lds[];
    Frame F;
    F.lds = (LAS unsigned char*)lds;
    F.MISC = (volatile LAS unsigned*)(F.lds + MISC_OFF);
    F.tid = threadIdx.x; F.lane = F.tid & 63; F.wave = __builtin_amdgcn_readfirstlane(F.tid >> 6);
    F.G = gridDim.x; { const int bx = blockIdx.x; F.vcu = (F.G % 8 == 0) ? (bx % 8) * (F.G / 8) + bx / 8 : bx; }
    for (int u = F.tid; u < (LDS_BYTES - LDSCTL_OFF) / 4; u += NWAVES * 64) ((LAS unsigned*)(F.lds + LDSCTL_OFF))[u] = 0u;
    __syncthreads();
    const int lo = kargs()->ph_lo, hi = kargs()->ph_hi;
    XcdBarrier bar; bar.bar = (unsigned*)(kargs()->ws + WS_CTL) + CW_BAR; bar.x = 0; bar.st = nullptr;
    if (hi - lo > 1) bar = xcd_barrier_post((unsigned*)(kargs()->ws + WS_CTL) + CW_BAR, F.MISC + 8);
    int ph = 0;
#define PH_ON (ph >= lo && ph < hi)
#define PH_END do { if (ph >= lo && ph + 1 < hi) { XcdBarrier b2_; b2_.bar = (unsigned*)(wsbase() + WS_CTL) + CW_BAR; b2_.st = bar.st; b2_.x = lg((int)__builtin_amdgcn_readfirstlane(bar.x)); xcd_barrier(b2_); } ++ph; } while (0)
#define in (kargs()->in)
#define X (kargs()->out)
#define XQB ((const bf16*)(wsbase() + WS_XQ))
#define W8P(off) ((const bf16*)(wsbase() + WS_W8 + ((off) - WS_WIN) / 2))
#define SBP(off) ((const float*)(wsbase() + WS_SB) + ((off) - WS_WIN) / 2048)
#define SAPTR ((const float*)(wsbase() + WS_SA))
#define ws (wsbase())

    if (PH_ON) REPEAT(REP_PRO) { prologue(F); __syncthreads(); }
    PH_END;
#pragma nounroll
    for (int layer = 0; layer < 4; ++layer) {
        const bool hg = layer < 2, moe = (layer & 1) != 0;
        const int fi = layer >> 1;
        if (hg) {
            if (PH_ON) {
                const size_t wo = WS_WIN + (size_t)layer * 4 * D * D * 2;
                pg8::Gemm g{XQB, W8P(wo), M, 4 * D, D / 2, D / 2, 0, 0, 0, 0, SAPTR, SBP(wo)}; pg8::StaticOrder S; S.init(M, 4 * D, lg(F.G), lg((int)blockIdx.x));
                pg8::EpiHgrnIn E{(bf16*)(ws + WS_QS), (_Float16*)(ws + WS_LF), (const float*)(ws + TAB_LB) + layer * D};
                static_assert(WS_VV == WS_QS + 2 * 2 * pg8::EpiHgrnIn::SEGSTRIDE && WS_GG == WS_QS + 3 * 2 * pg8::EpiHgrnIn::SEGSTRIDE, "segment buffers are 32 MiB apart");
                REPEAT(REP_WIN) { pg8::gemm_phase<pg8::EpiHgrnIn, pg8::StaticOrder, true, true, true>(F.lds + RING_OFF, g, S, E); __syncthreads(); }
            }
            PH_END;
            if (PH_ON) REPEAT(REP_HGRN * REP_HG0) hgrn_chunks<0>(F, nullptr);
            PH_END;
            if (PH_ON) REPEAT(REP_HGRN) hgrn_scan(F);
            PH_END;
            if (PH_ON) REPEAT(REP_HGRN * REP_HG1) hgrn_chunks<1>(F, in[5] + layer * 128);
            PH_END;
        } else {
            if (PH_ON) {
                const int nw = (layer == 2) ? 3 : 1;
#pragma nounroll
                for (int w = 0; w < nw * REP_QKV; ++w) {
                    pg8::Gemm g; pg8::EpiBf16P E; pg8::StaticOrder S;
                    if (w % nw == 0) { const size_t wo = WS_WQ + (size_t)(layer - 2) * D * D * 2; g = pg8::Gemm{XQB, W8P(wo), M, D, D / 2, D / 2, 0, 0, 0, 0, SAPTR, SBP(wo)}; E = pg8::EpiBf16P{(bf16*)(ws + WS_Q), D, 0}; }
                    else if (w % nw == 1) { g = pg8::Gemm{XQB, W8P(WS_WK), M, D, D / 2, D / 2, 0, 0, 0, 0, SAPTR, SBP(WS_WK)}; E = pg8::EpiBf16P{(bf16*)(ws + WS_K), D, 1}; }
                    else { g = pg8::Gemm{W8P(WS_WV), XQB, D, M, D / 2, D / 2, 0, 0, 0, 0, SBP(WS_WV), SAPTR}; E = pg8::EpiBf16P{(bf16*)(ws + WS_VT), M, 2}; }
                    S.init(g.M, g.N, lg(F.G), lg((int)blockIdx.x));
                    pg8::gemm_phase<pg8::EpiBf16P, pg8::StaticOrder, true, true, true>(F.lds + RING_OFF, g, S, E);
                    __syncthreads();
                }
            }
            PH_END;
            if (PH_ON) REPEAT(REP_ATTN) attn_mfma(F, (layer - 2) * (CONV_MOE_ITEMS / 2), CONV_MOE_ITEMS / 2);
            PH_END;
        }
        if (PH_ON) {
            const float* xin = (layer == 0) ? in[0] : X;
            pg8::Gemm g{hg ? (const bf16*)(ws + WS_OG) : (const bf16*)(ws + WS_AO), hg ? (const bf16*)(ws + WS_WOUT) + (size_t)layer * D * D : (const bf16*)(ws + WS_WO) + (size_t)(layer - 2) * D * D, M, D, D, D};
            pg8::StaticOrder S; S.init(M, D, lg(F.G), lg((int)blockIdx.x));
            REPEAT(REP_OUTP) { pg8::EpiResid E{xin, rep_ == 0 ? X : (float*)(ws + WS_OR), D};
                pg8::gemm_phase<pg8::EpiResid, pg8::StaticOrder, true, true>(F.lds + RING_OFF, g, S, E); __syncthreads(); }
        }
        PH_END;
        if (PH_ON) REPEAT(REP_NORM) { norm_phase(F, X, moe, in[13] + (size_t)fi * D * NE, in[2] + layer * D); __syncthreads(); }
        PH_END;
        if (moe) { if (PH_ON) REPEAT(REP_SCAT) { scatter_phase(F); __syncthreads(); } PH_END; }
        if (PH_ON) {
            const int nrt = moe ? __builtin_amdgcn_readfirstlane(((const GAS int*)(ws + TAB_TILE))[160]) : M / 256;
            const size_t wo = WS_WGU + (size_t)fi * 2 * FFD * D * 2;
            pg8::Gemm g{moe ? (const bf16*)(ws + WS_XPQ) : XQB, moe ? (const bf16*)(ws + WS_WM8) : W8P(wo), nrt * 256, moe ? 2 * FFE : 2 * FFD, D / 2, D / 2, 0, 0, 0, 0,
                        moe ? (const float*)(ws + WS_SAP) : SAPTR, moe ? (const float*)(ws + WS_SBM) : SBP(wo)};
            pg8::MoeOrder S; S.init(nrt, (moe ? 2 * FFE : 2 * FFD) / 256, 1, D / 2, lg(F.G), lg((int)blockIdx.x), moe ? (const int*)(ws + TAB_TILE) : (const int*)(ws + WS_CTL) + CW_ZTAB, nullptr, 0);
            pg8::EpiSwiglu E{moe ? (bf16*)(ws + WS_HM) : (bf16*)(ws + WS_HB), moe ? MROWS : M};
            REPEAT(moe ? REP_MGU : REP_DGU) { pg8::gemm_phase<pg8::EpiSwiglu, pg8::MoeOrder, true, true, true>(F.lds + RING_OFF, g, S, E); __syncthreads(); }
        }
        PH_END;
        if (PH_ON) {
            const int* TE = (const int*)(ws + TAB_TILE);
#pragma nounroll
            for (int w = 0; w < (moe ? 2 : 1); ++w) {
                const int nrt = moe ? __builtin_amdgcn_readfirstlane(((const GAS int*)TE)[w == 0 ? 336 : 368]) : M / 256;
                const int ksn = (moe && w == 1) ? MOE_RKS : 1, kl = moe ? (w == 1 ? MOE_RKL : FFE) : FFD;
                pg8::Gemm g{moe ? (const bf16*)(ws + WS_HM) : (const bf16*)(ws + WS_HB), moe ? (const bf16*)(ws + (layer == 1 ? WS_WMDN : WS_WMDN2)) : (const bf16*)(ws + WS_WDN) + (size_t)fi * D * FFD, nrt * 256, D, moe ? FFE : FFD, kl,
                            64, 64, (long)(moe ? MROWS : M) * 128, (long)(moe ? NE * D : D) * 128};
                pg8::MoeOrder S; S.init(nrt, D / 256, ksn, kl, lg(F.G), lg((int)blockIdx.x), moe ? TE : (const int*)(ws + WS_CTL) + CW_ZTAB, moe ? TE + (w == 0 ? 176 : 352) : nullptr, w);
                if (moe) { REPEAT(REP_MDOWN) { pg8::EpiDownMoe E{(bf16*)(ws + (w == 0 ? WS_Y0 : WS_YR)), YR_STRIDE, kl, D};
                    pg8::gemm_phase<pg8::EpiDownMoe, pg8::MoeOrder, true, true>(F.lds + RING_OFF, g, S, E); __syncthreads(); } }
                else { REPEAT(REP_DDOWN) { pg8::EpiDown E{X, rep_ == 0 ? X : (float*)(ws + WS_OR), nullptr, 0, kl, D};
                    pg8::gemm_phase<pg8::EpiDown, pg8::MoeOrder, true, true>(F.lds + RING_OFF, g, S, E); __syncthreads(); } }
            }
        }
        PH_END;
        if (PH_ON) {
            if (moe) { combine_phase(F, X, layer == 3, in[17]); if (layer == 1) REPEAT(REP_CONV) { __syncthreads(); conv8_all(F, false, 1); } }
            else norm_phase(F, X, false, nullptr, nullptr);
        }
        PH_END;
    }
#undef PH_ON
#undef PH_END
#undef in
#undef X
#undef ws
#undef XQB
#undef W8P
#undef SBP
#undef SAPTR
}

#ifndef MK_PER_PHASE
#define MK_PER_PHASE 0
#endif
extern "C" void kernel_launch(void* const* d_in, const int* in_sizes, int n_in, void* d_out, int out_size, void* d_ws, size_t ws_size, hipStream_t stream) {
    static int ok = 0;
    if (ok == 0) {
        if (n_in != 18 || in_sizes[0] != M * D || out_size != M * D || ws_size < WS_END) { fprintf(stderr, "kernel_launch: unexpected shapes / workspace (n_in %d, ws %zu, need %zu); nothing launched\n", n_in, ws_size, (size_t)WS_END); ok = -1; return; }
        if (hipFuncSetAttribute((const void*)yoco_fwd, hipFuncAttributeMaxDynamicSharedMemorySize, LDS_BYTES) != hipSuccess) { fprintf(stderr, "kernel_launch: hipFuncSetAttribute failed\n"); ok = -1; return; }
        int per_cu = 0;
        if (hipOccupancyMaxActiveBlocksPerMultiprocessor(&per_cu, (const void*)yoco_fwd, NWAVES * 64, LDS_BYTES) != hipSuccess || per_cu < 1) fprintf(stderr, "kernel_launch: note: occupancy query reports %d workgroups per CU\n", per_cu);
        (void)hipGetLastError();
        ok = 1;
    }
    if (ok < 0) return;
    (void)hipMemsetAsync((char*)d_ws + WS_CTL, 0, CTL_ZERO_BYTES, stream);
    Args a{};
    for (int i = 0; i < 18; ++i) a.in[i] = (const float*)d_in[i];
    a.out = (float*)d_out; a.ws = (unsigned char*)d_ws;
#if MK_PER_PHASE
    for (int p = 0; p < NPH; ++p) { a.ph_lo = p; a.ph_hi = p + 1; hipLaunchKernelGGL(yoco_fwd, dim3(GRID), dim3(NWAVES * 64), LDS_BYTES, stream, a); }
#else
    a.ph_lo = 0; a.ph_hi = NPH; hipLaunchKernelGGL(yoco_fwd, dim3(GRID), dim3(NWAVES * 64), LDS_BYTES, stream, a);
#endif
}
```
